# Optimizing an MI355X kernel written in HIP

```python
import jax, jax.numpy as jnp
from jax import lax
import numpy as np

D_MODEL = 2048
BATCH = 4
SEQ = 4096
DEPTH = 1

D_MIX = D_MODEL
D_ATTN = D_MIX // 2
D_POOL = D_MIX - D_ATTN
HEAD_DIM = 128
N_HEADS = D_ATTN // HEAD_DIM
ROPE_DIM = HEAD_DIM // 4
ROPE_THETA = 500000.0
DILATED_PATTERNS = ((128, 1), (512, 4), (2048, 16))
POOL_WINDOWS = (2, 4, 8, 16)
N_POOL_GROUPS = len(POOL_WINDOWS)
POOL_GROUP_DIM = D_POOL // N_POOL_GROUPS
D_IN = 3 * D_ATTN + D_POOL + D_MIX
LN_EPS = 1e-5
DEEPNORM_ALPHA = (2.0 * DEPTH) ** 0.25
DEEPNORM_BETA = (8.0 * DEPTH) ** -0.25

kernel_name = "hybrid_dilated_attn_pool_deepnorm"


def rotary_partial(t, positions):
    half = ROPE_DIM // 2
    inv_freq = ROPE_THETA ** (-(2.0 * jnp.arange(half, dtype=jnp.float32)) / ROPE_DIM)
    ang = positions.astype(jnp.float32)[:, None] * inv_freq[None, :]
    cos = jnp.cos(ang)[None, :, None, :]
    sin = jnp.sin(ang)[None, :, None, :]
    t32 = t.astype(jnp.float32)
    t1, t2, rest = t32[..., :half], t32[..., half:ROPE_DIM], t32[..., ROPE_DIM:]
    out = jnp.concatenate([t1 * cos - t2 * sin, t1 * sin + t2 * cos, rest], axis=-1)
    return out.astype(t.dtype)


def banded_causal_attention(q, k, v, n_keys):
    G, N, Dh = q.shape
    W = n_keys
    nb = -(-N // W)
    Np = nb * W
    pad = Np - N
    qp = jnp.pad(q, ((0, 0), (0, pad), (0, 0)))
    kp = jnp.pad(k, ((0, 0), (W, pad), (0, 0)))
    vp = jnp.pad(v, ((0, 0), (W, pad), (0, 0)))
    qb = qp.reshape(G, nb, W, Dh)
    kb = jnp.concatenate([kp[:, :Np].reshape(G, nb, W, Dh), kp[:, W:].reshape(G, nb, W, Dh)], axis=2)
    vb = jnp.concatenate([vp[:, :Np].reshape(G, nb, W, Dh), vp[:, W:].reshape(G, nb, W, Dh)], axis=2)
    s = jnp.einsum('gcqd,gckd->gcqk', qb, kb).astype(jnp.float32) * (Dh ** -0.5)
    qi = jnp.arange(W)[:, None]
    kj = jnp.arange(2 * W)[None, :]
    dist = W + qi - kj
    key_pos = (jnp.arange(nb)[:, None, None] - 1) * W + kj[None]
    mask = (dist >= 0)[None] & (dist <= W)[None] & (key_pos >= 0)
    s = jnp.where(mask[None], s, -jnp.inf)
    m = jnp.max(s, axis=-1, keepdims=True)
    p = jnp.exp(s - m)
    den = jnp.sum(p, axis=-1, keepdims=True)
    o = jnp.einsum('gcqk,gckd->gcqd', p, vb.astype(jnp.float32)) / den
    lse = (m + jnp.log(den))[..., 0]
    return o.reshape(G, Np, Dh)[:, :N], lse.reshape(G, Np)[:, :N]


def dilated_attention(q, k, v, window, dilation):
    B, H, S, Dh = q.shape
    n_sub = S // dilation

    def to_residues(t):
        return t.reshape(B, H, n_sub, dilation, Dh).transpose(0, 1, 3, 2, 4).reshape(B * H * dilation, n_sub, Dh)

    o, lse = banded_causal_attention(to_residues(q), to_residues(k), to_residues(v), window // dilation)
    o = o.reshape(B, H, dilation, n_sub, Dh).transpose(0, 1, 3, 2, 4).reshape(B, H, S, Dh)
    lse = lse.reshape(B, H, dilation, n_sub).transpose(0, 1, 3, 2).reshape(B, H, S)
    return o, lse


def dilated_attention_mixture(q, k, v):
    outs, lses = [], []
    for window, dilation in DILATED_PATTERNS:
        o, lse = dilated_attention(q, k, v, window, dilation)
        outs.append(o)
        lses.append(lse)
    w = jax.nn.softmax(jnp.stack(lses, axis=0), axis=0)
    return jnp.einsum('pbhs,pbhsd->bhsd', w, jnp.stack(outs, axis=0))


def causal_pool_minus_identity(u, window):
    S = u.shape[1]
    u32 = u.astype(jnp.float32)
    c = jnp.cumsum(u32, axis=1)
    c_shift = jnp.pad(c, ((0, 0), (window, 0), (0, 0)))[:, :S]
    count = jnp.minimum(jnp.arange(S) + 1, window).astype(jnp.float32)
    return (c - c_shift) / count[None, :, None] - u32


def layer_norm(h, gain, bias):
    h32 = h.astype(jnp.float32)
    mu = jnp.mean(h32, axis=-1, keepdims=True)
    var = jnp.mean(jnp.square(h32 - mu), axis=-1, keepdims=True)
    return (h32 - mu) * lax.rsqrt(var + LN_EPS) * gain.astype(jnp.float32) + bias.astype(jnp.float32)


def setup_inputs(seed: int = 0) -> dict:
    key = jax.random.key(seed)
    ks = jax.random.split(key, 8)
    x = jax.random.normal(ks[0], (BATCH, SEQ, D_MODEL), jnp.float32)
    w_in = jax.random.normal(ks[1], (DEPTH, D_MODEL, D_IN), jnp.float32) * D_MODEL ** -0.5
    w_pool = jax.random.normal(ks[2], (DEPTH, N_POOL_GROUPS, POOL_GROUP_DIM, POOL_GROUP_DIM), jnp.float32) * POOL_GROUP_DIM ** -0.5
    pool_scale = 1.0 + 0.02 * jax.random.normal(ks[3], (DEPTH, D_POOL), jnp.float32)
    w_out = jax.random.normal(ks[4], (DEPTH, D_MIX, D_MODEL), jnp.float32) * (D_MIX ** -0.5) * DEEPNORM_BETA
    ln_gain = 1.0 + 0.02 * jax.random.normal(ks[5], (DEPTH, D_MODEL), jnp.float32)
    ln_bias = 0.02 * jax.random.normal(ks[6], (DEPTH, D_MODEL), jnp.float32)
    return {"x": x, "w_in": w_in, "w_pool": w_pool, "pool_scale": pool_scale,
            "w_out": w_out, "ln_gain": ln_gain, "ln_bias": ln_bias}


def reference(x, w_in, w_pool, pool_scale, w_out, ln_gain, ln_bias):
    B, S, _ = x.shape
    positions = jnp.arange(S, dtype=jnp.int32)
    for layer in range(DEPTH):
        h = jnp.einsum('bsd,de->bse', x, w_in[layer])
        q, k, v, u_pool, gate = jnp.split(
            h, [D_ATTN, 2 * D_ATTN, 3 * D_ATTN, 3 * D_ATTN + D_POOL], axis=-1)

        q = rotary_partial(q.reshape(B, S, N_HEADS, HEAD_DIM), positions).transpose(0, 2, 1, 3)
        k = rotary_partial(k.reshape(B, S, N_HEADS, HEAD_DIM), positions).transpose(0, 2, 1, 3)
        v = v.reshape(B, S, N_HEADS, HEAD_DIM).transpose(0, 2, 1, 3)
        attn = dilated_attention_mixture(q, k, v)
        attn = attn.transpose(0, 2, 1, 3).reshape(B, S, D_ATTN)

        u_groups = u_pool.reshape(B, S, N_POOL_GROUPS, POOL_GROUP_DIM)
        pooled = jnp.stack([causal_pool_minus_identity(u_groups[:, :, g], POOL_WINDOWS[g])
                            for g in range(N_POOL_GROUPS)], axis=2)
        pool_out = jnp.einsum('bsgc,gcd->bsgd', pooled, w_pool[layer].astype(jnp.float32))
        pool_out = pool_out.reshape(B, S, D_POOL) * pool_scale[layer].astype(jnp.float32)

        y = jnp.concatenate([attn, pool_out], axis=-1) * jax.nn.silu(gate.astype(jnp.float32))
        out = jnp.einsum('bse,ed->bsd', y.astype(x.dtype), w_out[layer])

        x = layer_norm(DEEPNORM_ALPHA * x.astype(jnp.float32) + out.astype(jnp.float32),
                       ln_gain[layer], ln_bias[layer]).astype(x.dtype)
    return x
```

```cpp
#include <hip/hip_runtime.h>
#include <cstdio>
#include <cstdint>

#ifndef MK_N_LAUNCHES
#define MK_N_LAUNCHES 6
#endif

namespace pg8 {
#define PG8_LAS __attribute__((address_space(3)))
typedef unsigned short bf16_t;
typedef short bf16x8 __attribute__((ext_vector_type(8)));
typedef float f32x4 __attribute__((ext_vector_type(4)));
typedef unsigned u32x4 __attribute__((ext_vector_type(4)));
constexpr int BM = 256, BK = 64, HALF = 128, HTB = HALF * BK * 2  , STAGE_BYTES = 8 * HTB, NXCD = 8, WGM = 8;

__host__ __device__ __forceinline__ int lds_byte(int r, int c) { const int st = (r >> 4) * 2 + (c >> 5), rr = r & 15, cc = c & 31, ob = rr * 64 + cc * 2; return st * 1024 + (ob ^ (((ob >> 9) & 1) << 5)); }
__host__ __device__ __forceinline__ void stage_rc(int b, int& R, int& C) { const int st = b / 1024, sb = b % 1024, swz = sb ^ (((sb >> 9) & 1) << 5); R = (st >> 1) * 16 + swz / 64; C = (st & 1) * 32 + (swz % 64) / 2; }
__host__ __device__ __forceinline__ int perm32(int rho) { const int n = rho >> 4, i = rho & 15; return 8 * (i >> 2) + 4 * n + (i & 3); }

struct Unit { int pm, pn; };
struct Gemm { const bf16_t* A; const bf16_t* Bt; int M, N, K; };

struct StaticOrder {
    int nM, nN, nwg, G, c;
    __host__ __device__ void init(int M, int N, int G_, int c_) { nM = M / BM; nN = N / BM; nwg = nM * nN; G = G_; c = c_; }
    __host__ __device__ bool next(int i, Unit& u) const {
        const long L = (long)i * G + c; if (L >= nwg) return false;
        int wgid = (int)L; { const int q = nwg / NXCD, r = nwg % NXCD, xcd = wgid % NXCD, off = wgid / NXCD; wgid = (xcd < r ? xcd * (q + 1) : r * (q + 1) + (xcd - r) * q) + off; }
        const int nig = WGM * nN, gid = wgid / nig, fm = gid * WGM, gsz = (nM - fm) < WGM ? (nM - fm) : WGM;
        u.pm = fm + ((wgid % nig) % gsz); u.pn = (wgid % nig) / gsz; return true;
    }
    __device__ __forceinline__ void a_ready(const Unit&) const {}
    __device__ __forceinline__ void done(const Unit&) const {}
};


__device__ __forceinline__ unsigned cvt_pk_bf16(float lo, float hi) { unsigned r; asm volatile("v_cvt_pk_bf16_f32 %0, %1, %2" : "=v"(r) : "v"(lo), "v"(hi)); return r; }

struct EpiH {
    static constexpr bool PERM = true, AFTER_DRAIN = false;
    bf16_t* QKV;
    bf16_t* U;
    bf16_t* G;
    const float* rope;
    float qscale;
    __device__ __forceinline__ void operator()(const f32x4 (&acc)[2][2][4][2], const Unit& u, int wr, int wc, int fr, int fq) const {
        const int pn = u.pn, row0 = u.pm * BM + wr * 64 + fr;
        if (pn < 12) {
            const int which = pn >> 2;
            const bool rot = (which < 2) && (wc == 0);
            const float sc = (which == 0) ? qscale : 1.f;
            const float sgn = (fq < 2) ? -1.f : 1.f;
#pragma unroll
            for (int ai = 0; ai < 2; ++ai)
#pragma unroll
                for (int m = 0; m < 4; ++m) {
                    const int row = row0 + ai * HALF + m * 16, b = row >> 12, t = row & 4095;
                    f32x4 cs[2], sn[2];
                    if (rot) {
#pragma unroll
                        for (int n = 0; n < 2; ++n) { cs[n] = *(const f32x4*)(rope + t * 16 + 8 * (fq & 1) + 4 * n); sn[n] = *(const f32x4*)(rope + 65536 + t * 16 + 8 * (fq & 1) + 4 * n); }
                    }
#pragma unroll
                    for (int bj = 0; bj < 2; ++bj) {
                        const int head = 2 * (pn & 3) + bj;
                        f32x4 v[2] = {acc[ai][bj][m][0], acc[ai][bj][m][1]};
                        if (rot) {
#pragma unroll
                            for (int n = 0; n < 2; ++n)
#pragma unroll
                                for (int j = 0; j < 4; ++j) { const float own = v[n][j], oth = __shfl_xor(own, 32); v[n][j] = own * cs[n][j] + sgn * oth * sn[n][j]; }
                        }
                        u32x4 w; w.x = cvt_pk_bf16(v[0][0] * sc, v[0][1] * sc); w.y = cvt_pk_bf16(v[0][2] * sc, v[0][3] * sc); w.z = cvt_pk_bf16(v[1][0] * sc, v[1][1] * sc); w.w = cvt_pk_bf16(v[1][2] * sc, v[1][3] * sc);
                        *(u32x4*)(QKV + ((size_t)((which * 32 + b * 8 + head) * 4096 + t)) * 128 + wc * 32 + 8 * fq) = w;
                    }
                }
        } else {
            bf16_t* base; int ldc, colt;
            if (pn < 16) { base = U; ldc = 1024; colt = (pn - 12) * BM; } else { base = G; ldc = 2048; colt = (pn - 16) * BM; }
            const int col0 = colt + wc * 32 + 8 * fq;
#pragma unroll
            for (int ai = 0; ai < 2; ++ai)
#pragma unroll
                for (int m = 0; m < 4; ++m) { bf16_t* rowp = base + (size_t)(row0 + ai * HALF + m * 16) * ldc + col0;
#pragma unroll
                    for (int bj = 0; bj < 2; ++bj) { const f32x4 v0 = acc[ai][bj][m][0], v1 = acc[ai][bj][m][1];
                        u32x4 w; w.x = cvt_pk_bf16(v0[0], v0[1]); w.y = cvt_pk_bf16(v0[2], v0[3]); w.z = cvt_pk_bf16(v1[0], v1[1]); w.w = cvt_pk_bf16(v1[2], v1[3]);
                        *(u32x4*)(rowp + bj * HALF) = w; } }
        }
    }
};
struct EpiZ {
    static constexpr bool PERM = false, AFTER_DRAIN = false;
    const float* x; float* out; int ldc; float alpha;
    __device__ __forceinline__ void operator()(const f32x4 (&acc)[2][2][4][2], const Unit& u, int wr, int wc, int fr, int fq) const {
        const int row0 = u.pm * BM + wr * 64 + fr, col0 = u.pn * BM + wc * 32 + 4 * fq;
#pragma unroll
        for (int ai = 0; ai < 2; ++ai)
#pragma unroll
            for (int m = 0; m < 4; ++m) { const size_t off = (size_t)(row0 + ai * HALF + m * 16) * ldc + col0;
#pragma unroll
                for (int bj = 0; bj < 2; ++bj)
#pragma unroll
                    for (int n = 0; n < 2; ++n) { const f32x4 xv = *(const f32x4*)(x + off + bj * HALF + n * 16); *(f32x4*)(out + off + bj * HALF + n * 16) = xv * alpha + acc[ai][bj][m][n]; }
                if (m & 1) asm volatile("" ::: "memory"); }
    }
};

template <class Epi, class Sched, bool ALIGN_EPI = false, bool SP2 = false>
__device__ __forceinline__ void gemm_phase(PG8_LAS unsigned char* lds, const Gemm g, const Sched& S, const Epi& E) {
    int tid_ = threadIdx.x; asm volatile("" : "+v"(tid_));
    const int tid = tid_, wid = __builtin_amdgcn_readfirstlane(tid >> 6), lane = tid & 63, wr = wid >> 2, wc = wid & 3, fr = lane & 15, fq = lane >> 4;
    const int K = g.K, nt = K / BK;
    unsigned voffA[2], voffB[2];
#pragma unroll
    for (int i = 0; i < 2; ++i) { int R, C; stage_rc(tid * 16 + i * 8192, R, C); const int Rb = Epi::PERM ? ((R & ~31) + perm32(R & 31)) : R;
        voffA[i] = (unsigned)(R * K + C) * 2u; voffB[i] = (unsigned)(Rb * K + C) * 2u; }
    const size_t kstep = (size_t)(BK * 2);
    const size_t hstep = (size_t)HALF * K * 2;
    const size_t tstep = 2 * hstep;
    const unsigned ldsw = (unsigned)wid * 1024u;
    const int aoff = lds_byte(wr * 64 + fr, fq * 8), boff = lds_byte(wc * 32 + fr, fq * 8);
#define PG8_SA(b, h) (((b) * 2 + (h)) * HTB)
#define PG8_SB(b, h) ((4 + (b) * 2 + (h)) * HTB)
#define PG8_STAGE(bufoff, gbase, voff) do { _Pragma("unroll") for (int _i = 0; _i < 2; ++_i) \
        __builtin_amdgcn_global_load_lds((const unsigned*)((const char*)(gbase) + (voff)[_i]), (PG8_LAS unsigned*)(lds + (bufoff) + ldsw + _i * 8192), 16, 0, 0); } while (0)
#define PG8_LDA(dst, b, h) do { _Pragma("unroll") for (int m = 0; m < 4; ++m) _Pragma("unroll") for (int k = 0; k < 2; ++k) dst[m][k] = *(const PG8_LAS bf16x8*)(lds + PG8_SA(b, h) + aoff + m * 2048 + k * 1024); } while (0)
#define PG8_LDB(dst, b, h) do { _Pragma("unroll") for (int n = 0; n < 2; ++n) _Pragma("unroll") for (int k = 0; k < 2; ++k) dst[n][k] = *(const PG8_LAS bf16x8*)(lds + PG8_SB(b, h) + boff + n * 2048 + k * 1024); } while (0)
#define PG8_MMA(ai, bj, At, Bt) do { __builtin_amdgcn_s_setprio(1); _Pragma("unroll") for (int m = 0; m < 4; ++m) _Pragma("unroll") for (int n = 0; n < 2; ++n) _Pragma("unroll") for (int k = 0; k < 2; ++k) \
        acc[ai][bj][m][n] = __builtin_amdgcn_mfma_f32_16x16x32_bf16(Bt[n][k], At[m][k], acc[ai][bj][m][n], 0, 0, 0); __builtin_amdgcn_s_setprio(0); } while (0)
#define PG8_WAIT_V(n) asm volatile("s_waitcnt vmcnt(" #n ")" ::: "memory")
#define PG8_WAIT_L(n) asm volatile("s_waitcnt lgkmcnt(" #n ")" ::: "memory")
#define PG8_BAR __builtin_amdgcn_s_barrier()
#define PG8_SCHED __builtin_amdgcn_sched_barrier(0)
    Unit cur, nxt; int ui = 0;
    if (!S.next(0, cur)) return;
    f32x4 acc[2][2][4][2];
#pragma unroll
    for (int a = 0; a < 2; ++a)
#pragma unroll
        for (int b = 0; b < 2; ++b)
#pragma unroll
            for (int m = 0; m < 4; ++m)
#pragma unroll
                for (int n = 0; n < 2; ++n) acc[a][b][m][n] = (f32x4){0.f, 0.f, 0.f, 0.f};
    bf16x8 At[4][2], B0[2][2], B1[2][2];
    const char* cA = (const char*)g.A + (size_t)cur.pm * tstep; const char* cB = (const char*)g.Bt + (size_t)cur.pn * tstep;
    S.a_ready(cur);
    if constexpr (SP2) {
        PG8_STAGE(PG8_SB(0, 0), cB, voffB); PG8_STAGE(PG8_SB(0, 1), cB + hstep, voffB); PG8_STAGE(PG8_SA(0, 0), cA, voffA); PG8_STAGE(PG8_SA(0, 1), cA + hstep, voffA);
        if (wr == 1) PG8_BAR;
        PG8_WAIT_V(2); PG8_BAR;
        PG8_STAGE(PG8_SB(1, 0), cB + kstep, voffB); PG8_STAGE(PG8_SA(1, 0), cA + kstep, voffA); PG8_STAGE(PG8_SB(1, 1), cB + hstep + kstep, voffB);
        PG8_WAIT_V(6); PG8_BAR;
    } else {
        PG8_STAGE(PG8_SB(0, 0), cB, voffB); PG8_STAGE(PG8_SA(0, 0), cA, voffA); PG8_STAGE(PG8_SB(0, 1), cB + hstep, voffB); PG8_STAGE(PG8_SA(0, 1), cA + hstep, voffA);
        if (wr == 1) PG8_BAR;
        PG8_WAIT_V(4); PG8_BAR;
        PG8_STAGE(PG8_SB(1, 0), cB + kstep, voffB); PG8_STAGE(PG8_SA(1, 0), cA + kstep, voffA); PG8_STAGE(PG8_SB(1, 1), cB + hstep + kstep, voffB);
        PG8_WAIT_V(6); PG8_BAR;
    }
    for (;;) {
        const bool has_next = S.next(ui + 1, nxt);
        const char* nA = has_next ? (const char*)g.A + (size_t)nxt.pm * tstep : cA; const char* nB = has_next ? (const char*)g.Bt + (size_t)nxt.pn * tstep : cB;
        for (int t = 0; t < nt; t += 2) {
            const bool last = (t == nt - 2);
            const char* a1 = cA + (size_t)(t + 1) * kstep;
            const char* a2 = last ? nA : cA + (size_t)(t + 2) * kstep; const char* b2 = last ? nB : cB + (size_t)(t + 2) * kstep;
            const char* a3 = a2 + kstep; const char* b3 = b2 + kstep;
            if (last && has_next) S.a_ready(nxt);
            if constexpr (SP2) {
            PG8_LDB(B0, 0, 0); PG8_LDB(B1, 0, 1); PG8_SCHED; PG8_LDA(At, 0, 0); PG8_STAGE(PG8_SA(1, 1), a1 + hstep, voffA);
            PG8_WAIT_V(8); PG8_WAIT_L(0); PG8_BAR; PG8_MMA(0, 0, At, B0); PG8_MMA(0, 1, At, B1); PG8_BAR; PG8_SCHED;
            PG8_LDA(At, 0, 1); PG8_STAGE(PG8_SB(0, 0), b2, voffB); PG8_STAGE(PG8_SB(0, 1), b2 + hstep, voffB); PG8_STAGE(PG8_SA(0, 0), a2, voffA);
            PG8_WAIT_V(8); PG8_WAIT_L(0); PG8_BAR; PG8_MMA(1, 0, At, B0); PG8_MMA(1, 1, At, B1); PG8_BAR; PG8_SCHED;
            PG8_LDB(B0, 1, 0); PG8_LDB(B1, 1, 1); PG8_SCHED; PG8_LDA(At, 1, 0); PG8_STAGE(PG8_SA(0, 1), a2 + hstep, voffA);
            PG8_WAIT_V(8); PG8_WAIT_L(0); PG8_BAR; PG8_MMA(0, 0, At, B0); PG8_MMA(0, 1, At, B1); PG8_BAR; PG8_SCHED;
            PG8_LDA(At, 1, 1); PG8_STAGE(PG8_SB(1, 0), b3, voffB); PG8_STAGE(PG8_SB(1, 1), b3 + hstep, voffB); PG8_STAGE(PG8_SA(1, 0), a3, voffA);
            PG8_WAIT_V(8); PG8_WAIT_L(0); PG8_BAR; PG8_MMA(1, 0, At, B0); PG8_MMA(1, 1, At, B1); PG8_BAR; PG8_SCHED;
            } else {
            PG8_LDB(B0, 0, 0); PG8_SCHED; PG8_LDA(At, 0, 0); PG8_STAGE(PG8_SA(1, 1), a1 + hstep, voffA);
            PG8_WAIT_L(8); PG8_BAR; PG8_WAIT_L(0); PG8_MMA(0, 0, At, B0); PG8_BAR; PG8_SCHED;
            PG8_LDB(B1, 0, 1); PG8_STAGE(PG8_SB(0, 0), b2, voffB);
            PG8_BAR; PG8_WAIT_L(0); PG8_MMA(0, 1, At, B1); PG8_BAR;
            PG8_LDA(At, 0, 1); PG8_STAGE(PG8_SA(0, 0), a2, voffA);
            PG8_BAR; PG8_WAIT_L(0); PG8_MMA(1, 0, At, B0); PG8_BAR; PG8_SCHED;
            PG8_STAGE(PG8_SB(0, 1), b2 + hstep, voffB);
            PG8_WAIT_V(6); PG8_BAR; PG8_MMA(1, 1, At, B1); PG8_BAR;
            PG8_LDB(B0, 1, 0); PG8_SCHED; PG8_LDA(At, 1, 0); PG8_STAGE(PG8_SA(0, 1), a2 + hstep, voffA);
            PG8_WAIT_L(8); PG8_BAR; PG8_WAIT_L(0); PG8_MMA(0, 0, At, B0); PG8_BAR; PG8_SCHED;
            PG8_LDB(B1, 1, 1); PG8_STAGE(PG8_SB(1, 0), b3, voffB);
            PG8_BAR; PG8_WAIT_L(0); PG8_MMA(0, 1, At, B1); PG8_BAR;
            PG8_LDA(At, 1, 1); PG8_STAGE(PG8_SA(1, 0), a3, voffA);
            PG8_BAR; PG8_WAIT_L(0); PG8_MMA(1, 0, At, B0); PG8_BAR; PG8_SCHED;
            PG8_STAGE(PG8_SB(1, 1), b3 + hstep, voffB);
            PG8_WAIT_V(6); PG8_BAR; PG8_MMA(1, 1, At, B1); PG8_BAR;
            }
        }
        if constexpr (ALIGN_EPI) { if (wr == 0) PG8_BAR; }
        if constexpr (!Epi::AFTER_DRAIN) { E(acc, cur, wr, wc, fr, fq); S.done(cur); }
        if (!has_next) break;
#pragma unroll
        for (int a = 0; a < 2; ++a)
#pragma unroll
            for (int b = 0; b < 2; ++b)
#pragma unroll
                for (int m = 0; m < 4; ++m)
#pragma unroll
                    for (int n = 0; n < 2; ++n) acc[a][b][m][n] = (f32x4){0.f, 0.f, 0.f, 0.f};
        cur = nxt; cA = nA; cB = nB; ++ui;
        if constexpr (ALIGN_EPI) { if (wr == 1) PG8_BAR; }
    }
    PG8_WAIT_V(0);
    if constexpr (!ALIGN_EPI) { if (wr == 0) PG8_BAR; }
    PG8_BAR;
    if constexpr (Epi::AFTER_DRAIN) { E.fused(acc, cur, wr, wc, fr, fq, lds, wid, lane); S.done(cur); }
#undef PG8_SA
#undef PG8_SB
#undef PG8_STAGE
#undef PG8_LDA
#undef PG8_LDB
#undef PG8_MMA
#undef PG8_WAIT_V
#undef PG8_WAIT_L
#undef PG8_BAR
#undef PG8_SCHED
}
}

namespace att {
typedef unsigned short bf16_t;
typedef short bf16x8 __attribute__((ext_vector_type(8)));
typedef short s16x4 __attribute__((ext_vector_type(4)));
typedef float f32x16 __attribute__((ext_vector_type(16)));
typedef float f32x4 __attribute__((ext_vector_type(4)));
typedef unsigned u32x4 __attribute__((ext_vector_type(4)));
constexpr int D = 128, NW = 8, QBLK = 32, KVBLK = 64, QB = NW * QBLK;
constexpr int SHM_V = KVBLK * D * 2, SHM_K = KVBLK * D * 2;
constexpr int LDS_BYTES = 2 * SHM_V + 2 * SHM_K + NW * 64 * 4;
constexpr float THR = 8.f;
constexpr int W = 129;

#define KSWZ(row, colB) ((row) * 256 + ((colB) ^ (((row) & 7) << 4)))
#define SBAR() __builtin_amdgcn_sched_barrier(0)
__device__ __forceinline__ int v_st(int k, int c) { const int kk = (k & ~0xC) | ((k & 4) << 1) | ((k & 8) >> 1); return ((kk >> 3) * 4 + (c >> 5)) * 512 + ((kk & 7) * 32 + (c & 31)) * 2; }
__device__ __forceinline__ int v_rd_base(int lane) { return ((lane & 3) << 3) | (((lane >> 2) & 3) << 6) | (((lane >> 4) & 1) << 5) | (((lane >> 5) & 1) << 8); }
constexpr int v_rd_off(int d0, int ks, int half) { return d0 * 512 + ks * 4096 + half * 2048; }
__device__ __forceinline__ int crow(int r, int hi) { return (r & 3) + 8 * (r >> 2) + 4 * hi; }
__device__ __forceinline__ unsigned cvtpk(float lo, float hi) { unsigned r; asm volatile("v_cvt_pk_bf16_f32 %0, %1, %2" : "=v"(r) : "v"(lo), "v"(hi)); return r; }
__device__ __forceinline__ bf16x8 load8(const bf16_t* p) { return *reinterpret_cast<const bf16x8*>(p); }
__device__ __forceinline__ void mask_tile(f32x16& p0, f32x16& p1, int dq, unsigned Wm) {
    const float NEG = -__builtin_inff();
#pragma unroll
    for (int r = 0; r < 16; ++r) {
        const int c = (r & 3) + 8 * (r >> 2);
        if ((unsigned)(dq - c) >= Wm) p0[r] = NEG;
        if ((unsigned)(dq - c - 32) >= Wm) p1[r] = NEG;
    }
}
__device__ __forceinline__ void partialSM(f32x16& p0, f32x16& p1, float& m_reg, float& mn, float& alpha) {
    float pmax = p0[0]; for (int r = 1; r < 16; ++r) pmax = fmaxf(pmax, p0[r]); for (int r = 0; r < 16; ++r) pmax = fmaxf(pmax, p1[r]);
    { auto rr = __builtin_amdgcn_permlane32_swap(__float_as_uint(pmax), __float_as_uint(pmax), false, false);
      pmax = fmaxf(__uint_as_float(rr[0]), __uint_as_float(rr[1])); }
    if (__builtin_expect(__all((pmax - m_reg) <= THR), 1)) { mn = m_reg; alpha = 1.f; }
    else { mn = fmaxf(m_reg, pmax); alpha = __builtin_amdgcn_exp2f(m_reg - mn); m_reg = mn; }
    for (int r = 0; r < 16; ++r) p0[r] = p0[r] - mn; for (int r = 0; r < 16; ++r) p1[r] = p1[r] - mn;
    for (int r = 0; r < 16; ++r) p0[r] = __builtin_amdgcn_exp2f(p0[r]);
}
__device__ __forceinline__ void finishSM(f32x16& p0, f32x16& p1, float alpha, float& l_reg, bf16x8& pa0, bf16x8& pa1, bf16x8& pa2, bf16x8& pa3) {
    for (int r = 0; r < 16; ++r) p1[r] = __builtin_amdgcn_exp2f(p1[r]);
    float ps = 0; for (int r = 0; r < 16; ++r) ps += p0[r]; for (int r = 0; r < 16; ++r) ps += p1[r];
    { auto rr = __builtin_amdgcn_permlane32_swap(__float_as_uint(ps), __float_as_uint(ps), false, false);
      ps = __uint_as_float(rr[0]) + __uint_as_float(rr[1]); }
    l_reg = l_reg * alpha + ps;
#define PK4(P, B_, OUT) do { unsigned a0 = cvtpk(P[B_+0], P[B_+1]), a1 = cvtpk(P[B_+2], P[B_+3]);                          \
        unsigned b0 = cvtpk(P[B_+4], P[B_+5]), b1 = cvtpk(P[B_+6], P[B_+7]);                                             \
        auto r0 = __builtin_amdgcn_permlane32_swap(a0, b0, false, false); auto r1 = __builtin_amdgcn_permlane32_swap(a1, b1, false, false); \
        u32x4 w = {r0[0], r1[0], r0[1], r1[1]}; OUT = *reinterpret_cast<bf16x8*>(&w); } while (0)
    PK4(p0, 0, pa0); PK4(p0, 8, pa1); PK4(p1, 0, pa2); PK4(p1, 8, pa3);
#undef PK4
}
template <int KB>
__device__ __forceinline__ void qkt(f32x16& p0, f32x16& p1, const char* K_lds, int r32, int hi, const bf16x8* qr, bool act) {
    if (!act) { const float NEG = -__builtin_inff();
#pragma unroll
        for (int r = 0; r < 16; ++r) { p0[r] = NEG; p1[r] = NEG; } return; }
    p0 = f32x16{}; p1 = f32x16{};
    const char* kb[4];
#pragma unroll
    for (int dd = 0; dd < 4; ++dd) kb[dd] = K_lds + KB * SHM_K + KSWZ(r32, (dd * 16 + hi * 8) * 2);
#pragma unroll
    for (int d0 = 0; d0 < 8; ++d0) { const char* a = kb[d0 & 3] + (d0 >> 2) * 128;
        bf16x8 b0 = *reinterpret_cast<const bf16x8*>(a);
        bf16x8 b1 = *reinterpret_cast<const bf16x8*>(a + 32 * 256);
        p0 = __builtin_amdgcn_mfma_f32_32x32x16_bf16(b0, qr[d0], p0, 0, 0, 0);
        p1 = __builtin_amdgcn_mfma_f32_32x32x16_bf16(b1, qr[d0], p1, 0, 0, 0); }
}
template <int VB>
__device__ __forceinline__ void pv_tile(f32x16* o, int vb0, bf16x8 pa0, bf16x8 pa1, bf16x8 pa2, bf16x8 pa3, bool act) {
    if (!act) return;
#define TRRD(dst, off) asm volatile("ds_read_b64_tr_b16 %0, %1 offset:%2" : "=&v"(dst) : "v"(vb0), "i"(off) : "memory")
#define PV_D0(d0) do { s16x4 l0, l1, l2, l3, h0, h1, h2, h3; constexpr int b_ = VB * SHM_V + v_rd_off(d0, 0, 0);     \
        TRRD(l0, b_); TRRD(h0, b_ + 2048); TRRD(l1, b_ + 4096); TRRD(h1, b_ + 6144); TRRD(l2, b_ + 8192); TRRD(h2, b_ + 10240); TRRD(l3, b_ + 12288); TRRD(h3, b_ + 14336); \
        asm volatile("s_waitcnt lgkmcnt(0)" ::: "memory"); SBAR();                 \
        o[d0] = __builtin_amdgcn_mfma_f32_32x32x16_bf16(pa0, (bf16x8){l0[0], l0[1], l0[2], l0[3], h0[0], h0[1], h0[2], h0[3]}, o[d0], 0, 0, 0);   \
        o[d0] = __builtin_amdgcn_mfma_f32_32x32x16_bf16(pa1, (bf16x8){l1[0], l1[1], l1[2], l1[3], h1[0], h1[1], h1[2], h1[3]}, o[d0], 0, 0, 0);   \
        o[d0] = __builtin_amdgcn_mfma_f32_32x32x16_bf16(pa2, (bf16x8){l2[0], l2[1], l2[2], l2[3], h2[0], h2[1], h2[2], h2[3]}, o[d0], 0, 0, 0);   \
        o[d0] = __builtin_amdgcn_mfma_f32_32x32x16_bf16(pa3, (bf16x8){l3[0], l3[1], l3[2], l3[3], h3[0], h3[1], h3[2], h3[3]}, o[d0], 0, 0, 0); } while (0)
    PV_D0(0); PV_D0(1); PV_D0(2); PV_D0(3);
#undef PV_D0
#undef TRRD
}

struct BlockRef { const bf16_t* Q; const bf16_t* K; const bf16_t* V; bf16_t* O; float* L; int P0, pitch, lstride, skv; };
struct Seam { bf16x8 qr[8]; bf16x8 st_v0, st_v1, st_k0, st_k1; };
__device__ __forceinline__ int swa_jlo(int P0) { const int lowk = P0 - W + 1; return lowk > 0 ? lowk / KVBLK : 0; }
#define ROWP(p, pit, k0, rr) ((p) + (size_t)((k0) + (rr)) * (size_t)(pit) + sc)
#define VMW() asm volatile("s_waitcnt vmcnt(0)" ::: "memory")
#define VMWN(n) asm volatile("s_waitcnt vmcnt(%0)" :: "i"(n) : "memory")
#define SLOAD_H(Kp, Vp, pit, k0) do { S.st_v0 = load8(ROWP(Vp, pit, k0, sr)); S.st_v1 = load8(ROWP(Vp, pit, k0, 32 + sr));              \
                         S.st_k0 = load8(ROWP(Kp, pit, k0, sr)); S.st_k1 = load8(ROWP(Kp, pit, k0, 32 + sr)); } while (0)
#define SWRITE_HK(bf) do { *(bf16x8*)(K_lds + (bf) * SHM_K + kws) = S.st_k0; *(bf16x8*)(K_lds + (bf) * SHM_K + kws + 32 * 256) = S.st_k1; } while (0)
#define SWRITE_HV(bf) do { *(bf16x8*)(V_lds + (bf) * SHM_V + vst0) = S.st_v0; *(bf16x8*)(V_lds + (bf) * SHM_V + vst1) = S.st_v1; } while (0)
#define SWRITE_H(bf) do { SWRITE_HV(bf); SWRITE_HK(bf); } while (0)
__device__ __forceinline__ void swa_prime(const BlockRef& cur, char* lds, Seam& S) {
    int tid_ = threadIdx.x; asm volatile("" : "+v"(tid_));
    const int tid = tid_, wid = __builtin_amdgcn_readfirstlane(tid >> 6), lane = tid & 63, r32 = lane & 31, hi = lane >> 5;
    const int sr = tid >> 4, sc = (tid & 15) * 8, kws = KSWZ(sr, sc * 2); char* K_lds = lds + 2 * SHM_V;
    const int kb0 = swa_jlo(cur.P0) * KVBLK;
    for (int d0 = 0; d0 < 8; ++d0) S.qr[d0] = load8(cur.Q + (size_t)(wid * QBLK + r32) * (size_t)cur.pitch + d0 * 16 + hi * 8);
    SLOAD_H(cur.K, cur.V, cur.pitch, kb0); VMW(); SWRITE_HK(0);
    __syncthreads();
}
__device__ __forceinline__ void swa_block(const BlockRef& cur, const BlockRef& nxt, char* lds, Seam& S) {
    int tid_ = threadIdx.x; asm volatile("" : "+v"(tid_));
    const int tid = tid_, wid = __builtin_amdgcn_readfirstlane(tid >> 6), lane = tid & 63, r32 = lane & 31, hi = lane >> 5;
    const int j_lo = swa_jlo(cur.P0);
    int j_hi = (cur.P0 + QB - 1) / KVBLK + 1; if (j_hi > cur.skv / KVBLK) j_hi = cur.skv / KVBLK;
    const int NT = j_hi - j_lo;
    const int kbn = swa_jlo(nxt.P0) * KVBLK;
    const int qlo = cur.P0 + wid * QBLK, qm = qlo + r32 - 4 * hi;
    char* V_lds = lds; char* K_lds = lds + 2 * SHM_V;
    float* ws = (float*)(lds + 2 * SHM_V + 2 * SHM_K) + wid * 64; float* li_l = ws, * al_l = ws + 32;
    float m_reg = -1e30f, l_reg = 0; f32x16 o[4] = {};
    const int sr = tid >> 4, sc = (tid & 15) * 8, vst0 = v_st(sr, sc), vst1 = v_st(32 + sr, sc), kws = KSWZ(sr, sc * 2);
    const int vb0 = (int)(uintptr_t)V_lds + v_rd_base(lane);
    const bf16_t* Kh = cur.K; const bf16_t* Vh = cur.V; const int pit = cur.pitch;
#define RESC(a) do { if (__any((a) < 1.f)) { if (hi == 0) al_l[r32] = (a); asm volatile("s_waitcnt lgkmcnt(0)" ::: "memory");              \
                     for (int d_ = 0; d_ < 4; ++d_) for (int r = 0; r < 16; ++r) o[d_][r] *= al_l[crow(r, hi)]; } } while (0)
#define KBASE(t) ((j_lo + (t)) * KVBLK)
#define ACT(t) (KBASE(t) <= qlo + QBLK - 1 && KBASE(t) + KVBLK - 1 >= qlo - W + 1)
#define MASKT(P0_, P1_, t) do { const int kb_ = KBASE(t); if (ACT(t) && (kb_ + KVBLK - 1 > qlo || kb_ <= qlo + QBLK - 1 - W)) mask_tile(P0_, P1_, qm - kb_, (unsigned)W); } while (0)
    constexpr int NQL = 8;
#define SEAM_K0() do { VMWN(NQL); SWRITE_HK(0); SBAR(); } while (0)
    f32x16 pA0, pA1, pB0, pB1; float mnA, mnB, alA, alB; bf16x8 pa0, pa1, pa2, pa3;
    SWRITE_HV(0); SBAR();
    if (NT > 1) { SLOAD_H(Kh, Vh, pit, KBASE(1)); }
    SBAR(); qkt<0>(pA0, pA1, K_lds, r32, hi, S.qr, ACT(0));
    MASKT(pA0, pA1, 0); partialSM(pA0, pA1, m_reg, mnA, alA);
    if (NT > 1) { VMW(); SWRITE_H(1); }
    __syncthreads();
#define HALF_STEP(PX0, PX1, mnX, alX, PY0, PY1, alY, t, KB, VB, SB) do {                                                      \
        SBAR(); qkt<KB>(PX0, PX1, K_lds, r32, hi, S.qr, ACT(t));                                                 \
        finishSM(PY0, PY1, alY, l_reg, pa0, pa1, pa2, pa3); SBAR();                                                           \
        if ((t) + 1 < NT) { SLOAD_H(Kh, Vh, pit, KBASE((t) + 1)); SBAR(); }                                                   \
        pv_tile<VB>(o, vb0, pa0, pa1, pa2, pa3, ACT((t) - 1)); MASKT(PX0, PX1, (t)); partialSM(PX0, PX1, m_reg, mnX, alX);   \
        __syncthreads();                                                                                                      \
        if ((t) + 1 < NT) { VMW(); SWRITE_H(SB); }                                                                            \
        RESC(alX); __syncthreads(); } while (0)
    for (int t = 1; t + 1 < NT; t += 2) {
        HALF_STEP(pB0, pB1, mnB, alB, pA0, pA1, alA, t, 1, 0, 0);
        HALF_STEP(pA0, pA1, mnA, alA, pB0, pB1, alB, t + 1, 0, 1, 1);
    }
    const bool even = (NT & 1) == 0;
    if (even) { SBAR(); qkt<1>(pB0, pB1, K_lds, r32, hi, S.qr, ACT(NT - 1)); SBAR(); }
    SLOAD_H(nxt.K, nxt.V, nxt.pitch, kbn); SBAR();
#pragma unroll
    for (int d0 = 0; d0 < 8; ++d0) S.qr[d0] = load8(nxt.Q + (size_t)(wid * QBLK + r32) * (size_t)nxt.pitch + d0 * 16 + hi * 8);
    SBAR();
    finishSM(pA0, pA1, alA, l_reg, pa0, pa1, pa2, pa3); SBAR();
    pv_tile<0>(o, vb0, pa0, pa1, pa2, pa3, ACT(even ? NT - 2 : NT - 1));
    if (even) { MASKT(pB0, pB1, NT - 1); partialSM(pB0, pB1, m_reg, mnB, alB); __syncthreads(); RESC(alB);
        finishSM(pB0, pB1, alB, l_reg, pa0, pa1, pa2, pa3); SBAR(); pv_tile<1>(o, vb0, pa0, pa1, pa2, pa3, ACT(NT - 1)); }
    SBAR(); SEAM_K0();
    if (hi == 0) { li_l[r32] = l_reg; cur.L[(size_t)(wid * QBLK + r32) * (size_t)cur.lstride] = m_reg + __builtin_amdgcn_logf(l_reg); }
    asm volatile("s_waitcnt lgkmcnt(0)" ::: "memory");
    float rli[16];
#pragma unroll
    for (int r = 0; r < 16; ++r) rli[r] = __builtin_amdgcn_rcpf(li_l[crow(r, hi)]);
    bf16_t* Ow = cur.O + (size_t)(wid * QBLK) * (size_t)pit;
#pragma unroll
    for (int r = 0; r < 16; ++r) { const int orow = crow(r, hi);
#pragma unroll
        for (int d0 = 0; d0 < 4; ++d0) { const float v = o[d0][r] * rli[r];
            const float vn = __shfl_xor(v, 1);
            if ((r32 & 1) == 0) *(unsigned*)(Ow + (size_t)orow * (size_t)pit + d0 * 32 + r32) = cvtpk(v, vn); } }
    __syncthreads();
#undef RESC
#undef KBASE
#undef ACT
#undef MASKT
#undef SEAM_K0
#undef HALF_STEP
}
#undef ROWP
#undef VMW
#undef VMWN
#undef SLOAD_H
#undef SWRITE_HK
#undef SWRITE_HV
#undef SWRITE_H
#undef KSWZ
#undef SBAR
}

constexpr int NWAVES = 8;
constexpr int N_LAUNCHES = MK_N_LAUNCHES;
constexpr int PER_PHASE = 6;
constexpr int BATCH = 4, SEQ = 4096, DM = 2048, M = BATCH * SEQ;
constexpr int NH = 8, HD = 128, DATT = 1024, DPOOL = 1024, DIN = 6144;
constexpr float LN_EPS = 1e-5f;
constexpr float DN_ALPHA = 1.189207115002721f;
constexpr float QSCALE = 1.4426950408889634f * 0.08838834764831845f;

constexpr size_t MiB = 1u << 20;
constexpr size_t WS_CTL = 0, CTL_ZERO_BYTES = 64 * 1024;
constexpr size_t WS_ROPE = 1 * MiB;
constexpr size_t WS_WPT = 2 * MiB;
constexpr size_t WS_WOUT = 4 * MiB;
constexpr size_t WS_WIN = 12 * MiB;
constexpr size_t WS_XB = 36 * MiB;
constexpr size_t WS_QKV = 100 * MiB;
constexpr size_t WS_U = 196 * MiB;
constexpr size_t WS_G = 228 * MiB;
constexpr size_t WS_O = 292 * MiB;
constexpr size_t WS_L = 388 * MiB;
constexpr size_t WS_Y = 390 * MiB;
constexpr size_t WS_END = 454 * MiB;
constexpr int CW_BAR = 1024;

constexpr int RING_BYTES = 131072;
constexpr int LDSCTL_OFF = 143360, MISC_OFF = LDSCTL_OFF + 320;
constexpr int LDS_BYTES = 147456;

#define GAS __attribute__((address_space(1)))
#define LAS __attribute__((address_space(3)))
typedef unsigned short bf16;
typedef unsigned v4u __attribute__((ext_vector_type(4)));
typedef unsigned v2u __attribute__((ext_vector_type(2)));
typedef float f32x4 __attribute__((ext_vector_type(4)));
typedef short bf16x8 __attribute__((ext_vector_type(8)));
typedef GAS unsigned gu32;
#define RLX_AGENT __ATOMIC_RELAXED, __HIP_MEMORY_SCOPE_AGENT
#define LDS_WAIT() asm volatile("s_waitcnt lgkmcnt(0)" ::: "memory")
#define VM_WAIT() asm volatile("s_waitcnt vmcnt(0)" ::: "memory")
__device__ __forceinline__ unsigned pk2(float lo, float hi) { unsigned r; asm volatile("v_cvt_pk_bf16_f32 %0, %1, %2" : "=v"(r) : "v"(lo), "v"(hi)); return r; }
__device__ __forceinline__ float bf_lo(unsigned w) { return __uint_as_float(w << 16); }
__device__ __forceinline__ float bf_hi(unsigned w) { return __uint_as_float(w & 0xffff0000u); }
__device__ __forceinline__ float silu_f(float g) { return g * __builtin_amdgcn_rcpf(1.f + __builtin_amdgcn_exp2f(-1.4426950408889634f * g)); }

#define XB_TMO      128
#define XB_XCNT(j)  (256  + 64 * (j))
#define XB_XSUB(j)  (1280 + 64 * (j))
#define XB_XGEN(j)  (2304 + 64 * (j))
#define XB_TOP      3328
#define XB_TOPGEN   3392
#define XCD_BAR_WORDS 3456
#define XB_SPIN_CAP (1u << 18)

__device__ __forceinline__ unsigned xb_ld(unsigned* p)              { return __hip_atomic_load(p, __ATOMIC_RELAXED, __HIP_MEMORY_SCOPE_AGENT); }
__device__ __forceinline__ unsigned xb_add(unsigned* p, unsigned v) { return __hip_atomic_fetch_add(p, v, __ATOMIC_RELAXED, __HIP_MEMORY_SCOPE_AGENT); }
__device__ __forceinline__ unsigned xb_xcc_id() { return (unsigned)__builtin_amdgcn_s_getreg((3 << 11) | 20) & 0xFu; }
#define XB_SPIN(cond, bar) do { unsigned _sp = 0; while (cond) { __builtin_amdgcn_s_sleep(1); \
    if ((++_sp & 255u) == 0u) { if (xb_ld(&(bar)[XB_TMO])) break; if (_sp > XB_SPIN_CAP) { atomicAdd(&(bar)[XB_TMO], 1u); break; } } } } while (0)

struct XcdBarrier {
    unsigned* bar; unsigned x;
    volatile LAS unsigned* st;
};

__device__ __forceinline__ XcdBarrier xcd_barrier_post(unsigned* bar, volatile LAS unsigned* st) {
    XcdBarrier b; b.bar = bar; b.x = xb_xcc_id(); b.st = st;
    if (threadIdx.x == 0) (void)xb_add(&bar[XB_XCNT(b.x)], 1u);
    return b;
}
__device__ __forceinline__ void xcd_barrier_complete(unsigned* bar, unsigned x, unsigned& nloc, unsigned& nx) {
    const unsigned G = gridDim.x * gridDim.y * gridDim.z;
    unsigned sum, cnt, mine, sp = 0u;
    for (;;) {
        sum = 0u; cnt = 0u; mine = 0u;
#pragma unroll
        for (unsigned j = 0; j < 16; ++j) { const unsigned c = xb_ld(&bar[XB_XCNT(j)]); sum += c; cnt += (c > 0u) ? 1u : 0u; mine = (j == x) ? c : mine; }
        if (sum == G) break;
        __builtin_amdgcn_s_sleep(1);
        if ((++sp & 255u) == 0u) { if (xb_ld(&bar[XB_TMO])) break; if (sp > XB_SPIN_CAP) { atomicAdd(&bar[XB_TMO], 1u); break; } }
    }
    nloc = mine > 0u ? mine : 1u; nx = cnt > 0u ? cnt : 1u;
}

__device__ __forceinline__ void xcd_barrier(const XcdBarrier& b) {
    asm volatile("s_waitcnt vmcnt(0)" ::: "memory");
    __syncthreads();
    if (threadIdx.x == 0) {
        unsigned* bar = b.bar;
        __builtin_amdgcn_s_waitcnt(0);
        unsigned nloc = b.st[0], nx = b.st[1];
        if (nloc == 0u) { xcd_barrier_complete(bar, b.x, nloc, nx); b.st[0] = nloc; b.st[1] = nx; }
        const unsigned old = xb_add(&bar[XB_XSUB(b.x)], 1u);
        const unsigned gen = old / nloc;
        if (old + 1u == (gen + 1u) * nloc) {
            __builtin_amdgcn_fence(__ATOMIC_RELEASE, "agent");
            asm volatile("s_waitcnt vmcnt(0)" ::: "memory");
            const unsigned og = xb_add(&bar[XB_TOP], 1u);
            const unsigned tg = og / nx;
            if (og + 1u == (tg + 1u) * nx) xb_add(&bar[XB_TOPGEN], 1u);
            else XB_SPIN(xb_ld(&bar[XB_TOPGEN]) == tg, bar);
            __builtin_amdgcn_fence(__ATOMIC_ACQUIRE, "agent");
            xb_add(&bar[XB_XGEN(b.x)], 1u);
            asm volatile("s_waitcnt vmcnt(0)" ::: "memory");
        } else {
            XB_SPIN(xb_ld(&bar[XB_XGEN(b.x)]) == gen, bar);
            __builtin_amdgcn_fence(__ATOMIC_ACQUIRE, "agent");
            asm volatile("s_waitcnt vmcnt(0)" ::: "memory");
        }
    }
    __syncthreads();
}

__device__ __forceinline__ void p0_transpose_item(const float* W, int K, int N, bf16* WT, LAS float* scr, int item, int lane) {
    const int nblk = N / 32, kb = item / nblk, nb = item % nblk, k0 = 64 * kb, n0 = 32 * nb;
#pragma unroll 8
    for (int i = 0; i < 32; ++i) { const int kk = 2 * i + (lane >> 5); scr[kk * 33 + (lane & 31)] = W[(size_t)(k0 + kk) * N + n0 + (lane & 31)]; }
    LDS_WAIT(); asm volatile("" ::: "memory");
    const int c = lane & 7;
#pragma unroll
    for (int j = 0; j < 4; ++j) { const int n = (lane >> 3) + 8 * j; const LAS float* s = scr + (8 * c) * 33 + n;
        v4u o; o.x = pk2(s[0 * 33], s[1 * 33]); o.y = pk2(s[2 * 33], s[3 * 33]); o.z = pk2(s[4 * 33], s[5 * 33]); o.w = pk2(s[6 * 33], s[7 * 33]);
        *(GAS v4u*)(WT + (size_t)(n0 + n) * K + k0 + 8 * c) = o; }
    LDS_WAIT(); asm volatile("" ::: "memory");
}
__device__ __forceinline__ void sincos_pi(double r, double& s, double& c) {
    const double z = r * r;
    double ss = 0.0, cc = 0.0, term_s = r, term_c = 1.0;
#pragma unroll
    for (int k = 0; k < 16; ++k) { ss += term_s; cc += term_c; term_c = -term_c * z / (double)((2 * k + 1) * (2 * k + 2)); term_s = -term_s * z / (double)((2 * k + 2) * (2 * k + 3)); }
    s = ss; c = cc;
}
__device__ __forceinline__ void p0_prologue(LAS unsigned char* lds, const float* x, const float* w_in, const float* w_pool, const float* w_out, unsigned char* ws, int vcu, int G, int tid, int wave, int lane) {
    LAS float* scr = (LAS float*)(lds + wave * 16384);
    const int gw = vcu * NWAVES + wave, NGW = G * NWAVES;
    bf16* WinT = (bf16*)(ws + WS_WIN); bf16* WoutT = (bf16*)(ws + WS_WOUT); bf16* WpT = (bf16*)(ws + WS_WPT);
    constexpr int I_IN = (DM / 64) * (DIN / 32), I_OUT = (DM / 64) * (DM / 32), I_P = (256 / 64) * (256 / 32);
    constexpr int NITEMS = I_IN + I_OUT + 4 * I_P;
    for (int it = gw; it < NITEMS; it += NGW) {
        int r = it;
        if (r < I_IN) { p0_transpose_item(w_in, DM, DIN, WinT, scr, r, lane); continue; } r -= I_IN;
        if (r < I_OUT) { p0_transpose_item(w_out, DM, DM, WoutT, scr, r, lane); continue; } r -= I_OUT;
        const int g = r / I_P; r -= g * I_P;
        p0_transpose_item(w_pool + (size_t)g * 65536, 256, 256, WpT + (size_t)g * 65536, scr, r, lane);
    }
    {
        const size_t gt = (size_t)vcu * (NWAVES * 64) + tid, NT = (size_t)G * (NWAVES * 64);
        bf16* XB = (bf16*)(ws + WS_XB);
        for (size_t i = gt; i < (size_t)M * DM / 8; i += NT) {
            const f32x4 a = *(const GAS f32x4*)(x + i * 8), b = *(const GAS f32x4*)(x + i * 8 + 4);
            v4u o; o.x = pk2(a[0], a[1]); o.y = pk2(a[2], a[3]); o.z = pk2(b[0], b[1]); o.w = pk2(b[2], b[3]);
            *(GAS v4u*)(XB + i * 8) = o;
        }
        float* rope = (float*)(ws + WS_ROPE);
        for (size_t e = gt; e < 65536; e += NT) {
            const int i = (int)(e & 15), pos = (int)(e >> 4);
            double f;
            switch (i) { case 0: f = 1.0; break; case 1: f = 0.44036660267178046; break; case 2: f = 0.19392274474868576; break; case 3: f = 0.08539710028576561; break;
                case 4: f = 0.03760603093086393; break; case 5: f = 0.016560440080994446; break; case 6: f = 0.007292664737217109; break; case 7: f = 0.003211445994752591; break;
                case 8: f = 0.001414213562373095; break; case 9: f = 0.000622772421914596; break; case 10: f = 0.0002742481756762073; break; case 11: f = 0.00012076973741146504; break;
                case 12: f = 5.318295896944988e-05; break; case 13: f = 2.341999896140934e-05; break; case 14: f = 1.031338537721246e-05; break; default: f = 4.5416704806078695e-06; break; }
            const double ang = (double)pos * f;
            const double k = __builtin_rint(ang * 0.15915494309189535);
            const double r = __builtin_fma(-k, 2.4492935982947064e-16, __builtin_fma(-k, 6.283185307179586, ang));
            double s, c; sincos_pi(r, s, c);
            rope[e] = (float)c; rope[65536 + e] = (float)s;
        }
    }
}

__device__ __forceinline__ void pool_item(LAS unsigned char* lds, const bf16* U, const bf16* Gt, const bf16* WpT, const float* pool_scale, bf16* Y, int item, int tid, int wid, int lane) {
    const int g = item & 3, tile = item >> 2, tok0 = tile * 128, t0 = tok0 & 4095, w = 2 << g;
    LAS unsigned char* Ul = lds;
    LAS unsigned char* Al = lds + 73216;
    for (int c = tid; c < 143 * 32; c += NWAVES * 64) {
        const int lr = c >> 5, ch = c & 31, t = t0 - 15 + lr;
        v4u v = {0u, 0u, 0u, 0u};
        if (t >= 0) v = *(const GAS v4u*)(U + (size_t)(tok0 - 15 + lr) * 1024 + g * 256 + ch * 8);
        *(LAS v4u*)(Ul + lr * 512 + ch * 16) = v;
    }
    __syncthreads();
    {
        const int c4 = lane * 4, r0 = wid * 16;
        float s0 = 0.f, s1 = 0.f, s2 = 0.f, s3 = 0.f;
        for (int j = 1; j < w; ++j) { const v2u q = *(const LAS v2u*)(Ul + (r0 + 15 - j) * 512 + c4 * 2); s0 += bf_lo(q.x); s1 += bf_hi(q.x); s2 += bf_lo(q.y); s3 += bf_hi(q.y); }
        for (int i = 0; i < 16; ++i) {
            const int r = r0 + i;
            const v2u q = *(const LAS v2u*)(Ul + (r + 15) * 512 + c4 * 2);
            const float u0 = bf_lo(q.x), u1 = bf_hi(q.x), u2 = bf_lo(q.y), u3 = bf_hi(q.y);
            s0 += u0; s1 += u1; s2 += u2; s3 += u3;
            const int t = t0 + r, cnt = (t + 1 < w) ? t + 1 : w;
            const float inv = 1.f / (float)cnt;
            v2u o; o.x = pk2(s0 * inv - u0, s1 * inv - u1); o.y = pk2(s2 * inv - u2, s3 * inv - u3);
            *(LAS v2u*)(Al + r * 512 + (((c4 >> 3) ^ (r & 15)) << 4) + (c4 & 7) * 2) = o;
            const v2u qo = *(const LAS v2u*)(Ul + (r + 16 - w) * 512 + c4 * 2);
            s0 -= bf_lo(qo.x); s1 -= bf_hi(qo.x); s2 -= bf_lo(qo.y); s3 -= bf_hi(qo.y);
        }
    }
    __syncthreads();
    const int wr = wid >> 2, wc = wid & 3, fr = lane & 15, fq = lane >> 4;
    f32x4 acc[4][4];
#pragma unroll
    for (int m = 0; m < 4; ++m)
#pragma unroll
        for (int n = 0; n < 4; ++n) acc[m][n] = (f32x4){0.f, 0.f, 0.f, 0.f};
    const bf16* Bg = WpT + (size_t)g * 65536;
#pragma unroll 2
    for (int ks = 0; ks < 8; ++ks) {
        bf16x8 a[4], b[4];
#pragma unroll
        for (int m = 0; m < 4; ++m) { const int row = wr * 64 + m * 16 + fr; a[m] = *(const LAS bf16x8*)(Al + row * 512 + (((ks * 4 + fq) ^ (row & 15)) << 4)); }
#pragma unroll
        for (int n = 0; n < 4; ++n) { const int col = wc * 64 + n * 16 + fr; b[n] = *(const GAS bf16x8*)(Bg + (size_t)col * 256 + ks * 32 + fq * 8); }
#pragma unroll
        for (int m = 0; m < 4; ++m)
#pragma unroll
            for (int n = 0; n < 4; ++n) acc[m][n] = __builtin_amdgcn_mfma_f32_16x16x32_bf16(b[n], a[m], acc[m][n], 0, 0, 0);
    }
#pragma unroll
    for (int m = 0; m < 4; ++m) {
        const size_t token = (size_t)(tok0 + wr * 64 + m * 16 + fr);
#pragma unroll
        for (int n = 0; n < 4; ++n) {
            const int col = g * 256 + wc * 64 + n * 16 + 4 * fq;
            const v2u gt = *(const GAS v2u*)(Gt + token * 2048 + 1024 + col);
            const f32x4 sc = *(const GAS f32x4*)(pool_scale + col);
            const f32x4 v = acc[m][n];
            v2u o; o.x = pk2(v[0] * sc[0] * silu_f(bf_lo(gt.x)), v[1] * sc[1] * silu_f(bf_hi(gt.x))); o.y = pk2(v[2] * sc[2] * silu_f(bf_lo(gt.y)), v[3] * sc[3] * silu_f(bf_hi(gt.y)));
            *(GAS v2u*)(Y + token * 2048 + 1024 + col) = o;
        }
    }
    __syncthreads();
}

__device__ __forceinline__ void combine_phase(const bf16* O, const float* L, const bf16* Gt, bf16* Y, int vcu, int G, int tid) {
    const size_t gt = (size_t)vcu * (NWAVES * 64) + tid, NT = (size_t)G * (NWAVES * 64);
    constexpr size_t PST = (size_t)32 * 4096 * 128, LST = (size_t)32 * 4096;
    for (size_t idx = gt; idx < (size_t)32 * 4096 * 16; idx += NT) {
        const int c8 = (int)(idx & 15), t = (int)((idx >> 4) & 4095), bh = (int)(idx >> 16);
        const size_t oo = ((size_t)bh * 4096 + t) * 128 + c8 * 8, lo = (size_t)bh * 4096 + t;
        const v4u o1 = *(const GAS v4u*)(O + oo), o2 = *(const GAS v4u*)(O + PST + oo), o3 = *(const GAS v4u*)(O + 2 * PST + oo);
        const float l1 = L[lo], l2 = L[LST + lo], l3 = L[2 * LST + lo];
        const float mx = fmaxf(l1, fmaxf(l2, l3));
        float w1 = __builtin_amdgcn_exp2f(l1 - mx), w2 = __builtin_amdgcn_exp2f(l2 - mx), w3 = __builtin_amdgcn_exp2f(l3 - mx);
        const float inv = 1.f / (w1 + w2 + w3); w1 *= inv; w2 *= inv; w3 *= inv;
        const size_t yo = ((size_t)((bh >> 3) * 4096 + t)) * 2048 + (bh & 7) * 128 + c8 * 8;
        const v4u gv = *(const GAS v4u*)(Gt + yo);
        v4u out;
#define CMB(k) { const float a = (w1 * bf_lo(o1[k]) + w2 * bf_lo(o2[k]) + w3 * bf_lo(o3[k])) * silu_f(bf_lo(gv[k])); const float b = (w1 * bf_hi(o1[k]) + w2 * bf_hi(o2[k]) + w3 * bf_hi(o3[k])) * silu_f(bf_hi(gv[k])); out[k] = pk2(a, b); }
        CMB(0) CMB(1) CMB(2) CMB(3)
#undef CMB
        *(GAS v4u*)(Y + yo) = out;
    }
}

__device__ __forceinline__ void ln_phase(float* out, const float* gain, const float* bias, int vcu, int G, int wave, int lane) {
    const int gw = vcu * NWAVES + wave, NGW = G * NWAVES;
    for (int row = gw; row < M; row += NGW) {
        GAS f32x4* p = (GAS f32x4*)(out + (size_t)row * DM) + lane;
        f32x4 v[8]; float s = 0.f;
#pragma unroll
        for (int j = 0; j < 8; ++j) { v[j] = p[64 * j]; s += (v[j][0] + v[j][1]) + (v[j][2] + v[j][3]); }
#pragma unroll
        for (int o = 1; o < 64; o <<= 1) s += __shfl_xor(s, o);
        const float mean = s * (1.f / DM); float q = 0.f;
#pragma unroll
        for (int j = 0; j < 8; ++j) { v[j] = v[j] - mean; q += (v[j][0] * v[j][0] + v[j][1] * v[j][1]) + (v[j][2] * v[j][2] + v[j][3] * v[j][3]); }
#pragma unroll
        for (int o = 1; o < 64; o <<= 1) q += __shfl_xor(q, o);
        const float rstd = 1.f / sqrtf(q * (1.f / DM) + LN_EPS);
#pragma unroll
        for (int j = 0; j < 8; ++j) { const f32x4 gn = *((const GAS f32x4*)gain + lane + 64 * j), bs = *((const GAS f32x4*)bias + lane + 64 * j); p[64 * j] = v[j] * rstd * gn + bs; }
    }
}

struct Args { const float* x; const float* w_in; const float* w_pool; const float* pool_scale; const float* w_out; const float* ln_gain; const float* ln_bias; float* out; unsigned char* ws; int ph_lo, ph_hi; };
__global__ void __launch_bounds__(NWAVES * 64, 2) hybrid_fwd(Args args) {
    extern __shared__ __attribute__((aligned(16))) unsigned char lds_raw[];
    LAS unsigned char* lds = (LAS unsigned char*)lds_raw;
    volatile LAS unsigned* MISC = (volatile LAS unsigned*)(lds + MISC_OFF);
    const int tid = threadIdx.x, lane = tid & 63, wave = __builtin_amdgcn_readfirstlane(tid >> 6);
    const int G = gridDim.x; const int bx = blockIdx.x; const int vcu = (G % 8 == 0) ? (bx % 8) * (G / 8) + bx / 8 : bx;
    unsigned char* ws = args.ws;
    gu32* ctl = (gu32*)(ws + WS_CTL);
    for (int u = tid; u < (LDS_BYTES - LDSCTL_OFF) / 4; u += NWAVES * 64) ((LAS unsigned*)(lds + LDSCTL_OFF))[u] = 0u;
    __syncthreads();
    XcdBarrier bar; bar.bar = (unsigned*)(ctl + CW_BAR); bar.x = 0; bar.st = nullptr;
    if (N_LAUNCHES != PER_PHASE) bar = xcd_barrier_post((unsigned*)(ctl + CW_BAR), MISC + 8);
#define GRID_BAR() do { if (N_LAUNCHES != PER_PHASE) xcd_barrier(bar); } while (0)
    const int lo = args.ph_lo, hi = args.ph_hi;
#define IN(k) (lo <= (k) && (k) < hi)
#define BOTH(k) (IN(k) && IN((k) + 1))
    bf16* XB = (bf16*)(ws + WS_XB); bf16* WinT = (bf16*)(ws + WS_WIN); bf16* WoutT = (bf16*)(ws + WS_WOUT); bf16* WpT = (bf16*)(ws + WS_WPT);
    bf16* QKV = (bf16*)(ws + WS_QKV); bf16* Ub = (bf16*)(ws + WS_U); bf16* Gb = (bf16*)(ws + WS_G); bf16* Ob = (bf16*)(ws + WS_O); float* Lb = (float*)(ws + WS_L); bf16* Yb = (bf16*)(ws + WS_Y);
    float* rope = (float*)(ws + WS_ROPE);

    if (IN(0)) { int t_ = threadIdx.x; asm volatile("" : "+v"(t_)); p0_prologue(lds, args.x, args.w_in, args.w_pool, args.w_out, ws, vcu, G, t_, __builtin_amdgcn_readfirstlane(t_ >> 6), t_ & 63); if (BOTH(0)) GRID_BAR(); }

    if (IN(1)) {
        pg8::Gemm g{XB, WinT, M, DIN, DM}; pg8::StaticOrder S; S.init(M, DIN, G, bx);
        pg8::EpiH E{QKV, Ub, Gb, rope, QSCALE};
        pg8::gemm_phase<pg8::EpiH, pg8::StaticOrder, true, true>(lds, g, S, E);
        if (BOTH(1)) GRID_BAR();
    }

    if (IN(2)) {
        if (G == 256) {
            const int bh = vcu >> 3, j = vcu & 7;
            const bf16* Qh = QKV + (size_t)bh * 4096 * 128; const bf16* Kh = Qh + (size_t)32 * 4096 * 128; const bf16* Vh = Kh + (size_t)32 * 4096 * 128;
            att::Seam S;
            att::BlockRef cur, nxt;
#define MKREF(R, i) do { const int i_ = (i); \
                if (i_ < 2) { const int qb = 2 * j + i_; const size_t off = (size_t)qb * 256 * 128; \
                    R.Q = Qh + off; R.K = Kh; R.V = Vh; R.O = Ob + (size_t)bh * 4096 * 128 + off; R.L = Lb + (size_t)bh * 4096 + qb * 256; R.P0 = qb * 256; R.pitch = 128; R.lstride = 1; R.skv = 4096; } \
                else if (i_ < 4) { const int e = 2 * j + (i_ - 2), res = e >> 2, qb = e & 3; const size_t off = (size_t)res * 128 + (size_t)qb * 256 * 512; \
                    R.Q = Qh + off; R.K = Kh + res * 128; R.V = Vh + res * 128; R.O = Ob + (size_t)(32 + bh) * 4096 * 128 + off; R.L = Lb + (size_t)(32 + bh) * 4096 + res + qb * 1024; R.P0 = qb * 256; R.pitch = 512; R.lstride = 4; R.skv = 1024; } \
                else { const int res = 2 * j + (i_ - 4); const size_t off = (size_t)res * 128; \
                    R.Q = Qh + off; R.K = Kh + off; R.V = Vh + off; R.O = Ob + (size_t)(64 + bh) * 4096 * 128 + off; R.L = Lb + (size_t)(64 + bh) * 4096 + res; R.P0 = 0; R.pitch = 2048; R.lstride = 16; R.skv = 256; } } while (0)
            MKREF(cur, 0);
            att::swa_prime(cur, (char*)lds_raw, S);
            for (int i = 0; i < 6; ++i) {
                if (i < 5) MKREF(nxt, i + 1); else nxt = cur;
                att::swa_block(cur, nxt, (char*)lds_raw, S);
                cur = nxt;
            }
#undef MKREF
        }
        VM_WAIT(); __syncthreads();
        { int t_ = threadIdx.x; asm volatile("" : "+v"(t_)); const int w_ = __builtin_amdgcn_readfirstlane(t_ >> 6);
          for (int it = vcu; it < 512; it += G) pool_item(lds, Ub, Gb, WpT, args.pool_scale, Yb, it, t_, w_, t_ & 63); }
        if (BOTH(2)) GRID_BAR();
    }

    if (IN(3)) { int t_ = threadIdx.x; asm volatile("" : "+v"(t_)); combine_phase(Ob, Lb, Gb, Yb, vcu, G, t_); if (BOTH(3)) GRID_BAR(); }

    if (IN(4)) {
        pg8::Gemm g{Yb, WoutT, M, DM, DM}; pg8::StaticOrder S; S.init(M, DM, G, bx);
        pg8::EpiZ E{args.x, args.out, DM, DN_ALPHA};
        pg8::gemm_phase<pg8::EpiZ, pg8::StaticOrder, true, true>(lds, g, S, E);
        if (BOTH(4)) GRID_BAR();
    }

    if (IN(5)) { int t_ = threadIdx.x; asm volatile("" : "+v"(t_)); ln_phase(args.out, args.ln_gain, args.ln_bias, vcu, G, __builtin_amdgcn_readfirstlane(t_ >> 6), t_ & 63); }
#undef IN
#undef BOTH
#undef GRID_BAR
}

extern "C" void kernel_launch(void* const* d_in, const int* in_sizes, int n_in, void* d_out, int out_size, void* d_ws, size_t ws_size, hipStream_t stream) {
    static int grid = 0;
    if (grid == 0) {
        if (n_in != 7 || in_sizes[0] != M * DM || out_size != M * DM || ws_size < WS_END) { fprintf(stderr, "kernel_launch: shape mismatch (n_in %d in0 %d out %d ws %zu)\n", n_in, n_in > 0 ? in_sizes[0] : -1, out_size, ws_size); grid = -1; return; }
        int dev = 0, cus = 0, per_cu = 0;
        if (hipGetDevice(&dev) != hipSuccess || hipDeviceGetAttribute(&cus, hipDeviceAttributeMultiprocessorCount, dev) != hipSuccess) { fprintf(stderr, "kernel_launch: device query failed\n"); grid = -1; return; }
        if (hipFuncSetAttribute((const void*)hybrid_fwd, hipFuncAttributeMaxDynamicSharedMemorySize, LDS_BYTES) != hipSuccess) { fprintf(stderr, "kernel_launch: hipFuncSetAttribute failed\n"); grid = -1; return; }
        if (hipOccupancyMaxActiveBlocksPerMultiprocessor(&per_cu, (const void*)hybrid_fwd, NWAVES * 64, LDS_BYTES) != hipSuccess || per_cu < 1)
            fprintf(stderr, "kernel_launch: note: occupancy query reports %d workgroups per CU\n", per_cu);
        (void)hipGetLastError();
        grid = cus;
        if (grid != 256) fprintf(stderr, "kernel_launch: %d CUs: the attention phase is dealt for 256 workgroups\n", grid);
    }
    if (grid < 0) return;
    if (hipMemsetAsync((char*)d_ws + WS_CTL, 0, CTL_ZERO_BYTES, stream) != hipSuccess) { fprintf(stderr, "kernel_launch: memset failed\n"); return; }
    Args a{};
    a.x = (const float*)d_in[0]; a.w_in = (const float*)d_in[1]; a.w_pool = (const float*)d_in[2]; a.pool_scale = (const float*)d_in[3];
    a.w_out = (const float*)d_in[4]; a.ln_gain = (const float*)d_in[5]; a.ln_bias = (const float*)d_in[6]; a.out = (float*)d_out; a.ws = (unsigned char*)d_ws;
    for (int li = 0; li < N_LAUNCHES; ++li) {
        a.ph_lo = (N_LAUNCHES == PER_PHASE) ? li : 0; a.ph_hi = (N_LAUNCHES == PER_PHASE) ? li + 1 : PER_PHASE;
        hipLaunchKernelGGL(hybrid_fwd, dim3(grid), dim3(NWAVES * 64), LDS_BYTES, stream, a);
        const hipError_t le = hipPeekAtLastError();
        if (le != hipSuccess) { fprintf(stderr, "kernel_launch: launch %d failed: %s\n", li, hipGetErrorName(le)); break; }
    }
}
```

```cpp
#include <hip/hip_runtime.h>
#include <cstdio>
#include <cstdint>

#ifndef MK_N_LAUNCHES
#define MK_N_LAUNCHES 1
#endif

namespace pg8 {
#define PG8_LAS __attribute__((address_space(3)))
typedef unsigned short bf16_t;
typedef short bf16x8 __attribute__((ext_vector_type(8)));
typedef float f32x4 __attribute__((ext_vector_type(4)));
typedef unsigned u32x4 __attribute__((ext_vector_type(4)));
constexpr int BM = 256, BK = 64, HALF = 128, HTB = HALF * BK * 2  , STAGE_BYTES = 8 * HTB, NXCD = 8, WGM = 8;

__host__ __device__ __forceinline__ int lds_byte(int r, int c) { const int st = (r >> 4) * 2 + (c >> 5), rr = r & 15, cc = c & 31, ob = rr * 64 + cc * 2; return st * 1024 + (ob ^ (((ob >> 9) & 1) << 5)); }
__host__ __device__ __forceinline__ void stage_rc(int b, int& R, int& C) { const int st = b / 1024, sb = b % 1024, swz = sb ^ (((sb >> 9) & 1) << 5); R = (st >> 1) * 16 + swz / 64; C = (st & 1) * 32 + (swz % 64) / 2; }
__host__ __device__ __forceinline__ int perm32(int rho) { const int n = rho >> 4, i = rho & 15; return 8 * (i >> 2) + 4 * n + (i & 3); }

struct Unit { int pm, pn; };
struct Gemm { const bf16_t* A; const bf16_t* Bt; int M, N, K; };

struct StaticOrder {
    int nM, nN, nwg, G, c;
    __host__ __device__ void init(int M, int N, int G_, int c_) { nM = M / BM; nN = N / BM; nwg = nM * nN; G = G_; c = c_; }
    __host__ __device__ bool next(int i, Unit& u) const {
        const long L = (long)i * G + c; if (L >= nwg) return false;
        int wgid = (int)L; { const int q = nwg / NXCD, r = nwg % NXCD, xcd = wgid % NXCD, off = wgid / NXCD; wgid = (xcd < r ? xcd * (q + 1) : r * (q + 1) + (xcd - r) * q) + off; }
        const int nig = WGM * nN, gid = wgid / nig, fm = gid * WGM, gsz = (nM - fm) < WGM ? (nM - fm) : WGM;
        u.pm = fm + ((wgid % nig) % gsz); u.pn = (wgid % nig) / gsz; return true;
    }
    __device__ __forceinline__ void a_ready(const Unit&) const {}
    __device__ __forceinline__ void done(const Unit&) const {}
};


__device__ __forceinline__ unsigned cvt_pk_bf16(float lo, float hi) { unsigned r; asm volatile("v_cvt_pk_bf16_f32 %0, %1, %2" : "=v"(r) : "v"(lo), "v"(hi)); return r; }

struct EpiH {
    static constexpr bool PERM = true, AFTER_DRAIN = false;
    bf16_t* QKV;
    bf16_t* U;
    bf16_t* G;
    const float* rope;
    float qscale;
    __device__ __forceinline__ void operator()(const f32x4 (&acc)[2][2][4][2], const Unit& u, int wr, int wc, int fr, int fq) const {
        const int pn = u.pn, row0 = u.pm * BM + wr * 64 + fr;
        if (pn < 12) {
            const int which = pn >> 2;
            const bool rot = (which < 2) && (wc == 0);
            const float sc = (which == 0) ? qscale : 1.f;
            const float sgn = (fq < 2) ? -1.f : 1.f;
#pragma unroll
            for (int ai = 0; ai < 2; ++ai)
#pragma unroll
                for (int m = 0; m < 4; ++m) {
                    const int row = row0 + ai * HALF + m * 16, b = row >> 12, t = row & 4095;
                    f32x4 cs[2], sn[2];
                    if (rot) {
#pragma unroll
                        for (int n = 0; n < 2; ++n) { cs[n] = *(const f32x4*)(rope + t * 16 + 8 * (fq & 1) + 4 * n); sn[n] = *(const f32x4*)(rope + 65536 + t * 16 + 8 * (fq & 1) + 4 * n); }
                    }
#pragma unroll
                    for (int bj = 0; bj < 2; ++bj) {
                        const int head = 2 * (pn & 3) + bj;
                        f32x4 v[2] = {acc[ai][bj][m][0], acc[ai][bj][m][1]};
                        if (rot) {
#pragma unroll
                            for (int n = 0; n < 2; ++n)
#pragma unroll
                                for (int j = 0; j < 4; ++j) { const float own = v[n][j], oth = __shfl_xor(own, 32); v[n][j] = own * cs[n][j] + sgn * oth * sn[n][j]; }
                        }
                        u32x4 w; w.x = cvt_pk_bf16(v[0][0] * sc, v[0][1] * sc); w.y = cvt_pk_bf16(v[0][2] * sc, v[0][3] * sc); w.z = cvt_pk_bf16(v[1][0] * sc, v[1][1] * sc); w.w = cvt_pk_bf16(v[1][2] * sc, v[1][3] * sc);
                        *(u32x4*)(QKV + ((size_t)((which * 32 + b * 8 + head) * 4096 + t)) * 128 + wc * 32 + 8 * fq) = w;
                    }
                }
        } else {
            bf16_t* base; int ldc, colt;
            if (pn < 16) { base = U; ldc = 1024; colt = (pn - 12) * BM; } else { base = G; ldc = 2048; colt = (pn - 16) * BM; }
            const int col0 = colt + wc * 32 + 8 * fq;
#pragma unroll
            for (int ai = 0; ai < 2; ++ai)
#pragma unroll
                for (int m = 0; m < 4; ++m) { bf16_t* rowp = base + (size_t)(row0 + ai * HALF + m * 16) * ldc + col0;
#pragma unroll
                    for (int bj = 0; bj < 2; ++bj) { const f32x4 v0 = acc[ai][bj][m][0], v1 = acc[ai][bj][m][1];
                        u32x4 w; w.x = cvt_pk_bf16(v0[0], v0[1]); w.y = cvt_pk_bf16(v0[2], v0[3]); w.z = cvt_pk_bf16(v1[0], v1[1]); w.w = cvt_pk_bf16(v1[2], v1[3]);
                        *(u32x4*)(rowp + bj * HALF) = w; } }
        }
    }
};
struct EpiZ {
    static constexpr bool PERM = false, AFTER_DRAIN = false;
    const float* x; float* out; int ldc; float alpha;
    __device__ __forceinline__ void operator()(const f32x4 (&acc)[2][2][4][2], const Unit& u, int wr, int wc, int fr, int fq) const {
        const int row0 = u.pm * BM + wr * 64 + fr, col0 = u.pn * BM + wc * 32 + 4 * fq;
#pragma unroll
        for (int ai = 0; ai < 2; ++ai)
#pragma unroll
            for (int m = 0; m < 4; ++m) { const size_t off = (size_t)(row0 + ai * HALF + m * 16) * ldc + col0;
#pragma unroll
                for (int bj = 0; bj < 2; ++bj)
#pragma unroll
                    for (int n = 0; n < 2; ++n) { const f32x4 xv = *(const f32x4*)(x + off + bj * HALF + n * 16); *(f32x4*)(out + off + bj * HALF + n * 16) = xv * alpha + acc[ai][bj][m][n]; }
                if (m & 1) asm volatile("" ::: "memory"); }
    }
};

template <class Epi, class Sched, bool ALIGN_EPI = false, bool SP2 = false>
__device__ __forceinline__ void gemm_phase(PG8_LAS unsigned char* lds, const Gemm g, const Sched& S, const Epi& E) {
    int tid_ = threadIdx.x; asm volatile("" : "+v"(tid_));
    const int tid = tid_, wid = __builtin_amdgcn_readfirstlane(tid >> 6), lane = tid & 63, wr = wid >> 2, wc = wid & 3, fr = lane & 15, fq = lane >> 4;
    const int K = g.K, nt = K / BK;
    unsigned voffA[2], voffB[2];
#pragma unroll
    for (int i = 0; i < 2; ++i) { int R, C; stage_rc(tid * 16 + i * 8192, R, C); const int Rb = Epi::PERM ? ((R & ~31) + perm32(R & 31)) : R;
        voffA[i] = (unsigned)(R * K + C) * 2u; voffB[i] = (unsigned)(Rb * K + C) * 2u; }
    const size_t kstep = (size_t)(BK * 2);
    const size_t hstep = (size_t)HALF * K * 2;
    const size_t tstep = 2 * hstep;
    const unsigned ldsw = (unsigned)wid * 1024u;
    const int aoff = lds_byte(wr * 64 + fr, fq * 8), boff = lds_byte(wc * 32 + fr, fq * 8);
#define PG8_SA(b, h) (((b) * 2 + (h)) * HTB)
#define PG8_SB(b, h) ((4 + (b) * 2 + (h)) * HTB)
#define PG8_STAGE(bufoff, gbase, voff) do { _Pragma("unroll") for (int _i = 0; _i < 2; ++_i) \
        __builtin_amdgcn_global_load_lds((const unsigned*)((const char*)(gbase) + (voff)[_i]), (PG8_LAS unsigned*)(lds + (bufoff) + ldsw + _i * 8192), 16, 0, 0); } while (0)
#define PG8_LDA(dst, b, h) do { _Pragma("unroll") for (int m = 0; m < 4; ++m) _Pragma("unroll") for (int k = 0; k < 2; ++k) dst[m][k] = *(const PG8_LAS bf16x8*)(lds + PG8_SA(b, h) + aoff + m * 2048 + k * 1024); } while (0)
#define PG8_LDB(dst, b, h) do { _Pragma("unroll") for (int n = 0; n < 2; ++n) _Pragma("unroll") for (int k = 0; k < 2; ++k) dst[n][k] = *(const PG8_LAS bf16x8*)(lds + PG8_SB(b, h) + boff + n * 2048 + k * 1024); } while (0)
#define PG8_MMA(ai, bj, At, Bt) do { __builtin_amdgcn_s_setprio(1); _Pragma("unroll") for (int m = 0; m < 4; ++m) _Pragma("unroll") for (int n = 0; n < 2; ++n) _Pragma("unroll") for (int k = 0; k < 2; ++k) \
        acc[ai][bj][m][n] = __builtin_amdgcn_mfma_f32_16x16x32_bf16(Bt[n][k], At[m][k], acc[ai][bj][m][n], 0, 0, 0); __builtin_amdgcn_s_setprio(0); } while (0)
#define PG8_WAIT_V(n) asm volatile("s_waitcnt vmcnt(" #n ")" ::: "memory")
#define PG8_WAIT_L(n) asm volatile("s_waitcnt lgkmcnt(" #n ")" ::: "memory")
#define PG8_BAR __builtin_amdgcn_s_barrier()
#define PG8_SCHED __builtin_amdgcn_sched_barrier(0)
    Unit cur, nxt; int ui = 0;
    if (!S.next(0, cur)) return;
    f32x4 acc[2][2][4][2];
#pragma unroll
    for (int a = 0; a < 2; ++a)
#pragma unroll
        for (int b = 0; b < 2; ++b)
#pragma unroll
            for (int m = 0; m < 4; ++m)
#pragma unroll
                for (int n = 0; n < 2; ++n) acc[a][b][m][n] = (f32x4){0.f, 0.f, 0.f, 0.f};
    bf16x8 At[4][2], B0[2][2], B1[2][2];
    const char* cA = (const char*)g.A + (size_t)cur.pm * tstep; const char* cB = (const char*)g.Bt + (size_t)cur.pn * tstep;
    S.a_ready(cur);
    if constexpr (SP2) {
        PG8_STAGE(PG8_SB(0, 0), cB, voffB); PG8_STAGE(PG8_SB(0, 1), cB + hstep, voffB); PG8_STAGE(PG8_SA(0, 0), cA, voffA); PG8_STAGE(PG8_SA(0, 1), cA + hstep, voffA);
        if (wr == 1) PG8_BAR;
        PG8_WAIT_V(2); PG8_BAR;
        PG8_STAGE(PG8_SB(1, 0), cB + kstep, voffB); PG8_STAGE(PG8_SA(1, 0), cA + kstep, voffA); PG8_STAGE(PG8_SB(1, 1), cB + hstep + kstep, voffB);
        PG8_WAIT_V(6); PG8_BAR;
    } else {
        PG8_STAGE(PG8_SB(0, 0), cB, voffB); PG8_STAGE(PG8_SA(0, 0), cA, voffA); PG8_STAGE(PG8_SB(0, 1), cB + hstep, voffB); PG8_STAGE(PG8_SA(0, 1), cA + hstep, voffA);
        if (wr == 1) PG8_BAR;
        PG8_WAIT_V(4); PG8_BAR;
        PG8_STAGE(PG8_SB(1, 0), cB + kstep, voffB); PG8_STAGE(PG8_SA(1, 0), cA + kstep, voffA); PG8_STAGE(PG8_SB(1, 1), cB + hstep + kstep, voffB);
        PG8_WAIT_V(6); PG8_BAR;
    }
    for (;;) {
        const bool has_next = S.next(ui + 1, nxt);
        const char* nA = has_next ? (const char*)g.A + (size_t)nxt.pm * tstep : cA; const char* nB = has_next ? (const char*)g.Bt + (size_t)nxt.pn * tstep : cB;
        for (int t = 0; t < nt; t += 2) {
            const bool last = (t == nt - 2);
            const char* a1 = cA + (size_t)(t + 1) * kstep;
            const char* a2 = last ? nA : cA + (size_t)(t + 2) * kstep; const char* b2 = last ? nB : cB + (size_t)(t + 2) * kstep;
            const char* a3 = a2 + kstep; const char* b3 = b2 + kstep;
            if (last && has_next) S.a_ready(nxt);
            if constexpr (SP2) {
            PG8_LDB(B0, 0, 0); PG8_LDB(B1, 0, 1); PG8_SCHED; PG8_LDA(At, 0, 0); PG8_STAGE(PG8_SA(1, 1), a1 + hstep, voffA);
            PG8_WAIT_V(8); PG8_WAIT_L(0); PG8_BAR; PG8_MMA(0, 0, At, B0); PG8_MMA(0, 1, At, B1); PG8_BAR; PG8_SCHED;
            PG8_LDA(At, 0, 1); PG8_STAGE(PG8_SB(0, 0), b2, voffB); PG8_STAGE(PG8_SB(0, 1), b2 + hstep, voffB); PG8_STAGE(PG8_SA(0, 0), a2, voffA);
            PG8_WAIT_V(8); PG8_WAIT_L(0); PG8_BAR; PG8_MMA(1, 0, At, B0); PG8_MMA(1, 1, At, B1); PG8_BAR; PG8_SCHED;
            PG8_LDB(B0, 1, 0); PG8_LDB(B1, 1, 1); PG8_SCHED; PG8_LDA(At, 1, 0); PG8_STAGE(PG8_SA(0, 1), a2 + hstep, voffA);
            PG8_WAIT_V(8); PG8_WAIT_L(0); PG8_BAR; PG8_MMA(0, 0, At, B0); PG8_MMA(0, 1, At, B1); PG8_BAR; PG8_SCHED;
            PG8_LDA(At, 1, 1); PG8_STAGE(PG8_SB(1, 0), b3, voffB); PG8_STAGE(PG8_SB(1, 1), b3 + hstep, voffB); PG8_STAGE(PG8_SA(1, 0), a3, voffA);
            PG8_WAIT_V(8); PG8_WAIT_L(0); PG8_BAR; PG8_MMA(1, 0, At, B0); PG8_MMA(1, 1, At, B1); PG8_BAR; PG8_SCHED;
            } else {
            PG8_LDB(B0, 0, 0); PG8_SCHED; PG8_LDA(At, 0, 0); PG8_STAGE(PG8_SA(1, 1), a1 + hstep, voffA);
            PG8_WAIT_L(8); PG8_BAR; PG8_WAIT_L(0); PG8_MMA(0, 0, At, B0); PG8_BAR; PG8_SCHED;
            PG8_LDB(B1, 0, 1); PG8_STAGE(PG8_SB(0, 0), b2, voffB);
            PG8_BAR; PG8_WAIT_L(0); PG8_MMA(0, 1, At, B1); PG8_BAR;
            PG8_LDA(At, 0, 1); PG8_STAGE(PG8_SA(0, 0), a2, voffA);
            PG8_BAR; PG8_WAIT_L(0); PG8_MMA(1, 0, At, B0); PG8_BAR; PG8_SCHED;
            PG8_STAGE(PG8_SB(0, 1), b2 + hstep, voffB);
            PG8_WAIT_V(6); PG8_BAR; PG8_MMA(1, 1, At, B1); PG8_BAR;
            PG8_LDB(B0, 1, 0); PG8_SCHED; PG8_LDA(At, 1, 0); PG8_STAGE(PG8_SA(0, 1), a2 + hstep, voffA);
            PG8_WAIT_L(8); PG8_BAR; PG8_WAIT_L(0); PG8_MMA(0, 0, At, B0); PG8_BAR; PG8_SCHED;
            PG8_LDB(B1, 1, 1); PG8_STAGE(PG8_SB(1, 0), b3, voffB);
            PG8_BAR; PG8_WAIT_L(0); PG8_MMA(0, 1, At, B1); PG8_BAR;
            PG8_LDA(At, 1, 1); PG8_STAGE(PG8_SA(1, 0), a3, voffA);
            PG8_BAR; PG8_WAIT_L(0); PG8_MMA(1, 0, At, B0); PG8_BAR; PG8_SCHED;
            PG8_STAGE(PG8_SB(1, 1), b3 + hstep, voffB);
            PG8_WAIT_V(6); PG8_BAR; PG8_MMA(1, 1, At, B1); PG8_BAR;
            }
        }
        if constexpr (ALIGN_EPI) { if (wr == 0) PG8_BAR; }
        if constexpr (!Epi::AFTER_DRAIN) { E(acc, cur, wr, wc, fr, fq); S.done(cur); }
        if (!has_next) break;
#pragma unroll
        for (int a = 0; a < 2; ++a)
#pragma unroll
            for (int b = 0; b < 2; ++b)
#pragma unroll
                for (int m = 0; m < 4; ++m)
#pragma unroll
                    for (int n = 0; n < 2; ++n) acc[a][b][m][n] = (f32x4){0.f, 0.f, 0.f, 0.f};
        cur = nxt; cA = nA; cB = nB; ++ui;
        if constexpr (ALIGN_EPI) { if (wr == 1) PG8_BAR; }
    }
    PG8_WAIT_V(0);
    if constexpr (!ALIGN_EPI) { if (wr == 0) PG8_BAR; }
    PG8_BAR;
    if constexpr (Epi::AFTER_DRAIN) { E.fused(acc, cur, wr, wc, fr, fq, lds, wid, lane); S.done(cur); }
#undef PG8_SA
#undef PG8_SB
#undef PG8_STAGE
#undef PG8_LDA
#undef PG8_LDB
#undef PG8_MMA
#undef PG8_WAIT_V
#undef PG8_WAIT_L
#undef PG8_BAR
#undef PG8_SCHED
}
}

namespace att {
typedef unsigned short bf16_t;
typedef short bf16x8 __attribute__((ext_vector_type(8)));
typedef short s16x4 __attribute__((ext_vector_type(4)));
typedef float f32x16 __attribute__((ext_vector_type(16)));
typedef float f32x4 __attribute__((ext_vector_type(4)));
typedef unsigned u32x4 __attribute__((ext_vector_type(4)));
constexpr int D = 128, NW = 8, QBLK = 32, KVBLK = 64, QB = NW * QBLK;
constexpr int SHM_V = KVBLK * D * 2, SHM_K = KVBLK * D * 2;
constexpr int LDS_BYTES = 2 * SHM_V + 2 * SHM_K + NW * 64 * 4;
constexpr float THR = 8.f;
constexpr int W = 129;

#define KSWZ(row, colB) ((row) * 256 + ((colB) ^ (((row) & 7) << 4)))
#define SBAR() __builtin_amdgcn_sched_barrier(0)
__device__ __forceinline__ int v_st(int k, int c) { const int kk = (k & ~0xC) | ((k & 4) << 1) | ((k & 8) >> 1); return ((kk >> 3) * 4 + (c >> 5)) * 512 + ((kk & 7) * 32 + (c & 31)) * 2; }
__device__ __forceinline__ int v_rd_base(int lane) { return ((lane & 3) << 3) | (((lane >> 2) & 3) << 6) | (((lane >> 4) & 1) << 5) | (((lane >> 5) & 1) << 8); }
constexpr int v_rd_off(int d0, int ks, int half) { return d0 * 512 + ks * 4096 + half * 2048; }
__device__ __forceinline__ int crow(int r, int hi) { return (r & 3) + 8 * (r >> 2) + 4 * hi; }
__device__ __forceinline__ unsigned cvtpk(float lo, float hi) { unsigned r; asm volatile("v_cvt_pk_bf16_f32 %0, %1, %2" : "=v"(r) : "v"(lo), "v"(hi)); return r; }
__device__ __forceinline__ bf16x8 load8(const bf16_t* p) { return *reinterpret_cast<const bf16x8*>(p); }
__device__ __forceinline__ void mask_tile(f32x16& p0, f32x16& p1, int dq, unsigned Wm) {
    const float NEG = -__builtin_inff();
#pragma unroll
    for (int r = 0; r < 16; ++r) {
        const int c = (r & 3) + 8 * (r >> 2);
        if ((unsigned)(dq - c) >= Wm) p0[r] = NEG;
        if ((unsigned)(dq - c - 32) >= Wm) p1[r] = NEG;
    }
}
__device__ __forceinline__ void partialSM(f32x16& p0, f32x16& p1, float& m_reg, float& mn, float& alpha) {
    float pmax = p0[0]; for (int r = 1; r < 16; ++r) pmax = fmaxf(pmax, p0[r]); for (int r = 0; r < 16; ++r) pmax = fmaxf(pmax, p1[r]);
    { auto rr = __builtin_amdgcn_permlane32_swap(__float_as_uint(pmax), __float_as_uint(pmax), false, false);
      pmax = fmaxf(__uint_as_float(rr[0]), __uint_as_float(rr[1])); }
    if (__builtin_expect(__all((pmax - m_reg) <= THR), 1)) { mn = m_reg; alpha = 1.f; }
    else { mn = fmaxf(m_reg, pmax); alpha = __builtin_amdgcn_exp2f(m_reg - mn); m_reg = mn; }
    for (int r = 0; r < 16; ++r) p0[r] = p0[r] - mn; for (int r = 0; r < 16; ++r) p1[r] = p1[r] - mn;
    for (int r = 0; r < 16; ++r) p0[r] = __builtin_amdgcn_exp2f(p0[r]);
}
__device__ __forceinline__ void finishSM(f32x16& p0, f32x16& p1, float alpha, float& l_reg, bf16x8& pa0, bf16x8& pa1, bf16x8& pa2, bf16x8& pa3) {
    for (int r = 0; r < 16; ++r) p1[r] = __builtin_amdgcn_exp2f(p1[r]);
    float ps = 0; for (int r = 0; r < 16; ++r) ps += p0[r]; for (int r = 0; r < 16; ++r) ps += p1[r];
    { auto rr = __builtin_amdgcn_permlane32_swap(__float_as_uint(ps), __float_as_uint(ps), false, false);
      ps = __uint_as_float(rr[0]) + __uint_as_float(rr[1]); }
    l_reg = l_reg * alpha + ps;
#define PK4(P, B_, OUT) do { unsigned a0 = cvtpk(P[B_+0], P[B_+1]), a1 = cvtpk(P[B_+2], P[B_+3]);                          \
        unsigned b0 = cvtpk(P[B_+4], P[B_+5]), b1 = cvtpk(P[B_+6], P[B_+7]);                                             \
        auto r0 = __builtin_amdgcn_permlane32_swap(a0, b0, false, false); auto r1 = __builtin_amdgcn_permlane32_swap(a1, b1, false, false); \
        u32x4 w = {r0[0], r1[0], r0[1], r1[1]}; OUT = *reinterpret_cast<bf16x8*>(&w); } while (0)
    PK4(p0, 0, pa0); PK4(p0, 8, pa1); PK4(p1, 0, pa2); PK4(p1, 8, pa3);
#undef PK4
}
template <int KB>
__device__ __forceinline__ void qkt(f32x16& p0, f32x16& p1, const char* K_lds, int r32, int hi, const bf16x8* qr, bool act) {
    if (!act) { const float NEG = -__builtin_inff();
#pragma unroll
        for (int r = 0; r < 16; ++r) { p0[r] = NEG; p1[r] = NEG; } return; }
    p0 = f32x16{}; p1 = f32x16{};
    const char* kb[4];
#pragma unroll
    for (int dd = 0; dd < 4; ++dd) kb[dd] = K_lds + KB * SHM_K + KSWZ(r32, (dd * 16 + hi * 8) * 2);
#pragma unroll
    for (int d0 = 0; d0 < 8; ++d0) { const char* a = kb[d0 & 3] + (d0 >> 2) * 128;
        bf16x8 b0 = *reinterpret_cast<const bf16x8*>(a);
        bf16x8 b1 = *reinterpret_cast<const bf16x8*>(a + 32 * 256);
        p0 = __builtin_amdgcn_mfma_f32_32x32x16_bf16(b0, qr[d0], p0, 0, 0, 0);
        p1 = __builtin_amdgcn_mfma_f32_32x32x16_bf16(b1, qr[d0], p1, 0, 0, 0); }
}
template <int VB>
__device__ __forceinline__ void pv_tile(f32x16* o, int vb0, bf16x8 pa0, bf16x8 pa1, bf16x8 pa2, bf16x8 pa3, bool act) {
    if (!act) return;
#define TRRD(dst, off) asm volatile("ds_read_b64_tr_b16 %0, %1 offset:%2" : "=&v"(dst) : "v"(vb0), "i"(off) : "memory")
#define PV_D0(d0) do { s16x4 l0, l1, l2, l3, h0, h1, h2, h3; constexpr int b_ = VB * SHM_V + v_rd_off(d0, 0, 0);     \
        TRRD(l0, b_); TRRD(h0, b_ + 2048); TRRD(l1, b_ + 4096); TRRD(h1, b_ + 6144); TRRD(l2, b_ + 8192); TRRD(h2, b_ + 10240); TRRD(l3, b_ + 12288); TRRD(h3, b_ + 14336); \
        asm volatile("s_waitcnt lgkmcnt(0)" ::: "memory"); SBAR();                 \
        o[d0] = __builtin_amdgcn_mfma_f32_32x32x16_bf16(pa0, (bf16x8){l0[0], l0[1], l0[2], l0[3], h0[0], h0[1], h0[2], h0[3]}, o[d0], 0, 0, 0);   \
        o[d0] = __builtin_amdgcn_mfma_f32_32x32x16_bf16(pa1, (bf16x8){l1[0], l1[1], l1[2], l1[3], h1[0], h1[1], h1[2], h1[3]}, o[d0], 0, 0, 0);   \
        o[d0] = __builtin_amdgcn_mfma_f32_32x32x16_bf16(pa2, (bf16x8){l2[0], l2[1], l2[2], l2[3], h2[0], h2[1], h2[2], h2[3]}, o[d0], 0, 0, 0);   \
        o[d0] = __builtin_amdgcn_mfma_f32_32x32x16_bf16(pa3, (bf16x8){l3[0], l3[1], l3[2], l3[3], h3[0], h3[1], h3[2], h3[3]}, o[d0], 0, 0, 0); } while (0)
    PV_D0(0); PV_D0(1); PV_D0(2); PV_D0(3);
#undef PV_D0
#undef TRRD
}

struct BlockRef { const bf16_t* Q; const bf16_t* K; const bf16_t* V; bf16_t* O; float* L; int P0, pitch, lstride, skv; };
struct Seam { bf16x8 qr[8]; bf16x8 st_v0, st_v1, st_k0, st_k1; };
__device__ __forceinline__ int swa_jlo(int P0) { const int lowk = P0 - W + 1; return lowk > 0 ? lowk / KVBLK : 0; }
#define ROWP(p, pit, k0, rr) ((p) + (size_t)((k0) + (rr)) * (size_t)(pit) + sc)
#define VMW() asm volatile("s_waitcnt vmcnt(0)" ::: "memory")
#define VMWN(n) asm volatile("s_waitcnt vmcnt(%0)" :: "i"(n) : "memory")
#define SLOAD_H(Kp, Vp, pit, k0) do { S.st_v0 = load8(ROWP(Vp, pit, k0, sr)); S.st_v1 = load8(ROWP(Vp, pit, k0, 32 + sr));              \
                         S.st_k0 = load8(ROWP(Kp, pit, k0, sr)); S.st_k1 = load8(ROWP(Kp, pit, k0, 32 + sr)); } while (0)
#define SWRITE_HK(bf) do { *(bf16x8*)(K_lds + (bf) * SHM_K + kws) = S.st_k0; *(bf16x8*)(K_lds + (bf) * SHM_K + kws + 32 * 256) = S.st_k1; } while (0)
#define SWRITE_HV(bf) do { *(bf16x8*)(V_lds + (bf) * SHM_V + vst0) = S.st_v0; *(bf16x8*)(V_lds + (bf) * SHM_V + vst1) = S.st_v1; } while (0)
#define SWRITE_H(bf) do { SWRITE_HV(bf); SWRITE_HK(bf); } while (0)
__device__ __forceinline__ void swa_prime(const BlockRef& cur, char* lds, Seam& S) {
    int tid_ = threadIdx.x; asm volatile("" : "+v"(tid_));
    const int tid = tid_, wid = __builtin_amdgcn_readfirstlane(tid >> 6), lane = tid & 63, r32 = lane & 31, hi = lane >> 5;
    const int sr = tid >> 4, sc = (tid & 15) * 8, kws = KSWZ(sr, sc * 2); char* K_lds = lds + 2 * SHM_V;
    const int kb0 = swa_jlo(cur.P0) * KVBLK;
    for (int d0 = 0; d0 < 8; ++d0) S.qr[d0] = load8(cur.Q + (size_t)(wid * QBLK + r32) * (size_t)cur.pitch + d0 * 16 + hi * 8);
    SLOAD_H(cur.K, cur.V, cur.pitch, kb0); VMW(); SWRITE_HK(0);
    __syncthreads();
}
__device__ __forceinline__ void swa_block(const BlockRef& cur, const BlockRef& nxt, char* lds, Seam& S) {
    int tid_ = threadIdx.x; asm volatile("" : "+v"(tid_));
    const int tid = tid_, wid = __builtin_amdgcn_readfirstlane(tid >> 6), lane = tid & 63, r32 = lane & 31, hi = lane >> 5;
    const int j_lo = swa_jlo(cur.P0);
    int j_hi = (cur.P0 + QB - 1) / KVBLK + 1; if (j_hi > cur.skv / KVBLK) j_hi = cur.skv / KVBLK;
    const int NT = j_hi - j_lo;
    const int kbn = swa_jlo(nxt.P0) * KVBLK;
    const int qlo = cur.P0 + wid * QBLK, qm = qlo + r32 - 4 * hi;
    char* V_lds = lds; char* K_lds = lds + 2 * SHM_V;
    float* ws = (float*)(lds + 2 * SHM_V + 2 * SHM_K) + wid * 64; float* li_l = ws, * al_l = ws + 32;
    float m_reg = -1e30f, l_reg = 0; f32x16 o[4] = {};
    const int sr = tid >> 4, sc = (tid & 15) * 8, vst0 = v_st(sr, sc), vst1 = v_st(32 + sr, sc), kws = KSWZ(sr, sc * 2);
    const int vb0 = (int)(uintptr_t)V_lds + v_rd_base(lane);
    const bf16_t* Kh = cur.K; const bf16_t* Vh = cur.V; const int pit = cur.pitch;
#define RESC(a) do { if (__any((a) < 1.f)) { if (hi == 0) al_l[r32] = (a); asm volatile("s_waitcnt lgkmcnt(0)" ::: "memory");              \
                     for (int d_ = 0; d_ < 4; ++d_) for (int r = 0; r < 16; ++r) o[d_][r] *= al_l[crow(r, hi)]; } } while (0)
#define KBASE(t) ((j_lo + (t)) * KVBLK)
#define ACT(t) (KBASE(t) <= qlo + QBLK - 1 && KBASE(t) + KVBLK - 1 >= qlo - W + 1)
#define MASKT(P0_, P1_, t) do { const int kb_ = KBASE(t); if (ACT(t) && (kb_ + KVBLK - 1 > qlo || kb_ <= qlo + QBLK - 1 - W)) mask_tile(P0_, P1_, qm - kb_, (unsigned)W); } while (0)
    constexpr int NQL = 8;
#define SEAM_K0() do { VMWN(NQL); SWRITE_HK(0); SBAR(); } while (0)
    f32x16 pA0, pA1, pB0, pB1; float mnA, mnB, alA, alB; bf16x8 pa0, pa1, pa2, pa3;
    SWRITE_HV(0); SBAR();
    if (NT > 1) { SLOAD_H(Kh, Vh, pit, KBASE(1)); }
    SBAR(); qkt<0>(pA0, pA1, K_lds, r32, hi, S.qr, ACT(0));
    MASKT(pA0, pA1, 0); partialSM(pA0, pA1, m_reg, mnA, alA);
    if (NT > 1) { VMW(); SWRITE_H(1); }
    __syncthreads();
#define HALF_STEP(PX0, PX1, mnX, alX, PY0, PY1, alY, t, KB, VB, SB) do {                                                      \
        SBAR(); qkt<KB>(PX0, PX1, K_lds, r32, hi, S.qr, ACT(t));                                                 \
        finishSM(PY0, PY1, alY, l_reg, pa0, pa1, pa2, pa3); SBAR();                                                           \
        if ((t) + 1 < NT) { SLOAD_H(Kh, Vh, pit, KBASE((t) + 1)); SBAR(); }                                                   \
        pv_tile<VB>(o, vb0, pa0, pa1, pa2, pa3, ACT((t) - 1)); MASKT(PX0, PX1, (t)); partialSM(PX0, PX1, m_reg, mnX, alX);   \
        __syncthreads();                                                                                                      \
        if ((t) + 1 < NT) { VMW(); SWRITE_H(SB); }                                                                            \
        RESC(alX); __syncthreads(); } while (0)
    for (int t = 1; t + 1 < NT; t += 2) {
        HALF_STEP(pB0, pB1, mnB, alB, pA0, pA1, alA, t, 1, 0, 0);
        HALF_STEP(pA0, pA1, mnA, alA, pB0, pB1, alB, t + 1, 0, 1, 1);
    }
    const bool even = (NT & 1) == 0;
    if (even) { SBAR(); qkt<1>(pB0, pB1, K_lds, r32, hi, S.qr, ACT(NT - 1)); SBAR(); }
    SLOAD_H(nxt.K, nxt.V, nxt.pitch, kbn); SBAR();
#pragma unroll
    for (int d0 = 0; d0 < 8; ++d0) S.qr[d0] = load8(nxt.Q + (size_t)(wid * QBLK + r32) * (size_t)nxt.pitch + d0 * 16 + hi * 8);
    SBAR();
    finishSM(pA0, pA1, alA, l_reg, pa0, pa1, pa2, pa3); SBAR();
    pv_tile<0>(o, vb0, pa0, pa1, pa2, pa3, ACT(even ? NT - 2 : NT - 1));
    if (even) { MASKT(pB0, pB1, NT - 1); partialSM(pB0, pB1, m_reg, mnB, alB); __syncthreads(); RESC(alB);
        finishSM(pB0, pB1, alB, l_reg, pa0, pa1, pa2, pa3); SBAR(); pv_tile<1>(o, vb0, pa0, pa1, pa2, pa3, ACT(NT - 1)); }
    SBAR(); SEAM_K0();
    if (hi == 0) { li_l[r32] = l_reg; cur.L[(size_t)(wid * QBLK + r32) * (size_t)cur.lstride] = m_reg + __builtin_amdgcn_logf(l_reg); }
    asm volatile("s_waitcnt lgkmcnt(0)" ::: "memory");
    float rli[16];
#pragma unroll
    for (int r = 0; r < 16; ++r) rli[r] = __builtin_amdgcn_rcpf(li_l[crow(r, hi)]);
    bf16_t* Ow = cur.O + (size_t)(wid * QBLK) * (size_t)pit;
#pragma unroll
    for (int r = 0; r < 16; ++r) { const int orow = crow(r, hi);
#pragma unroll
        for (int d0 = 0; d0 < 4; ++d0) { const float v = o[d0][r] * rli[r];
            const float vn = __shfl_xor(v, 1);
            if ((r32 & 1) == 0) *(unsigned*)(Ow + (size_t)orow * (size_t)pit + d0 * 32 + r32) = cvtpk(v, vn); } }
    __syncthreads();
#undef RESC
#undef KBASE
#undef ACT
#undef MASKT
#undef SEAM_K0
#undef HALF_STEP
}
#undef ROWP
#undef VMW
#undef VMWN
#undef SLOAD_H
#undef SWRITE_HK
#undef SWRITE_HV
#undef SWRITE_H
#undef KSWZ
#undef SBAR
}

constexpr int NWAVES = 8;
constexpr int N_LAUNCHES = MK_N_LAUNCHES;
constexpr int PER_PHASE = 6;
constexpr int BATCH = 4, SEQ = 4096, DM = 2048, M = BATCH * SEQ;
constexpr int NH = 8, HD = 128, DATT = 1024, DPOOL = 1024, DIN = 6144;
constexpr float LN_EPS = 1e-5f;
constexpr float DN_ALPHA = 1.189207115002721f;
constexpr float QSCALE = 1.4426950408889634f * 0.08838834764831845f;

constexpr size_t MiB = 1u << 20;
constexpr size_t WS_CTL = 0, CTL_ZERO_BYTES = 64 * 1024;
constexpr size_t WS_ROPE = 1 * MiB;
constexpr size_t WS_WPT = 2 * MiB;
constexpr size_t WS_WOUT = 4 * MiB;
constexpr size_t WS_WIN = 12 * MiB;
constexpr size_t WS_XB = 36 * MiB;
constexpr size_t WS_QKV = 100 * MiB;
constexpr size_t WS_U = 196 * MiB;
constexpr size_t WS_G = 228 * MiB;
constexpr size_t WS_O = 292 * MiB;
constexpr size_t WS_L = 388 * MiB;
constexpr size_t WS_Y = 390 * MiB;
constexpr size_t WS_END = 454 * MiB;
constexpr int CW_BAR = 1024;

constexpr int RING_BYTES = 131072;
constexpr int LDSCTL_OFF = 143360, MISC_OFF = LDSCTL_OFF + 320;
constexpr int LDS_BYTES = 147456;

#define GAS __attribute__((address_space(1)))
#define LAS __attribute__((address_space(3)))
typedef unsigned short bf16;
typedef unsigned v4u __attribute__((ext_vector_type(4)));
typedef unsigned v2u __attribute__((ext_vector_type(2)));
typedef float f32x4 __attribute__((ext_vector_type(4)));
typedef short bf16x8 __attribute__((ext_vector_type(8)));
typedef GAS unsigned gu32;
#define RLX_AGENT __ATOMIC_RELAXED, __HIP_MEMORY_SCOPE_AGENT
#define LDS_WAIT() asm volatile("s_waitcnt lgkmcnt(0)" ::: "memory")
#define VM_WAIT() asm volatile("s_waitcnt vmcnt(0)" ::: "memory")
__device__ __forceinline__ unsigned pk2(float lo, float hi) { unsigned r; asm volatile("v_cvt_pk_bf16_f32 %0, %1, %2" : "=v"(r) : "v"(lo), "v"(hi)); return r; }
__device__ __forceinline__ float bf_lo(unsigned w) { return __uint_as_float(w << 16); }
__device__ __forceinline__ float bf_hi(unsigned w) { return __uint_as_float(w & 0xffff0000u); }
__device__ __forceinline__ float silu_f(float g) { return g * __builtin_amdgcn_rcpf(1.f + __builtin_amdgcn_exp2f(-1.4426950408889634f * g)); }

#define XB_TMO      128
#define XB_XCNT(j)  (256  + 64 * (j))
#define XB_XSUB(j)  (1280 + 64 * (j))
#define XB_XGEN(j)  (2304 + 64 * (j))
#define XB_TOP      3328
#define XB_TOPGEN   3392
#define XCD_BAR_WORDS 3456
#define XB_SPIN_CAP (1u << 18)

__device__ __forceinline__ unsigned xb_ld(unsigned* p)              { return __hip_atomic_load(p, __ATOMIC_RELAXED, __HIP_MEMORY_SCOPE_AGENT); }
__device__ __forceinline__ unsigned xb_add(unsigned* p, unsigned v) { return __hip_atomic_fetch_add(p, v, __ATOMIC_RELAXED, __HIP_MEMORY_SCOPE_AGENT); }
__device__ __forceinline__ unsigned xb_xcc_id() { return (unsigned)__builtin_amdgcn_s_getreg((3 << 11) | 20) & 0xFu; }
#define XB_SPIN(cond, bar) do { unsigned _sp = 0; while (cond) { __builtin_amdgcn_s_sleep(1); \
    if ((++_sp & 255u) == 0u) { if (xb_ld(&(bar)[XB_TMO])) break; if (_sp > XB_SPIN_CAP) { atomicAdd(&(bar)[XB_TMO], 1u); break; } } } } while (0)

struct XcdBarrier {
    unsigned* bar; unsigned x;
    volatile LAS unsigned* st;
};

__device__ __forceinline__ XcdBarrier xcd_barrier_post(unsigned* bar, volatile LAS unsigned* st) {
    XcdBarrier b; b.bar = bar; b.x = xb_xcc_id(); b.st = st;
    if (threadIdx.x == 0) (void)xb_add(&bar[XB_XCNT(b.x)], 1u);
    return b;
}
__device__ __forceinline__ void xcd_barrier_complete(unsigned* bar, unsigned x, unsigned& nloc, unsigned& nx) {
    const unsigned G = gridDim.x * gridDim.y * gridDim.z;
    unsigned sum, cnt, mine, sp = 0u;
    for (;;) {
        sum = 0u; cnt = 0u; mine = 0u;
#pragma unroll
        for (unsigned j = 0; j < 16; ++j) { const unsigned c = xb_ld(&bar[XB_XCNT(j)]); sum += c; cnt += (c > 0u) ? 1u : 0u; mine = (j == x) ? c : mine; }
        if (sum == G) break;
        __builtin_amdgcn_s_sleep(1);
        if ((++sp & 255u) == 0u) { if (xb_ld(&bar[XB_TMO])) break; if (sp > XB_SPIN_CAP) { atomicAdd(&bar[XB_TMO], 1u); break; } }
    }
    nloc = mine > 0u ? mine : 1u; nx = cnt > 0u ? cnt : 1u;
}

__device__ __forceinline__ void xcd_barrier(const XcdBarrier& b) {
    asm volatile("s_waitcnt vmcnt(0)" ::: "memory");
    __syncthreads();
    if (threadIdx.x == 0) {
        unsigned* bar = b.bar;
        __builtin_amdgcn_s_waitcnt(0);
        unsigned nloc = b.st[0], nx = b.st[1];
        if (nloc == 0u) { xcd_barrier_complete(bar, b.x, nloc, nx); b.st[0] = nloc; b.st[1] = nx; }
        const unsigned old = xb_add(&bar[XB_XSUB(b.x)], 1u);
        const unsigned gen = old / nloc;
        if (old + 1u == (gen + 1u) * nloc) {
            __builtin_amdgcn_fence(__ATOMIC_RELEASE, "agent");
            asm volatile("s_waitcnt vmcnt(0)" ::: "memory");
            const unsigned og = xb_add(&bar[XB_TOP], 1u);
            const unsigned tg = og / nx;
            if (og + 1u == (tg + 1u) * nx) xb_add(&bar[XB_TOPGEN], 1u);
            else XB_SPIN(xb_ld(&bar[XB_TOPGEN]) == tg, bar);
            __builtin_amdgcn_fence(__ATOMIC_ACQUIRE, "agent");
            xb_add(&bar[XB_XGEN(b.x)], 1u);
            asm volatile("s_waitcnt vmcnt(0)" ::: "memory");
        } else {
            XB_SPIN(xb_ld(&bar[XB_XGEN(b.x)]) == gen, bar);
            __builtin_amdgcn_fence(__ATOMIC_ACQUIRE, "agent");
            asm volatile("s_waitcnt vmcnt(0)" ::: "memory");
        }
    }
    __syncthreads();
}

__device__ __forceinline__ void p0_transpose_item(const float* W, int K, int N, bf16* WT, LAS float* scr, int item, int lane) {
    const int nblk = N / 32, kb = item / nblk, nb = item % nblk, k0 = 64 * kb, n0 = 32 * nb;
#pragma unroll 8
    for (int i = 0; i < 32; ++i) { const int kk = 2 * i + (lane >> 5); scr[kk * 33 + (lane & 31)] = W[(size_t)(k0 + kk) * N + n0 + (lane & 31)]; }
    LDS_WAIT(); asm volatile("" ::: "memory");
    const int c = lane & 7;
#pragma unroll
    for (int j = 0; j < 4; ++j) { const int n = (lane >> 3) + 8 * j; const LAS float* s = scr + (8 * c) * 33 + n;
        v4u o; o.x = pk2(s[0 * 33], s[1 * 33]); o.y = pk2(s[2 * 33], s[3 * 33]); o.z = pk2(s[4 * 33], s[5 * 33]); o.w = pk2(s[6 * 33], s[7 * 33]);
        *(GAS v4u*)(WT + (size_t)(n0 + n) * K + k0 + 8 * c) = o; }
    LDS_WAIT(); asm volatile("" ::: "memory");
}
__device__ __forceinline__ void sincos_pi(double r, double& s, double& c) {
    const double z = r * r;
    double ss = 0.0, cc = 0.0, term_s = r, term_c = 1.0;
#pragma unroll
    for (int k = 0; k < 16; ++k) { ss += term_s; cc += term_c; term_c = -term_c * z / (double)((2 * k + 1) * (2 * k + 2)); term_s = -term_s * z / (double)((2 * k + 2) * (2 * k + 3)); }
    s = ss; c = cc;
}
__device__ __forceinline__ void p0_prologue(LAS unsigned char* lds, const float* x, const float* w_in, const float* w_pool, const float* w_out, unsigned char* ws, int vcu, int G, int tid, int wave, int lane) {
    LAS float* scr = (LAS float*)(lds + wave * 16384);
    const int gw = vcu * NWAVES + wave, NGW = G * NWAVES;
    bf16* WinT = (bf16*)(ws + WS_WIN); bf16* WoutT = (bf16*)(ws + WS_WOUT); bf16* WpT = (bf16*)(ws + WS_WPT);
    constexpr int I_IN = (DM / 64) * (DIN / 32), I_OUT = (DM / 64) * (DM / 32), I_P = (256 / 64) * (256 / 32);
    constexpr int NITEMS = I_IN + I_OUT + 4 * I_P;
    for (int it = gw; it < NITEMS; it += NGW) {
        int r = it;
        if (r < I_IN) { p0_transpose_item(w_in, DM, DIN, WinT, scr, r, lane); continue; } r -= I_IN;
        if (r < I_OUT) { p0_transpose_item(w_out, DM, DM, WoutT, scr, r, lane); continue; } r -= I_OUT;
        const int g = r / I_P; r -= g * I_P;
        p0_transpose_item(w_pool + (size_t)g * 65536, 256, 256, WpT + (size_t)g * 65536, scr, r, lane);
    }
    {
        const size_t gt = (size_t)vcu * (NWAVES * 64) + tid, NT = (size_t)G * (NWAVES * 64);
        bf16* XB = (bf16*)(ws + WS_XB);
        for (size_t i = gt; i < (size_t)M * DM / 8; i += NT) {
            const f32x4 a = *(const GAS f32x4*)(x + i * 8), b = *(const GAS f32x4*)(x + i * 8 + 4);
            v4u o; o.x = pk2(a[0], a[1]); o.y = pk2(a[2], a[3]); o.z = pk2(b[0], b[1]); o.w = pk2(b[2], b[3]);
            *(GAS v4u*)(XB + i * 8) = o;
        }
        float* rope = (float*)(ws + WS_ROPE);
        for (size_t e = gt; e < 65536; e += NT) {
            const int i = (int)(e & 15), pos = (int)(e >> 4);
            double f;
            switch (i) { case 0: f = 1.0; break; case 1: f = 0.44036660267178046; break; case 2: f = 0.19392274474868576; break; case 3: f = 0.08539710028576561; break;
                case 4: f = 0.03760603093086393; break; case 5: f = 0.016560440080994446; break; case 6: f = 0.007292664737217109; break; case 7: f = 0.003211445994752591; break;
                case 8: f = 0.001414213562373095; break; case 9: f = 0.000622772421914596; break; case 10: f = 0.0002742481756762073; break; case 11: f = 0.00012076973741146504; break;
                case 12: f = 5.318295896944988e-05; break; case 13: f = 2.341999896140934e-05; break; case 14: f = 1.031338537721246e-05; break; default: f = 4.5416704806078695e-06; break; }
            const double ang = (double)pos * f;
            const double k = __builtin_rint(ang * 0.15915494309189535);
            const double r = __builtin_fma(-k, 2.4492935982947064e-16, __builtin_fma(-k, 6.283185307179586, ang));
            double s, c; sincos_pi(r, s, c);
            rope[e] = (float)c; rope[65536 + e] = (float)s;
        }
    }
}

__device__ __forceinline__ void pool_item(LAS unsigned char* lds, const bf16* U, const bf16* Gt, const bf16* WpT, const float* pool_scale, bf16* Y, int item, int tid, int wid, int lane) {
    const int g = item & 3, tile = item >> 2, tok0 = tile * 128, t0 = tok0 & 4095, w = 2 << g;
    LAS unsigned char* Ul = lds;
    LAS unsigned char* Al = lds + 73216;
    for (int c = tid; c < 143 * 32; c += NWAVES * 64) {
        const int lr = c >> 5, ch = c & 31, t = t0 - 15 + lr;
        v4u v = {0u, 0u, 0u, 0u};
        if (t >= 0) v = *(const GAS v4u*)(U + (size_t)(tok0 - 15 + lr) * 1024 + g * 256 + ch * 8);
        *(LAS v4u*)(Ul + lr * 512 + ch * 16) = v;
    }
    __syncthreads();
    {
        const int c4 = lane * 4, r0 = wid * 16;
        float s0 = 0.f, s1 = 0.f, s2 = 0.f, s3 = 0.f;
        for (int j = 1; j < w; ++j) { const v2u q = *(const LAS v2u*)(Ul + (r0 + 15 - j) * 512 + c4 * 2); s0 += bf_lo(q.x); s1 += bf_hi(q.x); s2 += bf_lo(q.y); s3 += bf_hi(q.y); }
        for (int i = 0; i < 16; ++i) {
            const int r = r0 + i;
            const v2u q = *(const LAS v2u*)(Ul + (r + 15) * 512 + c4 * 2);
            const float u0 = bf_lo(q.x), u1 = bf_hi(q.x), u2 = bf_lo(q.y), u3 = bf_hi(q.y);
            s0 += u0; s1 += u1; s2 += u2; s3 += u3;
            const int t = t0 + r, cnt = (t + 1 < w) ? t + 1 : w;
            const float inv = 1.f / (float)cnt;
            v2u o; o.x = pk2(s0 * inv - u0, s1 * inv - u1); o.y = pk2(s2 * inv - u2, s3 * inv - u3);
            *(LAS v2u*)(Al + r * 512 + (((c4 >> 3) ^ (r & 15)) << 4) + (c4 & 7) * 2) = o;
            const v2u qo = *(const LAS v2u*)(Ul + (r + 16 - w) * 512 + c4 * 2);
            s0 -= bf_lo(qo.x); s1 -= bf_hi(qo.x); s2 -= bf_lo(qo.y); s3 -= bf_hi(qo.y);
        }
    }
    __syncthreads();
    const int wr = wid >> 2, wc = wid & 3, fr = lane & 15, fq = lane >> 4;
    f32x4 acc[4][4];
#pragma unroll
    for (int m = 0; m < 4; ++m)
#pragma unroll
        for (int n = 0; n < 4; ++n) acc[m][n] = (f32x4){0.f, 0.f, 0.f, 0.f};
    const bf16* Bg = WpT + (size_t)g * 65536;
#pragma unroll 2
    for (int ks = 0; ks < 8; ++ks) {
        bf16x8 a[4], b[4];
#pragma unroll
        for (int m = 0; m < 4; ++m) { const int row = wr * 64 + m * 16 + fr; a[m] = *(const LAS bf16x8*)(Al + row * 512 + (((ks * 4 + fq) ^ (row & 15)) << 4)); }
#pragma unroll
        for (int n = 0; n < 4; ++n) { const int col = wc * 64 + n * 16 + fr; b[n] = *(const GAS bf16x8*)(Bg + (size_t)col * 256 + ks * 32 + fq * 8); }
#pragma unroll
        for (int m = 0; m < 4; ++m)
#pragma unroll
            for (int n = 0; n < 4; ++n) acc[m][n] = __builtin_amdgcn_mfma_f32_16x16x32_bf16(b[n], a[m], acc[m][n], 0, 0, 0);
    }
#pragma unroll
    for (int m = 0; m < 4; ++m) {
        const size_t token = (size_t)(tok0 + wr * 64 + m * 16 + fr);
#pragma unroll
        for (int n = 0; n < 4; ++n) {
            const int col = g * 256 + wc * 64 + n * 16 + 4 * fq;
            const v2u gt = *(const GAS v2u*)(Gt + token * 2048 + 1024 + col);
            const f32x4 sc = *(const GAS f32x4*)(pool_scale + col);
            const f32x4 v = acc[m][n];
            v2u o; o.x = pk2(v[0] * sc[0] * silu_f(bf_lo(gt.x)), v[1] * sc[1] * silu_f(bf_hi(gt.x))); o.y = pk2(v[2] * sc[2] * silu_f(bf_lo(gt.y)), v[3] * sc[3] * silu_f(bf_hi(gt.y)));
            *(GAS v2u*)(Y + token * 2048 + 1024 + col) = o;
        }
    }
    __syncthreads();
}

__device__ __forceinline__ void combine_phase(const bf16* O, const float* L, const bf16* Gt, bf16* Y, int vcu, int G, int tid) {
    const size_t gt = (size_t)vcu * (NWAVES * 64) + tid, NT = (size_t)G * (NWAVES * 64);
    constexpr size_t PST = (size_t)32 * 4096 * 128, LST = (size_t)32 * 4096;
    for (size_t idx = gt; idx < (size_t)32 * 4096 * 16; idx += NT) {
        const int c8 = (int)(idx & 15), t = (int)((idx >> 4) & 4095), bh = (int)(idx >> 16);
        const size_t oo = ((size_t)bh * 4096 + t) * 128 + c8 * 8, lo = (size_t)bh * 4096 + t;
        const v4u o1 = *(const GAS v4u*)(O + oo), o2 = *(const GAS v4u*)(O + PST + oo), o3 = *(const GAS v4u*)(O + 2 * PST + oo);
        const float l1 = L[lo], l2 = L[LST + lo], l3 = L[2 * LST + lo];
        const float mx = fmaxf(l1, fmaxf(l2, l3));
        float w1 = __builtin_amdgcn_exp2f(l1 - mx), w2 = __builtin_amdgcn_exp2f(l2 - mx), w3 = __builtin_amdgcn_exp2f(l3 - mx);
        const float inv = 1.f / (w1 + w2 + w3); w1 *= inv; w2 *= inv; w3 *= inv;
        const size_t yo = ((size_t)((bh >> 3) * 4096 + t)) * 2048 + (bh & 7) * 128 + c8 * 8;
        const v4u gv = *(const GAS v4u*)(Gt + yo);
        v4u out;
#define CMB(k) { const float a = (w1 * bf_lo(o1[k]) + w2 * bf_lo(o2[k]) + w3 * bf_lo(o3[k])) * silu_f(bf_lo(gv[k])); const float b = (w1 * bf_hi(o1[k]) + w2 * bf_hi(o2[k]) + w3 * bf_hi(o3[k])) * silu_f(bf_hi(gv[k])); out[k] = pk2(a, b); }
        CMB(0) CMB(1) CMB(2) CMB(3)
#undef CMB
        *(GAS v4u*)(Y + yo) = out;
    }
}

__device__ __forceinline__ void ln_phase(float* out, const float* gain, const float* bias, int vcu, int G, int wave, int lane) {
    const int gw = vcu * NWAVES + wave, NGW = G * NWAVES;
    for (int row = gw; row < M; row += NGW) {
        GAS f32x4* p = (GAS f32x4*)(out + (size_t)row * DM) + lane;
        f32x4 v[8]; float s = 0.f;
#pragma unroll
        for (int j = 0; j < 8; ++j) { v[j] = p[64 * j]; s += (v[j][0] + v[j][1]) + (v[j][2] + v[j][3]); }
#pragma unroll
        for (int o = 1; o < 64; o <<= 1) s += __shfl_xor(s, o);
        const float mean = s * (1.f / DM); float q = 0.f;
#pragma unroll
        for (int j = 0; j < 8; ++j) { v[j] = v[j] - mean; q += (v[j][0] * v[j][0] + v[j][1] * v[j][1]) + (v[j][2] * v[j][2] + v[j][3] * v[j][3]); }
#pragma unroll
        for (int o = 1; o < 64; o <<= 1) q += __shfl_xor(q, o);
        const float rstd = 1.f / sqrtf(q * (1.f / DM) + LN_EPS);
#pragma unroll
        for (int j = 0; j < 8; ++j) { const f32x4 gn = *((const GAS f32x4*)gain + lane + 64 * j), bs = *((const GAS f32x4*)bias + lane + 64 * j); p[64 * j] = v[j] * rstd * gn + bs; }
    }
}

struct Args { const float* x; const float* w_in; const float* w_pool; const float* pool_scale; const float* w_out; const float* ln_gain; const float* ln_bias; float* out; unsigned char* ws; int ph_lo, ph_hi; };
__global__ void __launch_bounds__(NWAVES * 64, 2) hybrid_fwd(Args args) {
    extern __shared__ __attribute__((aligned(16))) unsigned char lds_raw[];
    LAS unsigned char* lds = (LAS unsigned char*)lds_raw;
    volatile LAS unsigned* MISC = (volatile LAS unsigned*)(lds + MISC_OFF);
    const int tid = threadIdx.x, lane = tid & 63, wave = __builtin_amdgcn_readfirstlane(tid >> 6);
    const int G = gridDim.x; const int bx = blockIdx.x; const int vcu = (G % 8 == 0) ? (bx % 8) * (G / 8) + bx / 8 : bx;
    unsigned char* ws = args.ws;
    gu32* ctl = (gu32*)(ws + WS_CTL);
    for (int u = tid; u < (LDS_BYTES - LDSCTL_OFF) / 4; u += NWAVES * 64) ((LAS unsigned*)(lds + LDSCTL_OFF))[u] = 0u;
    __syncthreads();
    XcdBarrier bar; bar.bar = (unsigned*)(ctl + CW_BAR); bar.x = 0; bar.st = nullptr;
    if (N_LAUNCHES != PER_PHASE) bar = xcd_barrier_post((unsigned*)(ctl + CW_BAR), MISC + 8);
#define GRID_BAR() do { if (N_LAUNCHES != PER_PHASE) xcd_barrier(bar); } while (0)
    const int lo = args.ph_lo, hi = args.ph_hi;
#define IN(k) (lo <= (k) && (k) < hi)
#define BOTH(k) (IN(k) && IN((k) + 1))
    bf16* XB = (bf16*)(ws + WS_XB); bf16* WinT = (bf16*)(ws + WS_WIN); bf16* WoutT = (bf16*)(ws + WS_WOUT); bf16* WpT = (bf16*)(ws + WS_WPT);
    bf16* QKV = (bf16*)(ws + WS_QKV); bf16* Ub = (bf16*)(ws + WS_U); bf16* Gb = (bf16*)(ws + WS_G); bf16* Ob = (bf16*)(ws + WS_O); float* Lb = (float*)(ws + WS_L); bf16* Yb = (bf16*)(ws + WS_Y);
    float* rope = (float*)(ws + WS_ROPE);

    if (IN(0)) { int t_ = threadIdx.x; asm volatile("" : "+v"(t_)); p0_prologue(lds, args.x, args.w_in, args.w_pool, args.w_out, ws, vcu, G, t_, __builtin_amdgcn_readfirstlane(t_ >> 6), t_ & 63); if (BOTH(0)) GRID_BAR(); }

    if (IN(1)) {
        pg8::Gemm g{XB, WinT, M, DIN, DM}; pg8::StaticOrder S; S.init(M, DIN, G, bx);
        pg8::EpiH E{QKV, Ub, Gb, rope, QSCALE};
        pg8::gemm_phase<pg8::EpiH, pg8::StaticOrder, true, true>(lds, g, S, E);
        if (BOTH(1)) GRID_BAR();
    }

    if (IN(2)) {
        if (G == 256) {
            const int bh = vcu >> 3, j = vcu & 7;
            const bf16* Qh = QKV + (size_t)bh * 4096 * 128; const bf16* Kh = Qh + (size_t)32 * 4096 * 128; const bf16* Vh = Kh + (size_t)32 * 4096 * 128;
            att::Seam S;
            att::BlockRef cur, nxt;
#define MKREF(R, i) do { const int i_ = (i); \
                if (i_ < 2) { const int qb = 2 * j + i_; const size_t off = (size_t)qb * 256 * 128; \
                    R.Q = Qh + off; R.K = Kh; R.V = Vh; R.O = Ob + (size_t)bh * 4096 * 128 + off; R.L = Lb + (size_t)bh * 4096 + qb * 256; R.P0 = qb * 256; R.pitch = 128; R.lstride = 1; R.skv = 4096; } \
                else if (i_ < 4) { const int e = 2 * j + (i_ - 2), res = e >> 2, qb = e & 3; const size_t off = (size_t)res * 128 + (size_t)qb * 256 * 512; \
                    R.Q = Qh + off; R.K = Kh + res * 128; R.V = Vh + res * 128; R.O = Ob + (size_t)(32 + bh) * 4096 * 128 + off; R.L = Lb + (size_t)(32 + bh) * 4096 + res + qb * 1024; R.P0 = qb * 256; R.pitch = 512; R.lstride = 4; R.skv = 1024; } \
                else { const int res = 2 * j + (i_ - 4); const size_t off = (size_t)res * 128; \
                    R.Q = Qh + off; R.K = Kh + off; R.V = Vh + off; R.O = Ob + (size_t)(64 + bh) * 4096 * 128 + off; R.L = Lb + (size_t)(64 + bh) * 4096 + res; R.P0 = 0; R.pitch = 2048; R.lstride = 16; R.skv = 256; } } while (0)
            MKREF(cur, 0);
            att::swa_prime(cur, (char*)lds_raw, S);
            for (int i = 0; i < 6; ++i) {
                if (i < 5) MKREF(nxt, i + 1); else nxt = cur;
                att::swa_block(cur, nxt, (char*)lds_raw, S);
                cur = nxt;
            }
#undef MKREF
        }
        VM_WAIT(); __syncthreads();
        { int t_ = threadIdx.x; asm volatile("" : "+v"(t_)); const int w_ = __builtin_amdgcn_readfirstlane(t_ >> 6);
          for (int it = vcu; it < 512; it += G) pool_item(lds, Ub, Gb, WpT, args.pool_scale, Yb, it, t_, w_, t_ & 63); }
        if (BOTH(2)) GRID_BAR();
    }

    if (IN(3)) { int t_ = threadIdx.x; asm volatile("" : "+v"(t_)); combine_phase(Ob, Lb, Gb, Yb, vcu, G, t_); if (BOTH(3)) GRID_BAR(); }

    if (IN(4)) {
        pg8::Gemm g{Yb, WoutT, M, DM, DM}; pg8::StaticOrder S; S.init(M, DM, G, bx);
        pg8::EpiZ E{args.x, args.out, DM, DN_ALPHA};
        pg8::gemm_phase<pg8::EpiZ, pg8::StaticOrder, true, true>(lds, g, S, E);
        if (BOTH(4)) GRID_BAR();
    }

    if (IN(5)) { int t_ = threadIdx.x; asm volatile("" : "+v"(t_)); ln_phase(args.out, args.ln_gain, args.ln_bias, vcu, G, __builtin_amdgcn_readfirstlane(t_ >> 6), t_ & 63); }
#undef IN
#undef BOTH
#undef GRID_BAR
}

extern "C" void kernel_launch(void* const* d_in, const int* in_sizes, int n_in, void* d_out, int out_size, void* d_ws, size_t ws_size, hipStream_t stream) {
    static int grid = 0;
    if (grid == 0) {
        if (n_in != 7 || in_sizes[0] != M * DM || out_size != M * DM || ws_size < WS_END) { fprintf(stderr, "kernel_launch: shape mismatch (n_in %d in0 %d out %d ws %zu)\n", n_in, n_in > 0 ? in_sizes[0] : -1, out_size, ws_size); grid = -1; return; }
        int dev = 0, cus = 0, per_cu = 0;
        if (hipGetDevice(&dev) != hipSuccess || hipDeviceGetAttribute(&cus, hipDeviceAttributeMultiprocessorCount, dev) != hipSuccess) { fprintf(stderr, "kernel_launch: device query failed\n"); grid = -1; return; }
        if (hipFuncSetAttribute((const void*)hybrid_fwd, hipFuncAttributeMaxDynamicSharedMemorySize, LDS_BYTES) != hipSuccess) { fprintf(stderr, "kernel_launch: hipFuncSetAttribute failed\n"); grid = -1; return; }
        if (hipOccupancyMaxActiveBlocksPerMultiprocessor(&per_cu, (const void*)hybrid_fwd, NWAVES * 64, LDS_BYTES) != hipSuccess || per_cu < 1)
            fprintf(stderr, "kernel_launch: note: occupancy query reports %d workgroups per CU\n", per_cu);
        (void)hipGetLastError();
        grid = cus;
        if (grid != 256) fprintf(stderr, "kernel_launch: %d CUs: the attention phase is dealt for 256 workgroups\n", grid);
    }
    if (grid < 0) return;
    if (hipMemsetAsync((char*)d_ws + WS_CTL, 0, CTL_ZERO_BYTES, stream) != hipSuccess) { fprintf(stderr, "kernel_launch: memset failed\n"); return; }
    Args a{};
    a.x = (const float*)d_in[0]; a.w_in = (const float*)d_in[1]; a.w_pool = (const float*)d_in[2]; a.pool_scale = (const float*)d_in[3];
    a.w_out = (const float*)d_in[4]; a.ln_gain = (const float*)d_in[5]; a.ln_bias = (const float*)d_in[6]; a.out = (float*)d_out; a.ws = (unsigned char*)d_ws;
    for (int li = 0; li < N_LAUNCHES; ++li) {
        a.ph_lo = (N_LAUNCHES == PER_PHASE) ? li : 0; a.ph_hi = (N_LAUNCHES == PER_PHASE) ? li + 1 : PER_PHASE;
        hipLaunchKernelGGL(hybrid_fwd, dim3(grid), dim3(NWAVES * 64), LDS_BYTES, stream, a);
        const hipError_t le = hipPeekAtLastError();
        if (le != hipSuccess) { fprintf(stderr, "kernel_launch: launch %d failed: %s\n", li, hipGetErrorName(le)); break; }
    }
}
```

```cpp
#include <hip/hip_runtime.h>
#include <cstdio>
#include <cstdint>

#ifndef MK_N_LAUNCHES
#define MK_N_LAUNCHES 1
#endif

namespace pg8 {
#define PG8_LAS __attribute__((address_space(3)))
typedef unsigned short bf16_t;
typedef short bf16x8 __attribute__((ext_vector_type(8)));
typedef float f32x4 __attribute__((ext_vector_type(4)));
typedef unsigned u32x4 __attribute__((ext_vector_type(4)));
constexpr int BM = 256, BK = 64, HALF = 128, HTB = HALF * BK * 2  , STAGE_BYTES = 8 * HTB, NXCD = 8, WGM = 8;

__host__ __device__ __forceinline__ int lds_byte(int r, int c) { const int st = (r >> 4) * 2 + (c >> 5), rr = r & 15, cc = c & 31, ob = rr * 64 + cc * 2; return st * 1024 + (ob ^ (((ob >> 9) & 1) << 5)); }
__host__ __device__ __forceinline__ void stage_rc(int b, int& R, int& C) { const int st = b / 1024, sb = b % 1024, swz = sb ^ (((sb >> 9) & 1) << 5); R = (st >> 1) * 16 + swz / 64; C = (st & 1) * 32 + (swz % 64) / 2; }
__host__ __device__ __forceinline__ int perm32(int rho) { const int n = rho >> 4, i = rho & 15; return 8 * (i >> 2) + 4 * n + (i & 3); }

struct Unit { int pm, pn; };
struct Gemm { const bf16_t* A; const bf16_t* Bt; int M, N, K; };

struct StaticOrder {
    int nM, nN, nwg, G, c;
    __host__ __device__ void init(int M, int N, int G_, int c_) { nM = M / BM; nN = N / BM; nwg = nM * nN; G = G_; c = c_; }
    __host__ __device__ bool next(int i, Unit& u) const {
        const long L = (long)i * G + c; if (L >= nwg) return false;
        int wgid = (int)L; { const int q = nwg / NXCD, r = nwg % NXCD, xcd = wgid % NXCD, off = wgid / NXCD; wgid = (xcd < r ? xcd * (q + 1) : r * (q + 1) + (xcd - r) * q) + off; }
        const int nig = WGM * nN, gid = wgid / nig, fm = gid * WGM, gsz = (nM - fm) < WGM ? (nM - fm) : WGM;
        u.pm = fm + ((wgid % nig) % gsz); u.pn = (wgid % nig) / gsz; return true;
    }
    __device__ __forceinline__ void a_ready(const Unit&) const {}
    __device__ __forceinline__ void done(const Unit&) const {}
};


__device__ __forceinline__ unsigned cvt_pk_bf16(float lo, float hi) { unsigned r; asm volatile("v_cvt_pk_bf16_f32 %0, %1, %2" : "=v"(r) : "v"(lo), "v"(hi)); return r; }

struct EpiH {
    static constexpr bool PERM = true, AFTER_DRAIN = false, LNX = false;
    bf16_t* QKV;
    bf16_t* U;
    bf16_t* G;
    const float* rope;
    float qscale;
    __device__ __forceinline__ void operator()(const f32x4 (&acc)[2][2][4][2], const Unit& u, int wr, int wc, int fr, int fq) const {
        const int pn = u.pn, row0 = u.pm * BM + wr * 64 + fr;
        if (pn < 12) {
            const int which = pn >> 2;
            const bool rot = (which < 2) && (wc == 0);
            const float sc = (which == 0) ? qscale : 1.f;
            const float sgn = (fq < 2) ? -1.f : 1.f;
#pragma unroll
            for (int ai = 0; ai < 2; ++ai)
#pragma unroll
                for (int m = 0; m < 4; ++m) {
                    const int row = row0 + ai * HALF + m * 16, b = row >> 12, t = row & 4095;
                    f32x4 cs[2], sn[2];
                    if (rot) {
#pragma unroll
                        for (int n = 0; n < 2; ++n) { cs[n] = *(const f32x4*)(rope + t * 16 + 8 * (fq & 1) + 4 * n); sn[n] = *(const f32x4*)(rope + 65536 + t * 16 + 8 * (fq & 1) + 4 * n); }
                    }
#pragma unroll
                    for (int bj = 0; bj < 2; ++bj) {
                        const int head = 2 * (pn & 3) + bj;
                        f32x4 v[2] = {acc[ai][bj][m][0], acc[ai][bj][m][1]};
                        if (rot) {
#pragma unroll
                            for (int n = 0; n < 2; ++n)
#pragma unroll
                                for (int j = 0; j < 4; ++j) { const float own = v[n][j], oth = __shfl_xor(own, 32); v[n][j] = own * cs[n][j] + sgn * oth * sn[n][j]; }
                        }
                        u32x4 w; w.x = cvt_pk_bf16(v[0][0] * sc, v[0][1] * sc); w.y = cvt_pk_bf16(v[0][2] * sc, v[0][3] * sc); w.z = cvt_pk_bf16(v[1][0] * sc, v[1][1] * sc); w.w = cvt_pk_bf16(v[1][2] * sc, v[1][3] * sc);
                        *(u32x4*)(QKV + ((size_t)((which * 32 + b * 8 + head) * 4096 + t)) * 128 + wc * 32 + 8 * fq) = w;
                    }
                }
        } else {
            bf16_t* base; int ldc, colt;
            if (pn < 16) { base = U; ldc = 1024; colt = (pn - 12) * BM; } else { base = G; ldc = 2048; colt = (pn - 16) * BM; }
            const int col0 = colt + wc * 32 + 8 * fq;
#pragma unroll
            for (int ai = 0; ai < 2; ++ai)
#pragma unroll
                for (int m = 0; m < 4; ++m) { bf16_t* rowp = base + (size_t)(row0 + ai * HALF + m * 16) * ldc + col0;
#pragma unroll
                    for (int bj = 0; bj < 2; ++bj) { const f32x4 v0 = acc[ai][bj][m][0], v1 = acc[ai][bj][m][1];
                        u32x4 w; w.x = cvt_pk_bf16(v0[0], v0[1]); w.y = cvt_pk_bf16(v0[2], v0[3]); w.z = cvt_pk_bf16(v1[0], v1[1]); w.w = cvt_pk_bf16(v1[2], v1[3]);
                        *(u32x4*)(rowp + bj * HALF) = w; } }
        }
    }
};
struct EpiLN {
    static constexpr bool PERM = false, AFTER_DRAIN = false, LNX = true;
    const float* x; float* out; const float* gain; const float* bias; float alpha, eps;
    unsigned long long* xbuf;
    unsigned* cnt;
    typedef float f32x2v __attribute__((ext_vector_type(2)));
    __device__ __forceinline__ void lnx(f32x4 (&acc)[2][2][4][2], const Unit& u, bool last, int wr, int wc, int fr, int fq, PG8_LAS unsigned char* lx, int wid, int lane) const {
        PG8_LAS f32x2v* P = (PG8_LAS f32x2v*)lx;
        PG8_LAS f32x2v* S = (PG8_LAS f32x2v*)(lx + 8192);
        PG8_LAS f32x2v* T0 = (PG8_LAS f32x2v*)(lx + 10240);
        const int row0 = u.pm * BM + wr * 64 + fr, col0 = u.pn * BM + wc * 32 + 4 * fq;
#pragma unroll
        for (int ai = 0; ai < 2; ++ai)
#pragma unroll
            for (int m = 0; m < 4; ++m) { const size_t off = (size_t)(row0 + ai * HALF + m * 16) * 2048 + col0;
#pragma unroll
                for (int bj = 0; bj < 2; ++bj)
#pragma unroll
                    for (int n = 0; n < 2; ++n) { const f32x4 xv = *(const f32x4*)(x + off + bj * HALF + n * 16); acc[ai][bj][m][n] = xv * alpha + acc[ai][bj][m][n]; }
                asm volatile("" : "+v"(acc[ai][0][m][0]), "+v"(acc[ai][0][m][1]), "+v"(acc[ai][1][m][0]), "+v"(acc[ai][1][m][1]));
                if (m & 1) asm volatile("" ::: "memory"); }
#pragma unroll
        for (int ai = 0; ai < 2; ++ai)
#pragma unroll
            for (int m = 0; m < 4; ++m) {
                float s = 0.f;
#pragma unroll
                for (int bj = 0; bj < 2; ++bj)
#pragma unroll
                    for (int n = 0; n < 2; ++n) { const f32x4 v = acc[ai][bj][m][n]; s += (v[0] + v[1]) + (v[2] + v[3]); }
                s += __shfl_xor(s, 16); s += __shfl_xor(s, 32);
                const float mw = s * (1.0f / 64.0f); float q = 0.f;
#pragma unroll
                for (int bj = 0; bj < 2; ++bj)
#pragma unroll
                    for (int n = 0; n < 2; ++n) { const f32x4 d = acc[ai][bj][m][n] - mw; q += (d[0] * d[0] + d[1] * d[1]) + (d[2] * d[2] + d[3] * d[3]); }
                q += __shfl_xor(q, 16); q += __shfl_xor(q, 32);
                if (fq == 0) P[(ai * HALF + wr * 64 + m * 16 + fr) * 4 + wc] = (f32x2v){mw, q};
            }
        asm volatile("s_waitcnt lgkmcnt(0)" ::: "memory"); __builtin_amdgcn_s_barrier(); asm volatile("" ::: "memory");
        const int row = wid * 32 + (lane & 31);
        float mt = 0.f, m2 = 0.f;
        if (lane < 32) {
            const f32x2v a = P[row * 4 + 0], b = P[row * 4 + 1], c = P[row * 4 + 2], d = P[row * 4 + 3];
            mt = (a.x + b.x + c.x + d.x) * 0.25f;
            const float da = a.x - mt, db = b.x - mt, dc = c.x - mt, dd = d.x - mt;
            m2 = (a.y + b.y) + (c.y + d.y) + 64.0f * ((da * da + db * db) + (dc * dc + dd * dd));
        }
        if (!last) {
            if (lane < 32) T0[row] = (f32x2v){mt, m2};
#pragma unroll
            for (int ai = 0; ai < 2; ++ai)
#pragma unroll
                for (int m = 0; m < 4; ++m) { const size_t off = (size_t)(row0 + ai * HALF + m * 16) * 2048 + col0;
#pragma unroll
                    for (int bj = 0; bj < 2; ++bj)
#pragma unroll
                        for (int n = 0; n < 2; ++n) *(f32x4*)(out + off + bj * HALF + n * 16) = acc[ai][bj][m][n]; }
            asm volatile("s_waitcnt lgkmcnt(0)" ::: "memory"); __builtin_amdgcn_s_barrier(); asm volatile("" ::: "memory");
            return;
        }
        if (lane < 32) {
            const f32x2v t0 = T0[row];
            const float dl = mt - t0.x, m512 = 0.5f * (mt + t0.x), q512 = m2 + t0.y + 128.0f * dl * dl;
            unsigned long long* slot = xbuf + ((size_t)(u.pm * BM + row) * 4 + (u.pn & 3));
            __hip_atomic_store(slot, ((unsigned long long)__float_as_uint(q512) << 32) | __float_as_uint(m512), __ATOMIC_RELAXED, __HIP_MEMORY_SCOPE_AGENT);
        }
        asm volatile("s_waitcnt vmcnt(0)" ::: "memory");
        if (lane == 0) __hip_atomic_fetch_add(cnt + 64 * u.pm, 1u, __ATOMIC_RELAXED, __HIP_MEMORY_SCOPE_AGENT);
        if (wid == 0) {
            unsigned polls = 0;
            while ((unsigned)__builtin_amdgcn_readfirstlane(__hip_atomic_load(cnt + 64 * u.pm, __ATOMIC_RELAXED, __HIP_MEMORY_SCOPE_AGENT)) < 32u) {
                if (++polls > (1u << 22)) break;
                __builtin_amdgcn_s_sleep(2); }
            __builtin_amdgcn_fence(__ATOMIC_ACQUIRE, "agent");
        }
        asm volatile("s_waitcnt vmcnt(0) lgkmcnt(0)" ::: "memory"); __builtin_amdgcn_s_barrier(); asm volatile("" ::: "memory");
        if (lane < 32) {
            const unsigned long long* slot = xbuf + (size_t)(u.pm * BM + row) * 4; float mm[4], qq[4]; float ms = 0.f;
#pragma unroll
            for (int t = 0; t < 4; ++t) { const unsigned long long w = __hip_atomic_load(slot + t, __ATOMIC_RELAXED, __HIP_MEMORY_SCOPE_AGENT); mm[t] = __uint_as_float((unsigned)w); qq[t] = __uint_as_float((unsigned)(w >> 32)); ms += mm[t]; }
            const float mean = ms * 0.25f; float q = 0.f;
#pragma unroll
            for (int t = 0; t < 4; ++t) { const float dm = mm[t] - mean; q += qq[t] + 512.0f * dm * dm; }
            S[row] = (f32x2v){mean, 1.0f / sqrtf(q * (1.0f / 2048.0f) + eps)};
        }
        asm volatile("s_waitcnt lgkmcnt(0)" ::: "memory"); __builtin_amdgcn_s_barrier(); asm volatile("" ::: "memory");
        {
            f32x4 gn[2][2], bs[2][2];
#pragma unroll
            for (int bj = 0; bj < 2; ++bj)
#pragma unroll
                for (int n = 0; n < 2; ++n) { gn[bj][n] = *(const f32x4*)(gain + col0 + bj * HALF + n * 16); bs[bj][n] = *(const f32x4*)(bias + col0 + bj * HALF + n * 16); }
#pragma unroll
            for (int ai = 0; ai < 2; ++ai)
#pragma unroll
                for (int m = 0; m < 4; ++m) { const int r = ai * HALF + wr * 64 + m * 16 + fr; const f32x2v sr = S[r]; const size_t off = (size_t)(u.pm * BM + r) * 2048 + col0;
#pragma unroll
                    for (int bj = 0; bj < 2; ++bj)
#pragma unroll
                        for (int n = 0; n < 2; ++n) *(f32x4*)(out + off + bj * HALF + n * 16) = (acc[ai][bj][m][n] - sr.x) * sr.y * gn[bj][n] + bs[bj][n]; }
        }
        {
            const int colA = col0 - 4 * BM;
            f32x4 gn[2][2], bs[2][2];
#pragma unroll
            for (int bj = 0; bj < 2; ++bj)
#pragma unroll
                for (int n = 0; n < 2; ++n) { gn[bj][n] = *(const f32x4*)(gain + colA + bj * HALF + n * 16); bs[bj][n] = *(const f32x4*)(bias + colA + bj * HALF + n * 16); }
#pragma unroll
            for (int ai = 0; ai < 2; ++ai)
#pragma unroll
                for (int m = 0; m < 4; ++m) { const int r = ai * HALF + wr * 64 + m * 16 + fr; const f32x2v sr = S[r]; const size_t off = (size_t)(u.pm * BM + r) * 2048 + colA;
                    f32x4 z[2][2];
#pragma unroll
                    for (int bj = 0; bj < 2; ++bj)
#pragma unroll
                        for (int n = 0; n < 2; ++n) z[bj][n] = *(const f32x4*)(out + off + bj * HALF + n * 16);
#pragma unroll
                    for (int bj = 0; bj < 2; ++bj)
#pragma unroll
                        for (int n = 0; n < 2; ++n) *(f32x4*)(out + off + bj * HALF + n * 16) = (z[bj][n] - sr.x) * sr.y * gn[bj][n] + bs[bj][n];
                    if (m & 1) asm volatile("" ::: "memory"); }
        }
    }
};

template <class Epi, class Sched, bool ALIGN_EPI = false, bool SP2 = false>
__device__ __forceinline__ void gemm_phase(PG8_LAS unsigned char* lds, const Gemm g, const Sched& S, const Epi& E) {
    int tid_ = threadIdx.x; asm volatile("" : "+v"(tid_));
    const int tid = tid_, wid = __builtin_amdgcn_readfirstlane(tid >> 6), lane = tid & 63, wr = wid >> 2, wc = wid & 3, fr = lane & 15, fq = lane >> 4;
    const int K = g.K, nt = K / BK;
    unsigned voffA[2], voffB[2];
#pragma unroll
    for (int i = 0; i < 2; ++i) { int R, C; stage_rc(tid * 16 + i * 8192, R, C); const int Rb = Epi::PERM ? ((R & ~31) + perm32(R & 31)) : R;
        voffA[i] = (unsigned)(R * K + C) * 2u; voffB[i] = (unsigned)(Rb * K + C) * 2u; }
    const size_t kstep = (size_t)(BK * 2);
    const size_t hstep = (size_t)HALF * K * 2;
    const size_t tstep = 2 * hstep;
    const unsigned ldsw = (unsigned)wid * 1024u;
    const int aoff = lds_byte(wr * 64 + fr, fq * 8), boff = lds_byte(wc * 32 + fr, fq * 8);
#define PG8_SA(b, h) (((b) * 2 + (h)) * HTB)
#define PG8_SB(b, h) ((4 + (b) * 2 + (h)) * HTB)
#define PG8_STAGE(bufoff, gbase, voff) do { _Pragma("unroll") for (int _i = 0; _i < 2; ++_i) \
        __builtin_amdgcn_global_load_lds((const unsigned*)((const char*)(gbase) + (voff)[_i]), (PG8_LAS unsigned*)(lds + (bufoff) + ldsw + _i * 8192), 16, 0, 0); } while (0)
#define PG8_LDA(dst, b, h) do { _Pragma("unroll") for (int m = 0; m < 4; ++m) _Pragma("unroll") for (int k = 0; k < 2; ++k) dst[m][k] = *(const PG8_LAS bf16x8*)(lds + PG8_SA(b, h) + aoff + m * 2048 + k * 1024); } while (0)
#define PG8_LDB(dst, b, h) do { _Pragma("unroll") for (int n = 0; n < 2; ++n) _Pragma("unroll") for (int k = 0; k < 2; ++k) dst[n][k] = *(const PG8_LAS bf16x8*)(lds + PG8_SB(b, h) + boff + n * 2048 + k * 1024); } while (0)
#define PG8_MMA(ai, bj, At, Bt) do { __builtin_amdgcn_s_setprio(1); _Pragma("unroll") for (int m = 0; m < 4; ++m) _Pragma("unroll") for (int n = 0; n < 2; ++n) _Pragma("unroll") for (int k = 0; k < 2; ++k) \
        acc[ai][bj][m][n] = __builtin_amdgcn_mfma_f32_16x16x32_bf16(Bt[n][k], At[m][k], acc[ai][bj][m][n], 0, 0, 0); __builtin_amdgcn_s_setprio(0); } while (0)
#define PG8_WAIT_V(n) asm volatile("s_waitcnt vmcnt(" #n ")" ::: "memory")
#define PG8_WAIT_L(n) asm volatile("s_waitcnt lgkmcnt(" #n ")" ::: "memory")
#define PG8_BAR __builtin_amdgcn_s_barrier()
#define PG8_SCHED __builtin_amdgcn_sched_barrier(0)
    Unit cur, nxt; int ui = 0;
    if (!S.next(0, cur)) return;
    f32x4 acc[2][2][4][2];
#pragma unroll
    for (int a = 0; a < 2; ++a)
#pragma unroll
        for (int b = 0; b < 2; ++b)
#pragma unroll
            for (int m = 0; m < 4; ++m)
#pragma unroll
                for (int n = 0; n < 2; ++n) acc[a][b][m][n] = (f32x4){0.f, 0.f, 0.f, 0.f};
    bf16x8 At[4][2], B0[2][2], B1[2][2];
    const char* cA = (const char*)g.A + (size_t)cur.pm * tstep; const char* cB = (const char*)g.Bt + (size_t)cur.pn * tstep;
    S.a_ready(cur);
    if constexpr (SP2) {
        PG8_STAGE(PG8_SB(0, 0), cB, voffB); PG8_STAGE(PG8_SB(0, 1), cB + hstep, voffB); PG8_STAGE(PG8_SA(0, 0), cA, voffA); PG8_STAGE(PG8_SA(0, 1), cA + hstep, voffA);
        if (wr == 1) PG8_BAR;
        PG8_WAIT_V(2); PG8_BAR;
        PG8_STAGE(PG8_SB(1, 0), cB + kstep, voffB); PG8_STAGE(PG8_SA(1, 0), cA + kstep, voffA); PG8_STAGE(PG8_SB(1, 1), cB + hstep + kstep, voffB);
        PG8_WAIT_V(6); PG8_BAR;
    } else {
        PG8_STAGE(PG8_SB(0, 0), cB, voffB); PG8_STAGE(PG8_SA(0, 0), cA, voffA); PG8_STAGE(PG8_SB(0, 1), cB + hstep, voffB); PG8_STAGE(PG8_SA(0, 1), cA + hstep, voffA);
        if (wr == 1) PG8_BAR;
        PG8_WAIT_V(4); PG8_BAR;
        PG8_STAGE(PG8_SB(1, 0), cB + kstep, voffB); PG8_STAGE(PG8_SA(1, 0), cA + kstep, voffA); PG8_STAGE(PG8_SB(1, 1), cB + hstep + kstep, voffB);
        PG8_WAIT_V(6); PG8_BAR;
    }
    for (;;) {
        const bool has_next = S.next(ui + 1, nxt);
        const char* nA = has_next ? (const char*)g.A + (size_t)nxt.pm * tstep : cA; const char* nB = has_next ? (const char*)g.Bt + (size_t)nxt.pn * tstep : cB;
        for (int t = 0; t < nt; t += 2) {
            const bool last = (t == nt - 2);
            const char* a1 = cA + (size_t)(t + 1) * kstep;
            const char* a2 = last ? nA : cA + (size_t)(t + 2) * kstep; const char* b2 = last ? nB : cB + (size_t)(t + 2) * kstep;
            const char* a3 = a2 + kstep; const char* b3 = b2 + kstep;
            if (last && has_next) S.a_ready(nxt);
            if constexpr (SP2) {
            PG8_LDB(B0, 0, 0); PG8_LDB(B1, 0, 1); PG8_SCHED; PG8_LDA(At, 0, 0); PG8_STAGE(PG8_SA(1, 1), a1 + hstep, voffA);
            PG8_WAIT_V(8); PG8_WAIT_L(0); PG8_BAR; PG8_MMA(0, 0, At, B0); PG8_MMA(0, 1, At, B1); PG8_BAR; PG8_SCHED;
            PG8_LDA(At, 0, 1); PG8_STAGE(PG8_SB(0, 0), b2, voffB); PG8_STAGE(PG8_SB(0, 1), b2 + hstep, voffB); PG8_STAGE(PG8_SA(0, 0), a2, voffA);
            PG8_WAIT_V(8); PG8_WAIT_L(0); PG8_BAR; PG8_MMA(1, 0, At, B0); PG8_MMA(1, 1, At, B1); PG8_BAR; PG8_SCHED;
            PG8_LDB(B0, 1, 0); PG8_LDB(B1, 1, 1); PG8_SCHED; PG8_LDA(At, 1, 0); PG8_STAGE(PG8_SA(0, 1), a2 + hstep, voffA);
            PG8_WAIT_V(8); PG8_WAIT_L(0); PG8_BAR; PG8_MMA(0, 0, At, B0); PG8_MMA(0, 1, At, B1); PG8_BAR; PG8_SCHED;
            PG8_LDA(At, 1, 1); PG8_STAGE(PG8_SB(1, 0), b3, voffB); PG8_STAGE(PG8_SB(1, 1), b3 + hstep, voffB); PG8_STAGE(PG8_SA(1, 0), a3, voffA);
            PG8_WAIT_V(8); PG8_WAIT_L(0); PG8_BAR; PG8_MMA(1, 0, At, B0); PG8_MMA(1, 1, At, B1); PG8_BAR; PG8_SCHED;
            } else {
            PG8_LDB(B0, 0, 0); PG8_SCHED; PG8_LDA(At, 0, 0); PG8_STAGE(PG8_SA(1, 1), a1 + hstep, voffA);
            PG8_WAIT_L(8); PG8_BAR; PG8_WAIT_L(0); PG8_MMA(0, 0, At, B0); PG8_BAR; PG8_SCHED;
            PG8_LDB(B1, 0, 1); PG8_STAGE(PG8_SB(0, 0), b2, voffB);
            PG8_BAR; PG8_WAIT_L(0); PG8_MMA(0, 1, At, B1); PG8_BAR;
            PG8_LDA(At, 0, 1); PG8_STAGE(PG8_SA(0, 0), a2, voffA);
            PG8_BAR; PG8_WAIT_L(0); PG8_MMA(1, 0, At, B0); PG8_BAR; PG8_SCHED;
            PG8_STAGE(PG8_SB(0, 1), b2 + hstep, voffB);
            PG8_WAIT_V(6); PG8_BAR; PG8_MMA(1, 1, At, B1); PG8_BAR;
            PG8_LDB(B0, 1, 0); PG8_SCHED; PG8_LDA(At, 1, 0); PG8_STAGE(PG8_SA(0, 1), a2 + hstep, voffA);
            PG8_WAIT_L(8); PG8_BAR; PG8_WAIT_L(0); PG8_MMA(0, 0, At, B0); PG8_BAR; PG8_SCHED;
            PG8_LDB(B1, 1, 1); PG8_STAGE(PG8_SB(1, 0), b3, voffB);
            PG8_BAR; PG8_WAIT_L(0); PG8_MMA(0, 1, At, B1); PG8_BAR;
            PG8_LDA(At, 1, 1); PG8_STAGE(PG8_SA(1, 0), a3, voffA);
            PG8_BAR; PG8_WAIT_L(0); PG8_MMA(1, 0, At, B0); PG8_BAR; PG8_SCHED;
            PG8_STAGE(PG8_SB(1, 1), b3 + hstep, voffB);
            PG8_WAIT_V(6); PG8_BAR; PG8_MMA(1, 1, At, B1); PG8_BAR;
            }
        }
        if constexpr (ALIGN_EPI) { if (wr == 0) PG8_BAR; }
        if constexpr (Epi::LNX) { E.lnx(acc, cur, !has_next, wr, wc, fr, fq, lds + STAGE_BYTES, wid, lane); } else if constexpr (!Epi::AFTER_DRAIN) { E(acc, cur, wr, wc, fr, fq); S.done(cur); }
        if (!has_next) break;
#pragma unroll
        for (int a = 0; a < 2; ++a)
#pragma unroll
            for (int b = 0; b < 2; ++b)
#pragma unroll
                for (int m = 0; m < 4; ++m)
#pragma unroll
                    for (int n = 0; n < 2; ++n) acc[a][b][m][n] = (f32x4){0.f, 0.f, 0.f, 0.f};
        cur = nxt; cA = nA; cB = nB; ++ui;
        if constexpr (ALIGN_EPI) { if (wr == 1) PG8_BAR; }
    }
    PG8_WAIT_V(0);
    if constexpr (!ALIGN_EPI) { if (wr == 0) PG8_BAR; }
    PG8_BAR;
    if constexpr (Epi::AFTER_DRAIN) { E.fused(acc, cur, wr, wc, fr, fq, lds, wid, lane); S.done(cur); }
#undef PG8_SA
#undef PG8_SB
#undef PG8_STAGE
#undef PG8_LDA
#undef PG8_LDB
#undef PG8_MMA
#undef PG8_WAIT_V
#undef PG8_WAIT_L
#undef PG8_BAR
#undef PG8_SCHED
}
}

namespace att {
typedef unsigned short bf16_t;
typedef short bf16x8 __attribute__((ext_vector_type(8)));
typedef short s16x4 __attribute__((ext_vector_type(4)));
typedef float f32x16 __attribute__((ext_vector_type(16)));
typedef float f32x4 __attribute__((ext_vector_type(4)));
typedef unsigned u32x4 __attribute__((ext_vector_type(4)));
constexpr int D = 128, NW = 8, QBLK = 32, KVBLK = 64, QB = NW * QBLK;
constexpr int SHM_V = KVBLK * D * 2, SHM_K = KVBLK * D * 2;
constexpr int LDS_BYTES = 2 * SHM_V + 2 * SHM_K + NW * 64 * 4;
constexpr float THR = 8.f;
constexpr int W = 129;

#define KSWZ(row, colB) ((row) * 256 + ((colB) ^ (((row) & 7) << 4)))
#define SBAR() __builtin_amdgcn_sched_barrier(0)
__device__ __forceinline__ int v_st(int k, int c) { const int kk = (k & ~0xC) | ((k & 4) << 1) | ((k & 8) >> 1); return ((kk >> 3) * 4 + (c >> 5)) * 512 + ((kk & 7) * 32 + (c & 31)) * 2; }
__device__ __forceinline__ int v_rd_base(int lane) { return ((lane & 3) << 3) | (((lane >> 2) & 3) << 6) | (((lane >> 4) & 1) << 5) | (((lane >> 5) & 1) << 8); }
constexpr int v_rd_off(int d0, int ks, int half) { return d0 * 512 + ks * 4096 + half * 2048; }
__device__ __forceinline__ int crow(int r, int hi) { return (r & 3) + 8 * (r >> 2) + 4 * hi; }
__device__ __forceinline__ unsigned cvtpk(float lo, float hi) { unsigned r; asm volatile("v_cvt_pk_bf16_f32 %0, %1, %2" : "=v"(r) : "v"(lo), "v"(hi)); return r; }
__device__ __forceinline__ bf16x8 load8(const bf16_t* p) { return *reinterpret_cast<const bf16x8*>(p); }
__device__ __forceinline__ void mask_tile(f32x16& p0, f32x16& p1, int dq, unsigned Wm) {
    const float NEG = -__builtin_inff();
#pragma unroll
    for (int r = 0; r < 16; ++r) {
        const int c = (r & 3) + 8 * (r >> 2);
        if ((unsigned)(dq - c) >= Wm) p0[r] = NEG;
        if ((unsigned)(dq - c - 32) >= Wm) p1[r] = NEG;
    }
}
__device__ __forceinline__ void partialSM(f32x16& p0, f32x16& p1, float& m_reg, float& mn, float& alpha) {
    float pmax = p0[0]; for (int r = 1; r < 16; ++r) pmax = fmaxf(pmax, p0[r]); for (int r = 0; r < 16; ++r) pmax = fmaxf(pmax, p1[r]);
    { auto rr = __builtin_amdgcn_permlane32_swap(__float_as_uint(pmax), __float_as_uint(pmax), false, false);
      pmax = fmaxf(__uint_as_float(rr[0]), __uint_as_float(rr[1])); }
    if (__builtin_expect(__all((pmax - m_reg) <= THR), 1)) { mn = m_reg; alpha = 1.f; }
    else { mn = fmaxf(m_reg, pmax); alpha = __builtin_amdgcn_exp2f(m_reg - mn); m_reg = mn; }
    for (int r = 0; r < 16; ++r) p0[r] = p0[r] - mn; for (int r = 0; r < 16; ++r) p1[r] = p1[r] - mn;
    for (int r = 0; r < 16; ++r) p0[r] = __builtin_amdgcn_exp2f(p0[r]);
}
__device__ __forceinline__ void finishSM(f32x16& p0, f32x16& p1, float alpha, float& l_reg, bf16x8& pa0, bf16x8& pa1, bf16x8& pa2, bf16x8& pa3) {
    for (int r = 0; r < 16; ++r) p1[r] = __builtin_amdgcn_exp2f(p1[r]);
    float ps = 0; for (int r = 0; r < 16; ++r) ps += p0[r]; for (int r = 0; r < 16; ++r) ps += p1[r];
    { auto rr = __builtin_amdgcn_permlane32_swap(__float_as_uint(ps), __float_as_uint(ps), false, false);
      ps = __uint_as_float(rr[0]) + __uint_as_float(rr[1]); }
    l_reg = l_reg * alpha + ps;
#define PK4(P, B_, OUT) do { unsigned a0 = cvtpk(P[B_+0], P[B_+1]), a1 = cvtpk(P[B_+2], P[B_+3]);                          \
        unsigned b0 = cvtpk(P[B_+4], P[B_+5]), b1 = cvtpk(P[B_+6], P[B_+7]);                                             \
        auto r0 = __builtin_amdgcn_permlane32_swap(a0, b0, false, false); auto r1 = __builtin_amdgcn_permlane32_swap(a1, b1, false, false); \
        u32x4 w = {r0[0], r1[0], r0[1], r1[1]}; OUT = *reinterpret_cast<bf16x8*>(&w); } while (0)
    PK4(p0, 0, pa0); PK4(p0, 8, pa1); PK4(p1, 0, pa2); PK4(p1, 8, pa3);
#undef PK4
}
template <int KB>
__device__ __forceinline__ void qkt(f32x16& p0, f32x16& p1, const char* K_lds, int r32, int hi, const bf16x8* qr, bool act) {
    if (!act) { const float NEG = -__builtin_inff();
#pragma unroll
        for (int r = 0; r < 16; ++r) { p0[r] = NEG; p1[r] = NEG; } return; }
    p0 = f32x16{}; p1 = f32x16{};
    const char* kb[4];
#pragma unroll
    for (int dd = 0; dd < 4; ++dd) kb[dd] = K_lds + KB * SHM_K + KSWZ(r32, (dd * 16 + hi * 8) * 2);
#pragma unroll
    for (int d0 = 0; d0 < 8; ++d0) { const char* a = kb[d0 & 3] + (d0 >> 2) * 128;
        bf16x8 b0 = *reinterpret_cast<const bf16x8*>(a);
        bf16x8 b1 = *reinterpret_cast<const bf16x8*>(a + 32 * 256);
        p0 = __builtin_amdgcn_mfma_f32_32x32x16_bf16(b0, qr[d0], p0, 0, 0, 0);
        p1 = __builtin_amdgcn_mfma_f32_32x32x16_bf16(b1, qr[d0], p1, 0, 0, 0); }
}
template <int VB>
__device__ __forceinline__ void pv_tile(f32x16* o, int vb0, bf16x8 pa0, bf16x8 pa1, bf16x8 pa2, bf16x8 pa3, bool act) {
    if (!act) return;
#define TRRD(dst, off) asm volatile("ds_read_b64_tr_b16 %0, %1 offset:%2" : "=&v"(dst) : "v"(vb0), "i"(off) : "memory")
#define PV_D0(d0) do { s16x4 l0, l1, l2, l3, h0, h1, h2, h3; constexpr int b_ = VB * SHM_V + v_rd_off(d0, 0, 0);     \
        TRRD(l0, b_); TRRD(h0, b_ + 2048); TRRD(l1, b_ + 4096); TRRD(h1, b_ + 6144); TRRD(l2, b_ + 8192); TRRD(h2, b_ + 10240); TRRD(l3, b_ + 12288); TRRD(h3, b_ + 14336); \
        asm volatile("s_waitcnt lgkmcnt(0)" ::: "memory"); SBAR();                 \
        o[d0] = __builtin_amdgcn_mfma_f32_32x32x16_bf16(pa0, (bf16x8){l0[0], l0[1], l0[2], l0[3], h0[0], h0[1], h0[2], h0[3]}, o[d0], 0, 0, 0);   \
        o[d0] = __builtin_amdgcn_mfma_f32_32x32x16_bf16(pa1, (bf16x8){l1[0], l1[1], l1[2], l1[3], h1[0], h1[1], h1[2], h1[3]}, o[d0], 0, 0, 0);   \
        o[d0] = __builtin_amdgcn_mfma_f32_32x32x16_bf16(pa2, (bf16x8){l2[0], l2[1], l2[2], l2[3], h2[0], h2[1], h2[2], h2[3]}, o[d0], 0, 0, 0);   \
        o[d0] = __builtin_amdgcn_mfma_f32_32x32x16_bf16(pa3, (bf16x8){l3[0], l3[1], l3[2], l3[3], h3[0], h3[1], h3[2], h3[3]}, o[d0], 0, 0, 0); } while (0)
    PV_D0(0); PV_D0(1); PV_D0(2); PV_D0(3);
#undef PV_D0
#undef TRRD
}

struct BlockRef { const bf16_t* Q; const bf16_t* K; const bf16_t* V; bf16_t* O; float* L; int P0, pitch, lstride, skv; };
struct Seam { bf16x8 qr[8]; bf16x8 st_v0, st_v1, st_k0, st_k1; };
__device__ __forceinline__ int swa_jlo(int P0) { const int lowk = P0 - W + 1; return lowk > 0 ? lowk / KVBLK : 0; }
#define ROWP(p, pit, k0, rr) ((p) + (size_t)((k0) + (rr)) * (size_t)(pit) + sc)
#define VMW() asm volatile("s_waitcnt vmcnt(0)" ::: "memory")
#define VMWN(n) asm volatile("s_waitcnt vmcnt(%0)" :: "i"(n) : "memory")
#define SLOAD_H(Kp, Vp, pit, k0) do { S.st_v0 = load8(ROWP(Vp, pit, k0, sr)); S.st_v1 = load8(ROWP(Vp, pit, k0, 32 + sr));              \
                         S.st_k0 = load8(ROWP(Kp, pit, k0, sr)); S.st_k1 = load8(ROWP(Kp, pit, k0, 32 + sr)); } while (0)
#define SWRITE_HK(bf) do { *(bf16x8*)(K_lds + (bf) * SHM_K + kws) = S.st_k0; *(bf16x8*)(K_lds + (bf) * SHM_K + kws + 32 * 256) = S.st_k1; } while (0)
#define SWRITE_HV(bf) do { *(bf16x8*)(V_lds + (bf) * SHM_V + vst0) = S.st_v0; *(bf16x8*)(V_lds + (bf) * SHM_V + vst1) = S.st_v1; } while (0)
#define SWRITE_H(bf) do { SWRITE_HV(bf); SWRITE_HK(bf); } while (0)
__device__ __forceinline__ void swa_prime(const BlockRef& cur, char* lds, Seam& S) {
    int tid_ = threadIdx.x; asm volatile("" : "+v"(tid_));
    const int tid = tid_, wid = __builtin_amdgcn_readfirstlane(tid >> 6), lane = tid & 63, r32 = lane & 31, hi = lane >> 5;
    const int sr = tid >> 4, sc = (tid & 15) * 8, kws = KSWZ(sr, sc * 2); char* K_lds = lds + 2 * SHM_V;
    const int kb0 = swa_jlo(cur.P0) * KVBLK;
    for (int d0 = 0; d0 < 8; ++d0) S.qr[d0] = load8(cur.Q + (size_t)(wid * QBLK + r32) * (size_t)cur.pitch + d0 * 16 + hi * 8);
    SLOAD_H(cur.K, cur.V, cur.pitch, kb0); VMW(); SWRITE_HK(0);
    __syncthreads();
}
__device__ __forceinline__ void swa_block(const BlockRef& cur, const BlockRef& nxt, char* lds, Seam& S) {
    int tid_ = threadIdx.x; asm volatile("" : "+v"(tid_));
    const int tid = tid_, wid = __builtin_amdgcn_readfirstlane(tid >> 6), lane = tid & 63, r32 = lane & 31, hi = lane >> 5;
    const int j_lo = swa_jlo(cur.P0);
    int j_hi = (cur.P0 + QB - 1) / KVBLK + 1; if (j_hi > cur.skv / KVBLK) j_hi = cur.skv / KVBLK;
    const int NT = j_hi - j_lo;
    const int kbn = swa_jlo(nxt.P0) * KVBLK;
    const int qlo = cur.P0 + wid * QBLK, qm = qlo + r32 - 4 * hi;
    char* V_lds = lds; char* K_lds = lds + 2 * SHM_V;
    float* ws = (float*)(lds + 2 * SHM_V + 2 * SHM_K) + wid * 64; float* li_l = ws, * al_l = ws + 32;
    float m_reg = -1e30f, l_reg = 0; f32x16 o[4] = {};
    const int sr = tid >> 4, sc = (tid & 15) * 8, vst0 = v_st(sr, sc), vst1 = v_st(32 + sr, sc), kws = KSWZ(sr, sc * 2);
    const int vb0 = (int)(uintptr_t)V_lds + v_rd_base(lane);
    const bf16_t* Kh = cur.K; const bf16_t* Vh = cur.V; const int pit = cur.pitch;
#define RESC(a) do { if (__any((a) < 1.f)) { if (hi == 0) al_l[r32] = (a); asm volatile("s_waitcnt lgkmcnt(0)" ::: "memory");              \
                     for (int d_ = 0; d_ < 4; ++d_) for (int r = 0; r < 16; ++r) o[d_][r] *= al_l[crow(r, hi)]; } } while (0)
#define KBASE(t) ((j_lo + (t)) * KVBLK)
#define ACT(t) (KBASE(t) <= qlo + QBLK - 1 && KBASE(t) + KVBLK - 1 >= qlo - W + 1)
#define MASKT(P0_, P1_, t) do { const int kb_ = KBASE(t); if (ACT(t) && (kb_ + KVBLK - 1 > qlo || kb_ <= qlo + QBLK - 1 - W)) mask_tile(P0_, P1_, qm - kb_, (unsigned)W); } while (0)
    constexpr int NQL = 8;
#define SEAM_K0() do { VMWN(NQL); SWRITE_HK(0); SBAR(); } while (0)
    f32x16 pA0, pA1, pB0, pB1; float mnA, mnB, alA, alB; bf16x8 pa0, pa1, pa2, pa3;
    SWRITE_HV(0); SBAR();
    if (NT > 1) { SLOAD_H(Kh, Vh, pit, KBASE(1)); }
    SBAR(); qkt<0>(pA0, pA1, K_lds, r32, hi, S.qr, ACT(0));
    MASKT(pA0, pA1, 0); partialSM(pA0, pA1, m_reg, mnA, alA);
    if (NT > 1) { VMW(); SWRITE_H(1); }
    __syncthreads();
#define HALF_STEP(PX0, PX1, mnX, alX, PY0, PY1, alY, t, KB, VB, SB) do {                                                      \
        SBAR(); qkt<KB>(PX0, PX1, K_lds, r32, hi, S.qr, ACT(t));                                                 \
        finishSM(PY0, PY1, alY, l_reg, pa0, pa1, pa2, pa3); SBAR();                                                           \
        if ((t) + 1 < NT) { SLOAD_H(Kh, Vh, pit, KBASE((t) + 1)); SBAR(); }                                                   \
        pv_tile<VB>(o, vb0, pa0, pa1, pa2, pa3, ACT((t) - 1)); MASKT(PX0, PX1, (t)); partialSM(PX0, PX1, m_reg, mnX, alX);   \
        __syncthreads();                                                                                                      \
        if ((t) + 1 < NT) { VMW(); SWRITE_H(SB); }                                                                            \
        RESC(alX); __syncthreads(); } while (0)
    for (int t = 1; t + 1 < NT; t += 2) {
        HALF_STEP(pB0, pB1, mnB, alB, pA0, pA1, alA, t, 1, 0, 0);
        HALF_STEP(pA0, pA1, mnA, alA, pB0, pB1, alB, t + 1, 0, 1, 1);
    }
    const bool even = (NT & 1) == 0;
    if (even) { SBAR(); qkt<1>(pB0, pB1, K_lds, r32, hi, S.qr, ACT(NT - 1)); SBAR(); }
    SLOAD_H(nxt.K, nxt.V, nxt.pitch, kbn); SBAR();
#pragma unroll
    for (int d0 = 0; d0 < 8; ++d0) S.qr[d0] = load8(nxt.Q + (size_t)(wid * QBLK + r32) * (size_t)nxt.pitch + d0 * 16 + hi * 8);
    SBAR();
    finishSM(pA0, pA1, alA, l_reg, pa0, pa1, pa2, pa3); SBAR();
    pv_tile<0>(o, vb0, pa0, pa1, pa2, pa3, ACT(even ? NT - 2 : NT - 1));
    if (even) { MASKT(pB0, pB1, NT - 1); partialSM(pB0, pB1, m_reg, mnB, alB); __syncthreads(); RESC(alB);
        finishSM(pB0, pB1, alB, l_reg, pa0, pa1, pa2, pa3); SBAR(); pv_tile<1>(o, vb0, pa0, pa1, pa2, pa3, ACT(NT - 1)); }
    SBAR(); SEAM_K0();
    if (hi == 0) { li_l[r32] = l_reg; cur.L[(size_t)(wid * QBLK + r32) * (size_t)cur.lstride] = m_reg + __builtin_amdgcn_logf(l_reg); }
    asm volatile("s_waitcnt lgkmcnt(0)" ::: "memory");
    float rli[16];
#pragma unroll
    for (int r = 0; r < 16; ++r) rli[r] = __builtin_amdgcn_rcpf(li_l[crow(r, hi)]);
    bf16_t* Ow = cur.O + (size_t)(wid * QBLK) * (size_t)pit;
#pragma unroll
    for (int r = 0; r < 16; ++r) { const int orow = crow(r, hi);
#pragma unroll
        for (int d0 = 0; d0 < 4; ++d0) { const float v = o[d0][r] * rli[r];
            const float vn = __shfl_xor(v, 1);
            if ((r32 & 1) == 0) *(unsigned*)(Ow + (size_t)orow * (size_t)pit + d0 * 32 + r32) = cvtpk(v, vn); } }
    __syncthreads();
#undef RESC
#undef KBASE
#undef ACT
#undef MASKT
#undef SEAM_K0
#undef HALF_STEP
}
#undef ROWP
#undef VMW
#undef VMWN
#undef SLOAD_H
#undef SWRITE_HK
#undef SWRITE_HV
#undef SWRITE_H
#undef KSWZ
#undef SBAR
}

constexpr int NWAVES = 8;
constexpr int N_LAUNCHES = MK_N_LAUNCHES;
constexpr int PER_PHASE = 5;
#ifndef MK_DUP_PHASE
#define MK_DUP_PHASE -1
#endif
constexpr int DUP_PHASE = MK_DUP_PHASE;
constexpr int BATCH = 4, SEQ = 4096, DM = 2048, M = BATCH * SEQ;
constexpr int NH = 8, HD = 128, DATT = 1024, DPOOL = 1024, DIN = 6144;
constexpr float LN_EPS = 1e-5f;
constexpr float DN_ALPHA = 1.189207115002721f;
constexpr float QSCALE = 1.4426950408889634f * 0.08838834764831845f;

constexpr size_t MiB = 1u << 20;
constexpr size_t WS_CTL = 0, CTL_ZERO_BYTES = 64 * 1024;
constexpr size_t WS_ROPE = 1 * MiB;
constexpr size_t WS_WPT = 2 * MiB;
constexpr size_t WS_WOUT = 4 * MiB;
constexpr size_t WS_WIN = 12 * MiB;
constexpr size_t WS_XB = 36 * MiB;
constexpr size_t WS_QKV = 100 * MiB;
constexpr size_t WS_U = 196 * MiB;
constexpr size_t WS_G = 228 * MiB;
constexpr size_t WS_O = 292 * MiB;
constexpr size_t WS_L = 388 * MiB;
constexpr size_t WS_Y = 390 * MiB;
constexpr size_t WS_END = 454 * MiB;
constexpr size_t WS_X = 1 * MiB + 512 * 1024;
constexpr int CW_PANEL = 8192;
constexpr int CW_BAR = 1024;

constexpr int RING_BYTES = 131072;
constexpr int LDSCTL_OFF = 143360, MISC_OFF = LDSCTL_OFF + 320;
constexpr int LDS_BYTES = 147456;

#define GAS __attribute__((address_space(1)))
#define LAS __attribute__((address_space(3)))
typedef unsigned short bf16;
typedef unsigned v4u __attribute__((ext_vector_type(4)));
typedef unsigned v2u __attribute__((ext_vector_type(2)));
typedef float f32x4 __attribute__((ext_vector_type(4)));
typedef short bf16x8 __attribute__((ext_vector_type(8)));
typedef GAS unsigned gu32;
#define RLX_AGENT __ATOMIC_RELAXED, __HIP_MEMORY_SCOPE_AGENT
#define LDS_WAIT() asm volatile("s_waitcnt lgkmcnt(0)" ::: "memory")
#define VM_WAIT() asm volatile("s_waitcnt vmcnt(0)" ::: "memory")
__device__ __forceinline__ unsigned pk2(float lo, float hi) { unsigned r; asm volatile("v_cvt_pk_bf16_f32 %0, %1, %2" : "=v"(r) : "v"(lo), "v"(hi)); return r; }
__device__ __forceinline__ float bf_lo(unsigned w) { return __uint_as_float(w << 16); }
__device__ __forceinline__ float bf_hi(unsigned w) { return __uint_as_float(w & 0xffff0000u); }
__device__ __forceinline__ float silu_f(float g) { return g * __builtin_amdgcn_rcpf(1.f + __builtin_amdgcn_exp2f(-1.4426950408889634f * g)); }

#define XB_TMO      128
#define XB_XCNT(j)  (256  + 64 * (j))
#define XB_XSUB(j)  (1280 + 64 * (j))
#define XB_XGEN(j)  (2304 + 64 * (j))
#define XB_TOP      3328
#define XB_TOPGEN   3392
#define XCD_BAR_WORDS 3456
#define XB_SPIN_CAP (1u << 18)

__device__ __forceinline__ unsigned xb_ld(unsigned* p)              { return __hip_atomic_load(p, __ATOMIC_RELAXED, __HIP_MEMORY_SCOPE_AGENT); }
__device__ __forceinline__ unsigned xb_add(unsigned* p, unsigned v) { return __hip_atomic_fetch_add(p, v, __ATOMIC_RELAXED, __HIP_MEMORY_SCOPE_AGENT); }
__device__ __forceinline__ unsigned xb_xcc_id() { return (unsigned)__builtin_amdgcn_s_getreg((3 << 11) | 20) & 0xFu; }
#define XB_SPIN(cond, bar) do { unsigned _sp = 0; while (cond) { __builtin_amdgcn_s_sleep(1); \
    if ((++_sp & 255u) == 0u) { if (xb_ld(&(bar)[XB_TMO])) break; if (_sp > XB_SPIN_CAP) { atomicAdd(&(bar)[XB_TMO], 1u); break; } } } } while (0)

struct XcdBarrier {
    unsigned* bar; unsigned x;
    volatile LAS unsigned* st;
};

__device__ __forceinline__ XcdBarrier xcd_barrier_post(unsigned* bar, volatile LAS unsigned* st) {
    XcdBarrier b; b.bar = bar; b.x = xb_xcc_id(); b.st = st;
    if (threadIdx.x == 0) (void)xb_add(&bar[XB_XCNT(b.x)], 1u);
    return b;
}
__device__ __forceinline__ void xcd_barrier_complete(unsigned* bar, unsigned x, unsigned& nloc, unsigned& nx) {
    const unsigned G = gridDim.x * gridDim.y * gridDim.z;
    unsigned sum, cnt, mine, sp = 0u;
    for (;;) {
        sum = 0u; cnt = 0u; mine = 0u;
#pragma unroll
        for (unsigned j = 0; j < 16; ++j) { const unsigned c = xb_ld(&bar[XB_XCNT(j)]); sum += c; cnt += (c > 0u) ? 1u : 0u; mine = (j == x) ? c : mine; }
        if (sum == G) break;
        __builtin_amdgcn_s_sleep(1);
        if ((++sp & 255u) == 0u) { if (xb_ld(&bar[XB_TMO])) break; if (sp > XB_SPIN_CAP) { atomicAdd(&bar[XB_TMO], 1u); break; } }
    }
    nloc = mine > 0u ? mine : 1u; nx = cnt > 0u ? cnt : 1u;
}

__device__ __forceinline__ void xcd_barrier(const XcdBarrier& b) {
    asm volatile("s_waitcnt vmcnt(0)" ::: "memory");
    __syncthreads();
    if (threadIdx.x == 0) {
        unsigned* bar = b.bar;
        __builtin_amdgcn_s_waitcnt(0);
        unsigned nloc = b.st[0], nx = b.st[1];
        if (nloc == 0u) { xcd_barrier_complete(bar, b.x, nloc, nx); b.st[0] = nloc; b.st[1] = nx; }
        const unsigned old = xb_add(&bar[XB_XSUB(b.x)], 1u);
        const unsigned gen = old / nloc;
        if (old + 1u == (gen + 1u) * nloc) {
            __builtin_amdgcn_fence(__ATOMIC_RELEASE, "agent");
            asm volatile("s_waitcnt vmcnt(0)" ::: "memory");
            const unsigned og = xb_add(&bar[XB_TOP], 1u);
            const unsigned tg = og / nx;
            if (og + 1u == (tg + 1u) * nx) xb_add(&bar[XB_TOPGEN], 1u);
            else XB_SPIN(xb_ld(&bar[XB_TOPGEN]) == tg, bar);
            __builtin_amdgcn_fence(__ATOMIC_ACQUIRE, "agent");
            xb_add(&bar[XB_XGEN(b.x)], 1u);
            asm volatile("s_waitcnt vmcnt(0)" ::: "memory");
        } else {
            XB_SPIN(xb_ld(&bar[XB_XGEN(b.x)]) == gen, bar);
            __builtin_amdgcn_fence(__ATOMIC_ACQUIRE, "agent");
            asm volatile("s_waitcnt vmcnt(0)" ::: "memory");
        }
    }
    __syncthreads();
}

__device__ __forceinline__ void p0_transpose_item(const float* W, int K, int N, bf16* WT, LAS float* scr, int item, int lane) {
    const int nblk = N / 32, kb = item / nblk, nb = item % nblk, k0 = 64 * kb, n0 = 32 * nb;
#pragma unroll
    for (int i = 0; i < 32; ++i) { const int kk = 2 * i + (lane >> 5); scr[kk * 33 + (lane & 31)] = W[(size_t)(k0 + kk) * N + n0 + (lane & 31)]; }
    LDS_WAIT(); asm volatile("" ::: "memory");
    const int c = lane & 7;
#pragma unroll
    for (int j = 0; j < 4; ++j) { const int n = (lane >> 3) + 8 * j; const LAS float* s = scr + (8 * c) * 33 + n;
        v4u o; o.x = pk2(s[0 * 33], s[1 * 33]); o.y = pk2(s[2 * 33], s[3 * 33]); o.z = pk2(s[4 * 33], s[5 * 33]); o.w = pk2(s[6 * 33], s[7 * 33]);
        *(GAS v4u*)(WT + (size_t)(n0 + n) * K + k0 + 8 * c) = o; }
    LDS_WAIT(); asm volatile("" ::: "memory");
}
__device__ __forceinline__ void sincos_pi(double r, double& s, double& c) {
    const double z = r * r;
    double ss = 0.0, cc = 0.0, term_s = r, term_c = 1.0;
#pragma unroll
    for (int k = 0; k < 16; ++k) { ss += term_s; cc += term_c; term_c = -term_c * z / (double)((2 * k + 1) * (2 * k + 2)); term_s = -term_s * z / (double)((2 * k + 2) * (2 * k + 3)); }
    s = ss; c = cc;
}
__device__ __forceinline__ void p0_prologue(LAS unsigned char* lds, const float* x, const float* w_in, const float* w_pool, const float* w_out, unsigned char* ws, int vcu, int G, int tid, int wave, int lane) {
    LAS float* scr = (LAS float*)(lds + wave * 16384);
    const int gw = vcu * NWAVES + wave, NGW = G * NWAVES;
    bf16* WinT = (bf16*)(ws + WS_WIN); bf16* WoutT = (bf16*)(ws + WS_WOUT); bf16* WpT = (bf16*)(ws + WS_WPT);
    constexpr int I_IN = (DM / 64) * (DIN / 32), I_OUT = (DM / 64) * (DM / 32), I_P = (256 / 64) * (256 / 32);
    constexpr int NITEMS = I_IN + I_OUT + 4 * I_P;
    for (int it = gw; it < NITEMS; it += NGW) {
        int r = it;
        if (r < I_IN) { p0_transpose_item(w_in, DM, DIN, WinT, scr, r, lane); continue; } r -= I_IN;
        if (r < I_OUT) { p0_transpose_item(w_out, DM, DM, WoutT, scr, r, lane); continue; } r -= I_OUT;
        const int g = r / I_P; r -= g * I_P;
        p0_transpose_item(w_pool + (size_t)g * 65536, 256, 256, WpT + (size_t)g * 65536, scr, r, lane);
    }
    {
        const size_t gt = (size_t)vcu * (NWAVES * 64) + tid, NT = (size_t)G * (NWAVES * 64);
        bf16* XB = (bf16*)(ws + WS_XB);
        for (size_t i = gt; i < (size_t)M * DM / 8; i += NT) {
            const f32x4 a = *(const GAS f32x4*)(x + i * 8), b = *(const GAS f32x4*)(x + i * 8 + 4);
            v4u o; o.x = pk2(a[0], a[1]); o.y = pk2(a[2], a[3]); o.z = pk2(b[0], b[1]); o.w = pk2(b[2], b[3]);
            *(GAS v4u*)(XB + i * 8) = o;
        }
        float* rope = (float*)(ws + WS_ROPE);
        for (size_t e = gt; e < 65536; e += NT) {
            const int i = (int)(e & 15), pos = (int)(e >> 4);
            double f;
            switch (i) { case 0: f = 1.0; break; case 1: f = 0.44036660267178046; break; case 2: f = 0.19392274474868576; break; case 3: f = 0.08539710028576561; break;
                case 4: f = 0.03760603093086393; break; case 5: f = 0.016560440080994446; break; case 6: f = 0.007292664737217109; break; case 7: f = 0.003211445994752591; break;
                case 8: f = 0.001414213562373095; break; case 9: f = 0.000622772421914596; break; case 10: f = 0.0002742481756762073; break; case 11: f = 0.00012076973741146504; break;
                case 12: f = 5.318295896944988e-05; break; case 13: f = 2.341999896140934e-05; break; case 14: f = 1.031338537721246e-05; break; default: f = 4.5416704806078695e-06; break; }
            const double ang = (double)pos * f;
            const double k = __builtin_rint(ang * 0.15915494309189535);
            const double r = __builtin_fma(-k, 2.4492935982947064e-16, __builtin_fma(-k, 6.283185307179586, ang));
            double s, c; sincos_pi(r, s, c);
            rope[e] = (float)c; rope[65536 + e] = (float)s;
        }
    }
}

__device__ __forceinline__ void pool_item(LAS unsigned char* lds, const bf16* U, const bf16* Gt, const bf16* WpT, const float* pool_scale, bf16* Y, int item, int tid, int wid, int lane) {
    const int g = item & 3, tile = item >> 2, tok0 = tile * 128, t0 = tok0 & 4095, w = 2 << g;
    LAS unsigned char* Ul = lds;
    LAS unsigned char* Al = lds + 73216;
    for (int c = tid; c < 143 * 32; c += NWAVES * 64) {
        const int lr = c >> 5, ch = c & 31, t = t0 - 15 + lr;
        v4u v = {0u, 0u, 0u, 0u};
        if (t >= 0) v = *(const GAS v4u*)(U + (size_t)(tok0 - 15 + lr) * 1024 + g * 256 + ch * 8);
        *(LAS v4u*)(Ul + lr * 512 + ch * 16) = v;
    }
    __syncthreads();
    {
        const int c4 = lane * 4, r0 = wid * 16;
        float s0 = 0.f, s1 = 0.f, s2 = 0.f, s3 = 0.f;
        for (int j = 1; j < w; ++j) { const v2u q = *(const LAS v2u*)(Ul + (r0 + 15 - j) * 512 + c4 * 2); s0 += bf_lo(q.x); s1 += bf_hi(q.x); s2 += bf_lo(q.y); s3 += bf_hi(q.y); }
        for (int i = 0; i < 16; ++i) {
            const int r = r0 + i;
            const v2u q = *(const LAS v2u*)(Ul + (r + 15) * 512 + c4 * 2);
            const float u0 = bf_lo(q.x), u1 = bf_hi(q.x), u2 = bf_lo(q.y), u3 = bf_hi(q.y);
            s0 += u0; s1 += u1; s2 += u2; s3 += u3;
            const int t = t0 + r, cnt = (t + 1 < w) ? t + 1 : w;
            const float inv = 1.f / (float)cnt;
            v2u o; o.x = pk2(s0 * inv - u0, s1 * inv - u1); o.y = pk2(s2 * inv - u2, s3 * inv - u3);
            *(LAS v2u*)(Al + r * 512 + (((c4 >> 3) ^ (r & 15)) << 4) + (c4 & 7) * 2) = o;
            const v2u qo = *(const LAS v2u*)(Ul + (r + 16 - w) * 512 + c4 * 2);
            s0 -= bf_lo(qo.x); s1 -= bf_hi(qo.x); s2 -= bf_lo(qo.y); s3 -= bf_hi(qo.y);
        }
    }
    __syncthreads();
    const int wr = wid >> 2, wc = wid & 3, fr = lane & 15, fq = lane >> 4;
    f32x4 acc[4][4];
#pragma unroll
    for (int m = 0; m < 4; ++m)
#pragma unroll
        for (int n = 0; n < 4; ++n) acc[m][n] = (f32x4){0.f, 0.f, 0.f, 0.f};
    const bf16* Bg = WpT + (size_t)g * 65536;
#pragma unroll 2
    for (int ks = 0; ks < 8; ++ks) {
        bf16x8 a[4], b[4];
#pragma unroll
        for (int m = 0; m < 4; ++m) { const int row = wr * 64 + m * 16 + fr; a[m] = *(const LAS bf16x8*)(Al + row * 512 + (((ks * 4 + fq) ^ (row & 15)) << 4)); }
#pragma unroll
        for (int n = 0; n < 4; ++n) { const int col = wc * 64 + n * 16 + fr; b[n] = *(const GAS bf16x8*)(Bg + (size_t)col * 256 + ks * 32 + fq * 8); }
#pragma unroll
        for (int m = 0; m < 4; ++m)
#pragma unroll
            for (int n = 0; n < 4; ++n) acc[m][n] = __builtin_amdgcn_mfma_f32_16x16x32_bf16(b[n], a[m], acc[m][n], 0, 0, 0);
    }
#pragma unroll
    for (int m = 0; m < 4; ++m) {
        const size_t token = (size_t)(tok0 + wr * 64 + m * 16 + fr);
#pragma unroll
        for (int n = 0; n < 4; ++n) {
            const int col = g * 256 + wc * 64 + n * 16 + 4 * fq;
            const v2u gt = *(const GAS v2u*)(Gt + token * 2048 + 1024 + col);
            const f32x4 sc = *(const GAS f32x4*)(pool_scale + col);
            const f32x4 v = acc[m][n];
            v2u o; o.x = pk2(v[0] * sc[0] * silu_f(bf_lo(gt.x)), v[1] * sc[1] * silu_f(bf_hi(gt.x))); o.y = pk2(v[2] * sc[2] * silu_f(bf_lo(gt.y)), v[3] * sc[3] * silu_f(bf_hi(gt.y)));
            *(GAS v2u*)(Y + token * 2048 + 1024 + col) = o;
        }
    }
    __syncthreads();
}

__device__ __forceinline__ void combine_phase(const bf16* O, const float* L, const bf16* Gt, bf16* Y, int vcu, int G, int tid) {
    const size_t gt = (size_t)vcu * (NWAVES * 64) + tid, NT = (size_t)G * (NWAVES * 64);
    constexpr size_t PST = (size_t)32 * 4096 * 128, LST = (size_t)32 * 4096;
    for (size_t idx = gt; idx < (size_t)32 * 4096 * 16; idx += NT) {
        const int c8 = (int)(idx & 15), t = (int)((idx >> 4) & 4095), bh = (int)(idx >> 16);
        const size_t oo = ((size_t)bh * 4096 + t) * 128 + c8 * 8, lo = (size_t)bh * 4096 + t;
        const v4u o1 = *(const GAS v4u*)(O + oo), o2 = *(const GAS v4u*)(O + PST + oo), o3 = *(const GAS v4u*)(O + 2 * PST + oo);
        const float l1 = L[lo], l2 = L[LST + lo], l3 = L[2 * LST + lo];
        const float mx = fmaxf(l1, fmaxf(l2, l3));
        float w1 = __builtin_amdgcn_exp2f(l1 - mx), w2 = __builtin_amdgcn_exp2f(l2 - mx), w3 = __builtin_amdgcn_exp2f(l3 - mx);
        const float inv = 1.f / (w1 + w2 + w3); w1 *= inv; w2 *= inv; w3 *= inv;
        const size_t yo = ((size_t)((bh >> 3) * 4096 + t)) * 2048 + (bh & 7) * 128 + c8 * 8;
        const v4u gv = *(const GAS v4u*)(Gt + yo);
        v4u out;
#define CMB(k) { const float a = (w1 * bf_lo(o1[k]) + w2 * bf_lo(o2[k]) + w3 * bf_lo(o3[k])) * silu_f(bf_lo(gv[k])); const float b = (w1 * bf_hi(o1[k]) + w2 * bf_hi(o2[k]) + w3 * bf_hi(o3[k])) * silu_f(bf_hi(gv[k])); out[k] = pk2(a, b); }
        CMB(0) CMB(1) CMB(2) CMB(3)
#undef CMB
        *(GAS v4u*)(Y + yo) = out;
    }
}

__device__ __forceinline__ void ln_phase(float* out, const float* gain, const float* bias, int vcu, int G, int wave, int lane) {
    const int gw = vcu * NWAVES + wave, NGW = G * NWAVES;
    for (int row = gw; row < M; row += NGW) {
        GAS f32x4* p = (GAS f32x4*)(out + (size_t)row * DM) + lane;
        f32x4 v[8]; float s = 0.f;
#pragma unroll
        for (int j = 0; j < 8; ++j) { v[j] = p[64 * j]; s += (v[j][0] + v[j][1]) + (v[j][2] + v[j][3]); }
#pragma unroll
        for (int o = 1; o < 64; o <<= 1) s += __shfl_xor(s, o);
        const float mean = s * (1.f / DM); float q = 0.f;
#pragma unroll
        for (int j = 0; j < 8; ++j) { v[j] = v[j] - mean; q += (v[j][0] * v[j][0] + v[j][1] * v[j][1]) + (v[j][2] * v[j][2] + v[j][3] * v[j][3]); }
#pragma unroll
        for (int o = 1; o < 64; o <<= 1) q += __shfl_xor(q, o);
        const float rstd = 1.f / sqrtf(q * (1.f / DM) + LN_EPS);
#pragma unroll
        for (int j = 0; j < 8; ++j) { const f32x4 gn = *((const GAS f32x4*)gain + lane + 64 * j), bs = *((const GAS f32x4*)bias + lane + 64 * j); p[64 * j] = v[j] * rstd * gn + bs; }
    }
}

struct Args { const float* x; const float* w_in; const float* w_pool; const float* pool_scale; const float* w_out; const float* ln_gain; const float* ln_bias; float* out; unsigned char* ws; int ph_lo, ph_hi; };
__global__ void __launch_bounds__(NWAVES * 64, 2) hybrid_fwd(Args args) {
    extern __shared__ __attribute__((aligned(16))) unsigned char lds_raw[];
    LAS unsigned char* lds = (LAS unsigned char*)lds_raw;
    volatile LAS unsigned* MISC = (volatile LAS unsigned*)(lds + MISC_OFF);
    const int tid = threadIdx.x, lane = tid & 63, wave = __builtin_amdgcn_readfirstlane(tid >> 6);
    const int G = gridDim.x; const int bx = blockIdx.x; const int vcu = (G % 8 == 0) ? (bx % 8) * (G / 8) + bx / 8 : bx;
    unsigned char* ws = args.ws;
    gu32* ctl = (gu32*)(ws + WS_CTL);
    for (int u = tid; u < (LDS_BYTES - LDSCTL_OFF) / 4; u += NWAVES * 64) ((LAS unsigned*)(lds + LDSCTL_OFF))[u] = 0u;
    __syncthreads();
    XcdBarrier bar; bar.bar = (unsigned*)(ctl + CW_BAR); bar.x = 0; bar.st = nullptr;
    if (N_LAUNCHES != PER_PHASE) bar = xcd_barrier_post((unsigned*)(ctl + CW_BAR), MISC + 8);
#define GRID_BAR() do { if (N_LAUNCHES != PER_PHASE) xcd_barrier(bar); } while (0)
    const int lo = (N_LAUNCHES == 1) ? 0 : args.ph_lo, hi = (N_LAUNCHES == 1) ? PER_PHASE : args.ph_hi;
#define IN(k) (lo <= (k) && (k) < hi)
#if MK_DUP_PHASE >= 0
#define REP(k) for (int rep_ = 0; rep_ < (DUP_PHASE == (k) ? 2 : 1); ++rep_)
#else
#define REP(k)
#endif
#define BOTH(k) (IN(k) && IN((k) + 1))
    bf16* XB = (bf16*)(ws + WS_XB); bf16* WinT = (bf16*)(ws + WS_WIN); bf16* WoutT = (bf16*)(ws + WS_WOUT); bf16* WpT = (bf16*)(ws + WS_WPT);
    bf16* QKV = (bf16*)(ws + WS_QKV); bf16* Ub = (bf16*)(ws + WS_U); bf16* Gb = (bf16*)(ws + WS_G); bf16* Ob = (bf16*)(ws + WS_O); float* Lb = (float*)(ws + WS_L); bf16* Yb = (bf16*)(ws + WS_Y);
    float* rope = (float*)(ws + WS_ROPE);

    REP(0) if (IN(0)) { int t_ = threadIdx.x; asm volatile("" : "+v"(t_)); p0_prologue(lds, args.x, args.w_in, args.w_pool, args.w_out, ws, vcu, G, t_, __builtin_amdgcn_readfirstlane(t_ >> 6), t_ & 63); if (BOTH(0)) GRID_BAR(); }

    REP(1) if (IN(1)) {
        pg8::Gemm g{XB, WinT, M, DIN, DM}; pg8::StaticOrder S; S.init(M, DIN, G, bx);
        pg8::EpiH E{QKV, Ub, Gb, rope, QSCALE};
        pg8::gemm_phase<pg8::EpiH, pg8::StaticOrder, true, true>(lds, g, S, E);
        if (BOTH(1)) GRID_BAR();
    }

    REP(2) if (IN(2)) {
        if (G == 256) {
            const int bh = vcu >> 3, j = vcu & 7;
            const bf16* Qh = QKV + (size_t)bh * 4096 * 128; const bf16* Kh = Qh + (size_t)32 * 4096 * 128; const bf16* Vh = Kh + (size_t)32 * 4096 * 128;
            att::Seam S;
            att::BlockRef cur, nxt;
#define MKREF(R, i) do { const int i_ = (i); \
                if (i_ < 2) { const int qb = 2 * j + i_; const size_t off = (size_t)qb * 256 * 128; \
                    R.Q = Qh + off; R.K = Kh; R.V = Vh; R.O = Ob + (size_t)bh * 4096 * 128 + off; R.L = Lb + (size_t)bh * 4096 + qb * 256; R.P0 = qb * 256; R.pitch = 128; R.lstride = 1; R.skv = 4096; } \
                else if (i_ < 4) { const int e = 2 * j + (i_ - 2), res = e >> 2, qb = e & 3; const size_t off = (size_t)res * 128 + (size_t)qb * 256 * 512; \
                    R.Q = Qh + off; R.K = Kh + res * 128; R.V = Vh + res * 128; R.O = Ob + (size_t)(32 + bh) * 4096 * 128 + off; R.L = Lb + (size_t)(32 + bh) * 4096 + res + qb * 1024; R.P0 = qb * 256; R.pitch = 512; R.lstride = 4; R.skv = 1024; } \
                else { const int res = 2 * j + (i_ - 4); const size_t off = (size_t)res * 128; \
                    R.Q = Qh + off; R.K = Kh + off; R.V = Vh + off; R.O = Ob + (size_t)(64 + bh) * 4096 * 128 + off; R.L = Lb + (size_t)(64 + bh) * 4096 + res; R.P0 = 0; R.pitch = 2048; R.lstride = 16; R.skv = 256; } } while (0)
            MKREF(cur, 0);
            att::swa_prime(cur, (char*)lds_raw, S);
            for (int i = 0; i < 6; ++i) {
                if (i < 5) MKREF(nxt, i + 1); else nxt = cur;
                att::swa_block(cur, nxt, (char*)lds_raw, S);
                cur = nxt;
            }
#undef MKREF
        }
        VM_WAIT(); __syncthreads();
        { int t_ = threadIdx.x; asm volatile("" : "+v"(t_)); const int w_ = __builtin_amdgcn_readfirstlane(t_ >> 6);
          for (int it = vcu; it < 512; it += G) pool_item(lds, Ub, Gb, WpT, args.pool_scale, Yb, it, t_, w_, t_ & 63); }
        if (BOTH(2)) GRID_BAR();
    }

    REP(3) if (IN(3)) { int t_ = threadIdx.x; asm volatile("" : "+v"(t_)); combine_phase(Ob, Lb, Gb, Yb, vcu, G, t_); if (BOTH(3)) GRID_BAR(); }

    REP(4) if (IN(4)) {
        pg8::Gemm g{Yb, WoutT, M, DM, DM}; pg8::StaticOrder S; S.init(M, DM, G, bx);
        pg8::EpiLN E{args.x, args.out, args.ln_gain, args.ln_bias, DN_ALPHA, LN_EPS, (unsigned long long*)(ws + WS_X), (unsigned*)(ctl + CW_PANEL)};
        pg8::gemm_phase<pg8::EpiLN, pg8::StaticOrder, true, true>(lds, g, S, E);
    }
#undef IN
#undef BOTH
#undef GRID_BAR
}

extern "C" void kernel_launch(void* const* d_in, const int* in_sizes, int n_in, void* d_out, int out_size, void* d_ws, size_t ws_size, hipStream_t stream) {
    static int grid = 0;
    if (grid == 0) {
        if (n_in != 7 || in_sizes[0] != M * DM || out_size != M * DM || ws_size < WS_END) { fprintf(stderr, "kernel_launch: shape mismatch (n_in %d in0 %d out %d ws %zu)\n", n_in, n_in > 0 ? in_sizes[0] : -1, out_size, ws_size); grid = -1; return; }
        int dev = 0, cus = 0, per_cu = 0;
        if (hipGetDevice(&dev) != hipSuccess || hipDeviceGetAttribute(&cus, hipDeviceAttributeMultiprocessorCount, dev) != hipSuccess) { fprintf(stderr, "kernel_launch: device query failed\n"); grid = -1; return; }
        if (hipFuncSetAttribute((const void*)hybrid_fwd, hipFuncAttributeMaxDynamicSharedMemorySize, LDS_BYTES) != hipSuccess) { fprintf(stderr, "kernel_launch: hipFuncSetAttribute failed\n"); grid = -1; return; }
        if (hipOccupancyMaxActiveBlocksPerMultiprocessor(&per_cu, (const void*)hybrid_fwd, NWAVES * 64, LDS_BYTES) != hipSuccess || per_cu < 1)
            fprintf(stderr, "kernel_launch: note: occupancy query reports %d workgroups per CU\n", per_cu);
        (void)hipGetLastError();
        grid = cus;
        if (grid != 256) fprintf(stderr, "kernel_launch: %d CUs: the attention phase is dealt for 256 workgroups\n", grid);
    }
    if (grid < 0) return;
    if (hipMemsetAsync((char*)d_ws + WS_CTL, 0, CTL_ZERO_BYTES, stream) != hipSuccess) { fprintf(stderr, "kernel_launch: memset failed\n"); return; }
    Args a{};
    a.x = (const float*)d_in[0]; a.w_in = (const float*)d_in[1]; a.w_pool = (const float*)d_in[2]; a.pool_scale = (const float*)d_in[3];
    a.w_out = (const float*)d_in[4]; a.ln_gain = (const float*)d_in[5]; a.ln_bias = (const float*)d_in[6]; a.out = (float*)d_out; a.ws = (unsigned char*)d_ws;
    for (int li = 0; li < N_LAUNCHES; ++li) {
        a.ph_lo = (N_LAUNCHES == PER_PHASE) ? li : 0; a.ph_hi = (N_LAUNCHES == PER_PHASE) ? li + 1 : PER_PHASE;
        hipLaunchKernelGGL(hybrid_fwd, dim3(grid), dim3(NWAVES * 64), LDS_BYTES, stream, a);
        const hipError_t le = hipPeekAtLastError();
        if (le != hipSuccess) { fprintf(stderr, "kernel_launch: launch %d failed: %s\n", li, hipGetErrorName(le)); break; }
    }
}
```

```cpp
#include <hip/hip_runtime.h>
#include <cstdio>
#include <cstdint>

#ifndef MK_N_LAUNCHES
#define MK_N_LAUNCHES 1
#endif

namespace pg8 {
#define PG8_LAS __attribute__((address_space(3)))
typedef unsigned short bf16_t;
typedef short bf16x8 __attribute__((ext_vector_type(8)));
typedef float f32x4 __attribute__((ext_vector_type(4)));
typedef unsigned u32x4 __attribute__((ext_vector_type(4)));
constexpr int BM = 256, BK = 64, HALF = 128, HTB = HALF * BK * 2  , STAGE_BYTES = 8 * HTB, NXCD = 8, WGM = 8;

__host__ __device__ __forceinline__ int lds_byte(int r, int c) { const int st = (r >> 4) * 2 + (c >> 5), rr = r & 15, cc = c & 31, ob = rr * 64 + cc * 2; return st * 1024 + (ob ^ (((ob >> 9) & 1) << 5)); }
__host__ __device__ __forceinline__ void stage_rc(int b, int& R, int& C) { const int st = b / 1024, sb = b % 1024, swz = sb ^ (((sb >> 9) & 1) << 5); R = (st >> 1) * 16 + swz / 64; C = (st & 1) * 32 + (swz % 64) / 2; }
__host__ __device__ __forceinline__ int perm32(int rho) { const int n = rho >> 4, i = rho & 15; return 8 * (i >> 2) + 4 * n + (i & 3); }

struct Unit { int pm, pn; };
struct Gemm { const bf16_t* A; const bf16_t* Bt; int M, N, K; };

struct StaticOrder {
    int nM, nN, nwg, G, c; bool rev = false;
    __host__ __device__ void init(int M, int N, int G_, int c_) { nM = M / BM; nN = N / BM; nwg = nM * nN; G = G_; c = c_; }
    __host__ __device__ bool next(int i, Unit& u) const {
        const long L = (long)i * G + c; if (L >= nwg) return false;
        int wgid = (int)L; { const int q = nwg / NXCD, r = nwg % NXCD, xcd = wgid % NXCD, off = wgid / NXCD; wgid = (xcd < r ? xcd * (q + 1) : r * (q + 1) + (xcd - r) * q) + off; }
        const int nig = WGM * nN, gid = wgid / nig, fm = gid * WGM, gsz = (nM - fm) < WGM ? (nM - fm) : WGM;
        u.pm = fm + ((wgid % nig) % gsz); u.pn = (wgid % nig) / gsz; if (rev) u.pn = nN - 1 - u.pn; return true;
    }
    __device__ __forceinline__ void a_ready(const Unit&) const {}
    __device__ __forceinline__ void done(const Unit&) const {}
};


__device__ __forceinline__ unsigned cvt_pk_bf16(float lo, float hi) { unsigned r; asm volatile("v_cvt_pk_bf16_f32 %0, %1, %2" : "=v"(r) : "v"(lo), "v"(hi)); return r; }

struct EpiH {
    static constexpr bool PERM = true, AFTER_DRAIN = false, LNX = false;
    bf16_t* QKV;
    bf16_t* U;
    bf16_t* G;
    const float* rope;
    float qscale;
    __device__ __forceinline__ void operator()(const f32x4 (&acc)[2][2][4][2], const Unit& u, int wr, int wc, int fr, int fq) const {
        const int pn = u.pn, row0 = u.pm * BM + wr * 64 + fr;
        if (pn < 12) {
            const int which = pn >> 2;
            const bool rot = (which < 2) && (wc == 0);
            const float sc = (which == 0) ? qscale : 1.f;
            const float sgn = (fq < 2) ? -1.f : 1.f;
#pragma unroll
            for (int ai = 0; ai < 2; ++ai)
#pragma unroll
                for (int m = 0; m < 4; ++m) {
                    const int row = row0 + ai * HALF + m * 16, b = row >> 12, t = row & 4095;
                    f32x4 cs[2], sn[2];
                    if (rot) {
#pragma unroll
                        for (int n = 0; n < 2; ++n) { cs[n] = *(const f32x4*)(rope + t * 16 + 8 * (fq & 1) + 4 * n); sn[n] = *(const f32x4*)(rope + 65536 + t * 16 + 8 * (fq & 1) + 4 * n); }
                    }
#pragma unroll
                    for (int bj = 0; bj < 2; ++bj) {
                        const int head = 2 * (pn & 3) + bj;
                        f32x4 v[2] = {acc[ai][bj][m][0], acc[ai][bj][m][1]};
                        if (rot) {
#pragma unroll
                            for (int n = 0; n < 2; ++n)
#pragma unroll
                                for (int j = 0; j < 4; ++j) { const float own = v[n][j], oth = __shfl_xor(own, 32); v[n][j] = own * cs[n][j] + sgn * oth * sn[n][j]; }
                        }
                        u32x4 w; w.x = cvt_pk_bf16(v[0][0] * sc, v[0][1] * sc); w.y = cvt_pk_bf16(v[0][2] * sc, v[0][3] * sc); w.z = cvt_pk_bf16(v[1][0] * sc, v[1][1] * sc); w.w = cvt_pk_bf16(v[1][2] * sc, v[1][3] * sc);
                        *(u32x4*)(QKV + ((size_t)((which * 32 + b * 8 + head) * 4096 + t)) * 128 + wc * 32 + 8 * fq) = w;
                    }
                }
        } else {
            bf16_t* base; int ldc, colt;
            if (pn < 16) { base = U; ldc = 1024; colt = (pn - 12) * BM; } else { base = G; ldc = 2048; colt = (pn - 16) * BM; }
            const int col0 = colt + wc * 32 + 8 * fq;
#pragma unroll
            for (int ai = 0; ai < 2; ++ai)
#pragma unroll
                for (int m = 0; m < 4; ++m) { bf16_t* rowp = base + (size_t)(row0 + ai * HALF + m * 16) * ldc + col0;
#pragma unroll
                    for (int bj = 0; bj < 2; ++bj) { const f32x4 v0 = acc[ai][bj][m][0], v1 = acc[ai][bj][m][1];
                        u32x4 w; w.x = cvt_pk_bf16(v0[0], v0[1]); w.y = cvt_pk_bf16(v0[2], v0[3]); w.z = cvt_pk_bf16(v1[0], v1[1]); w.w = cvt_pk_bf16(v1[2], v1[3]);
                        *(u32x4*)(rowp + bj * HALF) = w; } }
        }
    }
};
struct SchedLN {
    int c;
    __device__ __forceinline__ bool next(int i, Unit& u) const { if (i >= 2) return false; const int k = c >> 3; u.pn = k & 7; u.pm = i * 32 + (c & 7) * 4 + (k >> 3); return true; }
    __device__ __forceinline__ void a_ready(const Unit&) const {}
    __device__ __forceinline__ void done(const Unit&) const {}
};
struct EpiLN {
    static constexpr bool PERM = false, AFTER_DRAIN = false, LNX = true;
    const float* x; float* out; const float* gain; const float* bias; float alpha, eps;
    unsigned long long* xbuf;
    unsigned* cnt;
    typedef float f32x2v __attribute__((ext_vector_type(2)));
    __device__ __forceinline__ void lnx(f32x4 (&acc)[2][2][4][2], const Unit& u, bool, int wr, int wc, int fr, int fq, PG8_LAS unsigned char* lx, int wid, int lane) const {
        PG8_LAS f32x2v* P = (PG8_LAS f32x2v*)lx;
        PG8_LAS f32x2v* S = (PG8_LAS f32x2v*)(lx + 8192);
        const int row0 = u.pm * BM + wr * 64 + fr, col0 = u.pn * BM + wc * 32 + 4 * fq;
#pragma unroll
        for (int ai = 0; ai < 2; ++ai)
#pragma unroll
            for (int m = 0; m < 4; ++m) { const size_t off = (size_t)(row0 + ai * HALF + m * 16) * 2048 + col0;
#pragma unroll
                for (int bj = 0; bj < 2; ++bj)
#pragma unroll
                    for (int n = 0; n < 2; ++n) { const f32x4 xv = __builtin_nontemporal_load((const f32x4*)(x + off + bj * HALF + n * 16)); acc[ai][bj][m][n] = xv * alpha + acc[ai][bj][m][n]; }
                asm volatile("" : "+v"(acc[ai][0][m][0]), "+v"(acc[ai][0][m][1]), "+v"(acc[ai][1][m][0]), "+v"(acc[ai][1][m][1]));
                if (m & 1) asm volatile("" ::: "memory"); }
#pragma unroll
        for (int ai = 0; ai < 2; ++ai)
#pragma unroll
            for (int m = 0; m < 4; ++m) {
                float s = 0.f;
#pragma unroll
                for (int bj = 0; bj < 2; ++bj)
#pragma unroll
                    for (int n = 0; n < 2; ++n) { const f32x4 v = acc[ai][bj][m][n]; s += (v[0] + v[1]) + (v[2] + v[3]); }
                s += __shfl_xor(s, 16); s += __shfl_xor(s, 32);
                const float mw = s * (1.0f / 64.0f); float q = 0.f;
#pragma unroll
                for (int bj = 0; bj < 2; ++bj)
#pragma unroll
                    for (int n = 0; n < 2; ++n) { const f32x4 d = acc[ai][bj][m][n] - mw; q += (d[0] * d[0] + d[1] * d[1]) + (d[2] * d[2] + d[3] * d[3]); }
                q += __shfl_xor(q, 16); q += __shfl_xor(q, 32);
                if (fq == 0) P[(ai * HALF + wr * 64 + m * 16 + fr) * 4 + wc] = (f32x2v){mw, q};
            }
        asm volatile("s_waitcnt lgkmcnt(0)" ::: "memory"); __builtin_amdgcn_s_barrier(); asm volatile("" ::: "memory");
        const int row = wid * 32 + (lane & 31);
        if (lane < 32) {
            const f32x2v a = P[row * 4 + 0], b = P[row * 4 + 1], c = P[row * 4 + 2], d = P[row * 4 + 3];
            const float mt = (a.x + b.x + c.x + d.x) * 0.25f;
            const float da = a.x - mt, db = b.x - mt, dc = c.x - mt, dd = d.x - mt;
            const float m2 = (a.y + b.y) + (c.y + d.y) + 64.0f * ((da * da + db * db) + (dc * dc + dd * dd));
            unsigned long long* slot = xbuf + ((size_t)(u.pm * BM + row) * 8 + u.pn);
            __hip_atomic_store(slot, ((unsigned long long)__float_as_uint(m2) << 32) | __float_as_uint(mt), __ATOMIC_RELAXED, __HIP_MEMORY_SCOPE_AGENT);
        }
        asm volatile("s_waitcnt vmcnt(0)" ::: "memory");
        if (lane == 0) __hip_atomic_fetch_add(cnt + 64 * u.pm, 1u, __ATOMIC_RELAXED, __HIP_MEMORY_SCOPE_AGENT);
        if (wid == 0) {
            unsigned polls = 0;
            while ((unsigned)__builtin_amdgcn_readfirstlane(__hip_atomic_load(cnt + 64 * u.pm, __ATOMIC_RELAXED, __HIP_MEMORY_SCOPE_AGENT)) < 64u) {
                if (++polls > (1u << 22)) break;
                __builtin_amdgcn_s_sleep(2); }
            __builtin_amdgcn_fence(__ATOMIC_ACQUIRE, "agent");
        }
        asm volatile("s_waitcnt vmcnt(0) lgkmcnt(0)" ::: "memory"); __builtin_amdgcn_s_barrier(); asm volatile("" ::: "memory");
        if (lane < 32) {
            const unsigned long long* slot = xbuf + (size_t)(u.pm * BM + row) * 8; float mm[8], qq[8]; float ms = 0.f;
#pragma unroll
            for (int t = 0; t < 8; ++t) { const unsigned long long w = __hip_atomic_load(slot + t, __ATOMIC_RELAXED, __HIP_MEMORY_SCOPE_AGENT); mm[t] = __uint_as_float((unsigned)w); qq[t] = __uint_as_float((unsigned)(w >> 32)); ms += mm[t]; }
            const float mean = ms * 0.125f; float q = 0.f;
#pragma unroll
            for (int t = 0; t < 8; ++t) { const float dm = mm[t] - mean; q += qq[t] + 256.0f * dm * dm; }
            S[row] = (f32x2v){mean, 1.0f / sqrtf(q * (1.0f / 2048.0f) + eps)};
        }
        asm volatile("s_waitcnt lgkmcnt(0)" ::: "memory"); __builtin_amdgcn_s_barrier(); asm volatile("" ::: "memory");
        f32x4 gn[2][2], bs[2][2];
#pragma unroll
        for (int bj = 0; bj < 2; ++bj)
#pragma unroll
            for (int n = 0; n < 2; ++n) { gn[bj][n] = *(const f32x4*)(gain + col0 + bj * HALF + n * 16); bs[bj][n] = *(const f32x4*)(bias + col0 + bj * HALF + n * 16); }
#pragma unroll
        for (int ai = 0; ai < 2; ++ai)
#pragma unroll
            for (int m = 0; m < 4; ++m) { const int r = ai * HALF + wr * 64 + m * 16 + fr; const f32x2v sr = S[r]; const size_t off = (size_t)(u.pm * BM + r) * 2048 + col0;
#pragma unroll
                for (int bj = 0; bj < 2; ++bj)
#pragma unroll
                    for (int n = 0; n < 2; ++n) __builtin_nontemporal_store((acc[ai][bj][m][n] - sr.x) * sr.y * gn[bj][n] + bs[bj][n], (f32x4*)(out + off + bj * HALF + n * 16)); }
    }
};

struct SchedOne {
    __device__ __forceinline__ bool next(int i, Unit& u) const { if (i != 0) return false; u.pm = 0; u.pn = 0; return true; }
    __device__ __forceinline__ void a_ready(const Unit&) const {}
    __device__ __forceinline__ void done(const Unit&) const {}
};
struct EpiW {
    static constexpr bool PERM = true, AFTER_DRAIN = false, LNX = false;
    bf16_t* O;
    __device__ __forceinline__ void operator()(const f32x4 (&acc)[2][2][4][2], const Unit&, int wr, int wc, int fr, int fq) const {
        const int row0 = wr * 64 + fr, col0 = wc * 32 + 8 * fq;
#pragma unroll
        for (int ai = 0; ai < 2; ++ai)
#pragma unroll
            for (int m = 0; m < 4; ++m) { bf16_t* rowp = O + (size_t)(row0 + ai * HALF + m * 16) * 2048 + col0;
#pragma unroll
                for (int bj = 0; bj < 2; ++bj) { const f32x4 v0 = acc[ai][bj][m][0], v1 = acc[ai][bj][m][1];
                    u32x4 w; w.x = cvt_pk_bf16(v0[0], v0[1]); w.y = cvt_pk_bf16(v0[2], v0[3]); w.z = cvt_pk_bf16(v1[0], v1[1]); w.w = cvt_pk_bf16(v1[2], v1[3]);
                    *(u32x4*)(rowp + bj * HALF) = w; } }
    }
};

template <class Epi, class Sched, bool ALIGN_EPI = false, bool SP2 = false>
__device__ __forceinline__ void gemm_phase(PG8_LAS unsigned char* lds, const Gemm g, const Sched& S, const Epi& E) {
    int tid_ = threadIdx.x; asm volatile("" : "+v"(tid_));
    const int tid = tid_, wid = __builtin_amdgcn_readfirstlane(tid >> 6), lane = tid & 63, wr = wid >> 2, wc = wid & 3, fr = lane & 15, fq = lane >> 4;
    const int K = g.K, nt = K / BK;
    unsigned voffA[2], voffB[2];
#pragma unroll
    for (int i = 0; i < 2; ++i) { int R, C; stage_rc(tid * 16 + i * 8192, R, C); const int Rb = Epi::PERM ? ((R & ~31) + perm32(R & 31)) : R;
        voffA[i] = (unsigned)(R * K + C) * 2u; voffB[i] = (unsigned)(Rb * K + C) * 2u; }
    const size_t kstep = (size_t)(BK * 2);
    const size_t hstep = (size_t)HALF * K * 2;
    const size_t tstep = 2 * hstep;
    const unsigned ldsw = (unsigned)wid * 1024u;
    const int aoff = lds_byte(wr * 64 + fr, fq * 8), boff = lds_byte(wc * 32 + fr, fq * 8);
#define PG8_SA(b, h) (((b) * 2 + (h)) * HTB)
#define PG8_SB(b, h) ((4 + (b) * 2 + (h)) * HTB)
#define PG8_STAGE(bufoff, gbase, voff) do { _Pragma("unroll") for (int _i = 0; _i < 2; ++_i) \
        __builtin_amdgcn_global_load_lds((const unsigned*)((const char*)(gbase) + (voff)[_i]), (PG8_LAS unsigned*)(lds + (bufoff) + ldsw + _i * 8192), 16, 0, 0); } while (0)
#define PG8_LDA(dst, b, h) do { _Pragma("unroll") for (int m = 0; m < 4; ++m) _Pragma("unroll") for (int k = 0; k < 2; ++k) dst[m][k] = *(const PG8_LAS bf16x8*)(lds + PG8_SA(b, h) + aoff + m * 2048 + k * 1024); } while (0)
#define PG8_LDB(dst, b, h) do { _Pragma("unroll") for (int n = 0; n < 2; ++n) _Pragma("unroll") for (int k = 0; k < 2; ++k) dst[n][k] = *(const PG8_LAS bf16x8*)(lds + PG8_SB(b, h) + boff + n * 2048 + k * 1024); } while (0)
#define PG8_MMA(ai, bj, At, Bt) do { __builtin_amdgcn_s_setprio(1); _Pragma("unroll") for (int m = 0; m < 4; ++m) _Pragma("unroll") for (int n = 0; n < 2; ++n) _Pragma("unroll") for (int k = 0; k < 2; ++k) \
        acc[ai][bj][m][n] = __builtin_amdgcn_mfma_f32_16x16x32_bf16(Bt[n][k], At[m][k], acc[ai][bj][m][n], 0, 0, 0); __builtin_amdgcn_s_setprio(0); } while (0)
#define PG8_WAIT_V(n) asm volatile("s_waitcnt vmcnt(" #n ")" ::: "memory")
#define PG8_WAIT_L(n) asm volatile("s_waitcnt lgkmcnt(" #n ")" ::: "memory")
#define PG8_BAR __builtin_amdgcn_s_barrier()
#define PG8_SCHED __builtin_amdgcn_sched_barrier(0)
    Unit cur, nxt; int ui = 0;
    if (!S.next(0, cur)) return;
    f32x4 acc[2][2][4][2];
#pragma unroll
    for (int a = 0; a < 2; ++a)
#pragma unroll
        for (int b = 0; b < 2; ++b)
#pragma unroll
            for (int m = 0; m < 4; ++m)
#pragma unroll
                for (int n = 0; n < 2; ++n) acc[a][b][m][n] = (f32x4){0.f, 0.f, 0.f, 0.f};
    bf16x8 At[4][2], B0[2][2], B1[2][2];
    const char* cA = (const char*)g.A + (size_t)cur.pm * tstep; const char* cB = (const char*)g.Bt + (size_t)cur.pn * tstep;
    S.a_ready(cur);
    if constexpr (SP2) {
        PG8_STAGE(PG8_SB(0, 0), cB, voffB); PG8_STAGE(PG8_SB(0, 1), cB + hstep, voffB); PG8_STAGE(PG8_SA(0, 0), cA, voffA); PG8_STAGE(PG8_SA(0, 1), cA + hstep, voffA);
        if (wr == 1) PG8_BAR;
        PG8_WAIT_V(2); PG8_BAR;
        PG8_STAGE(PG8_SB(1, 0), cB + kstep, voffB); PG8_STAGE(PG8_SA(1, 0), cA + kstep, voffA); PG8_STAGE(PG8_SB(1, 1), cB + hstep + kstep, voffB);
        PG8_WAIT_V(6); PG8_BAR;
    } else {
        PG8_STAGE(PG8_SB(0, 0), cB, voffB); PG8_STAGE(PG8_SA(0, 0), cA, voffA); PG8_STAGE(PG8_SB(0, 1), cB + hstep, voffB); PG8_STAGE(PG8_SA(0, 1), cA + hstep, voffA);
        if (wr == 1) PG8_BAR;
        PG8_WAIT_V(4); PG8_BAR;
        PG8_STAGE(PG8_SB(1, 0), cB + kstep, voffB); PG8_STAGE(PG8_SA(1, 0), cA + kstep, voffA); PG8_STAGE(PG8_SB(1, 1), cB + hstep + kstep, voffB);
        PG8_WAIT_V(6); PG8_BAR;
    }
    for (;;) {
        const bool has_next = S.next(ui + 1, nxt);
        const char* nA = has_next ? (const char*)g.A + (size_t)nxt.pm * tstep : cA; const char* nB = has_next ? (const char*)g.Bt + (size_t)nxt.pn * tstep : cB;
        for (int t = 0; t < nt; t += 2) {
            const bool last = (t == nt - 2);
            const char* a1 = cA + (size_t)(t + 1) * kstep;
            const char* a2 = last ? nA : cA + (size_t)(t + 2) * kstep; const char* b2 = last ? nB : cB + (size_t)(t + 2) * kstep;
            const char* a3 = a2 + kstep; const char* b3 = b2 + kstep;
            if (last && has_next) S.a_ready(nxt);
            if constexpr (SP2) {
            PG8_LDB(B0, 0, 0); PG8_LDB(B1, 0, 1); PG8_SCHED; PG8_LDA(At, 0, 0); PG8_STAGE(PG8_SA(1, 1), a1 + hstep, voffA);
            PG8_WAIT_V(8); PG8_WAIT_L(0); PG8_BAR; PG8_MMA(0, 0, At, B0); PG8_MMA(0, 1, At, B1); PG8_BAR; PG8_SCHED;
            PG8_LDA(At, 0, 1); PG8_STAGE(PG8_SB(0, 0), b2, voffB); PG8_STAGE(PG8_SB(0, 1), b2 + hstep, voffB); PG8_STAGE(PG8_SA(0, 0), a2, voffA);
            PG8_WAIT_V(8); PG8_WAIT_L(0); PG8_BAR; PG8_MMA(1, 0, At, B0); PG8_MMA(1, 1, At, B1); PG8_BAR; PG8_SCHED;
            PG8_LDB(B0, 1, 0); PG8_LDB(B1, 1, 1); PG8_SCHED; PG8_LDA(At, 1, 0); PG8_STAGE(PG8_SA(0, 1), a2 + hstep, voffA);
            PG8_WAIT_V(8); PG8_WAIT_L(0); PG8_BAR; PG8_MMA(0, 0, At, B0); PG8_MMA(0, 1, At, B1); PG8_BAR; PG8_SCHED;
            PG8_LDA(At, 1, 1); PG8_STAGE(PG8_SB(1, 0), b3, voffB); PG8_STAGE(PG8_SB(1, 1), b3 + hstep, voffB); PG8_STAGE(PG8_SA(1, 0), a3, voffA);
            PG8_WAIT_V(8); PG8_WAIT_L(0); PG8_BAR; PG8_MMA(1, 0, At, B0); PG8_MMA(1, 1, At, B1); PG8_BAR; PG8_SCHED;
            } else {
            PG8_LDB(B0, 0, 0); PG8_SCHED; PG8_LDA(At, 0, 0); PG8_STAGE(PG8_SA(1, 1), a1 + hstep, voffA);
            PG8_WAIT_L(8); PG8_BAR; PG8_WAIT_L(0); PG8_MMA(0, 0, At, B0); PG8_BAR; PG8_SCHED;
            PG8_LDB(B1, 0, 1); PG8_STAGE(PG8_SB(0, 0), b2, voffB);
            PG8_BAR; PG8_WAIT_L(0); PG8_MMA(0, 1, At, B1); PG8_BAR;
            PG8_LDA(At, 0, 1); PG8_STAGE(PG8_SA(0, 0), a2, voffA);
            PG8_BAR; PG8_WAIT_L(0); PG8_MMA(1, 0, At, B0); PG8_BAR; PG8_SCHED;
            PG8_STAGE(PG8_SB(0, 1), b2 + hstep, voffB);
            PG8_WAIT_V(6); PG8_BAR; PG8_MMA(1, 1, At, B1); PG8_BAR;
            PG8_LDB(B0, 1, 0); PG8_SCHED; PG8_LDA(At, 1, 0); PG8_STAGE(PG8_SA(0, 1), a2 + hstep, voffA);
            PG8_WAIT_L(8); PG8_BAR; PG8_WAIT_L(0); PG8_MMA(0, 0, At, B0); PG8_BAR; PG8_SCHED;
            PG8_LDB(B1, 1, 1); PG8_STAGE(PG8_SB(1, 0), b3, voffB);
            PG8_BAR; PG8_WAIT_L(0); PG8_MMA(0, 1, At, B1); PG8_BAR;
            PG8_LDA(At, 1, 1); PG8_STAGE(PG8_SA(1, 0), a3, voffA);
            PG8_BAR; PG8_WAIT_L(0); PG8_MMA(1, 0, At, B0); PG8_BAR; PG8_SCHED;
            PG8_STAGE(PG8_SB(1, 1), b3 + hstep, voffB);
            PG8_WAIT_V(6); PG8_BAR; PG8_MMA(1, 1, At, B1); PG8_BAR;
            }
        }
        if constexpr (ALIGN_EPI) { if (wr == 0) PG8_BAR; }
        if constexpr (Epi::LNX) { E.lnx(acc, cur, !has_next, wr, wc, fr, fq, lds + STAGE_BYTES, wid, lane); } else if constexpr (!Epi::AFTER_DRAIN) { E(acc, cur, wr, wc, fr, fq); S.done(cur); }
        if (!has_next) break;
#pragma unroll
        for (int a = 0; a < 2; ++a)
#pragma unroll
            for (int b = 0; b < 2; ++b)
#pragma unroll
                for (int m = 0; m < 4; ++m)
#pragma unroll
                    for (int n = 0; n < 2; ++n) acc[a][b][m][n] = (f32x4){0.f, 0.f, 0.f, 0.f};
        cur = nxt; cA = nA; cB = nB; ++ui;
        if constexpr (ALIGN_EPI) { if (wr == 1) PG8_BAR; }
    }
    PG8_WAIT_V(0);
    if constexpr (!ALIGN_EPI) { if (wr == 0) PG8_BAR; }
    PG8_BAR;
    if constexpr (Epi::AFTER_DRAIN) { E.fused(acc, cur, wr, wc, fr, fq, lds, wid, lane); S.done(cur); }
#undef PG8_SA
#undef PG8_SB
#undef PG8_STAGE
#undef PG8_LDA
#undef PG8_LDB
#undef PG8_MMA
#undef PG8_WAIT_V
#undef PG8_WAIT_L
#undef PG8_BAR
#undef PG8_SCHED
}
}

namespace att {
typedef unsigned short bf16_t;
typedef short bf16x8 __attribute__((ext_vector_type(8)));
typedef short s16x4 __attribute__((ext_vector_type(4)));
typedef float f32x16 __attribute__((ext_vector_type(16)));
typedef float f32x4 __attribute__((ext_vector_type(4)));
typedef unsigned u32x4 __attribute__((ext_vector_type(4)));
constexpr int D = 128, NW = 8, QBLK = 32, KVBLK = 64, QB = NW * QBLK;
constexpr int SHM_V = KVBLK * D * 2, SHM_K = KVBLK * D * 2;
constexpr int LDS_BYTES = 4 * SHM_V + 4 * SHM_K + NW * 64 * 4;
constexpr float THR = 8.f;
constexpr int W = 129;

#define KSWZ(row, colB) ((row) * 256 + ((colB) ^ (((row) & 7) << 4)))
#define SBAR() __builtin_amdgcn_sched_barrier(0)
__device__ __forceinline__ int v_st(int k, int c) { const int kk = (k & ~0xC) | ((k & 4) << 1) | ((k & 8) >> 1); return ((kk >> 3) * 4 + (c >> 5)) * 512 + ((kk & 7) * 32 + (c & 31)) * 2; }
__device__ __forceinline__ int v_rd_base(int lane) { return ((lane & 3) << 3) | (((lane >> 2) & 3) << 6) | (((lane >> 4) & 1) << 5) | (((lane >> 5) & 1) << 8); }
constexpr int v_rd_off(int d0, int ks, int half) { return d0 * 512 + ks * 4096 + half * 2048; }
__device__ __forceinline__ int crow(int r, int hi) { return (r & 3) + 8 * (r >> 2) + 4 * hi; }
__device__ __forceinline__ unsigned cvtpk(float lo, float hi) { unsigned r; asm volatile("v_cvt_pk_bf16_f32 %0, %1, %2" : "=v"(r) : "v"(lo), "v"(hi)); return r; }
__device__ __forceinline__ bf16x8 load8(const bf16_t* p) { return *reinterpret_cast<const bf16x8*>(p); }
__device__ __forceinline__ void mask_tile(f32x16& p0, f32x16& p1, int dq, unsigned Wm) {
    const float NEG = -__builtin_inff();
#pragma unroll
    for (int r = 0; r < 16; ++r) {
        const int c = (r & 3) + 8 * (r >> 2);
        if ((unsigned)(dq - c) >= Wm) p0[r] = NEG;
        if ((unsigned)(dq - c - 32) >= Wm) p1[r] = NEG;
    }
}
__device__ __forceinline__ void partialSM(f32x16& p0, f32x16& p1, float& m_reg, float& mn, float& alpha) {
    float pmax = p0[0]; for (int r = 1; r < 16; ++r) pmax = fmaxf(pmax, p0[r]); for (int r = 0; r < 16; ++r) pmax = fmaxf(pmax, p1[r]);
    { auto rr = __builtin_amdgcn_permlane32_swap(__float_as_uint(pmax), __float_as_uint(pmax), false, false);
      pmax = fmaxf(__uint_as_float(rr[0]), __uint_as_float(rr[1])); }
    if (__builtin_expect(__all((pmax - m_reg) <= THR), 1)) { mn = m_reg; alpha = 1.f; }
    else { mn = fmaxf(m_reg, pmax); alpha = __builtin_amdgcn_exp2f(m_reg - mn); m_reg = mn; }
    for (int r = 0; r < 16; ++r) p0[r] = p0[r] - mn; for (int r = 0; r < 16; ++r) p1[r] = p1[r] - mn;
    for (int r = 0; r < 16; ++r) p0[r] = __builtin_amdgcn_exp2f(p0[r]);
}
__device__ __forceinline__ void finishSM(f32x16& p0, f32x16& p1, float alpha, float& l_reg, bf16x8& pa0, bf16x8& pa1, bf16x8& pa2, bf16x8& pa3) {
    for (int r = 0; r < 16; ++r) p1[r] = __builtin_amdgcn_exp2f(p1[r]);
    float ps = 0; for (int r = 0; r < 16; ++r) ps += p0[r]; for (int r = 0; r < 16; ++r) ps += p1[r];
    { auto rr = __builtin_amdgcn_permlane32_swap(__float_as_uint(ps), __float_as_uint(ps), false, false);
      ps = __uint_as_float(rr[0]) + __uint_as_float(rr[1]); }
    l_reg = l_reg * alpha + ps;
#define PK4(P, B_, OUT) do { unsigned a0 = cvtpk(P[B_+0], P[B_+1]), a1 = cvtpk(P[B_+2], P[B_+3]);                          \
        unsigned b0 = cvtpk(P[B_+4], P[B_+5]), b1 = cvtpk(P[B_+6], P[B_+7]);                                             \
        auto r0 = __builtin_amdgcn_permlane32_swap(a0, b0, false, false); auto r1 = __builtin_amdgcn_permlane32_swap(a1, b1, false, false); \
        u32x4 w = {r0[0], r1[0], r0[1], r1[1]}; OUT = *reinterpret_cast<bf16x8*>(&w); } while (0)
    PK4(p0, 0, pa0); PK4(p0, 8, pa1); PK4(p1, 0, pa2); PK4(p1, 8, pa3);
#undef PK4
}
template <int KB>
__device__ __forceinline__ void qkt(f32x16& p0, f32x16& p1, const char* K_lds, int r32, int hi, const bf16x8* qr, bool act) {
    if (!act) { const float NEG = -__builtin_inff();
#pragma unroll
        for (int r = 0; r < 16; ++r) { p0[r] = NEG; p1[r] = NEG; } return; }
    p0 = f32x16{}; p1 = f32x16{};
    const char* kb[4];
#pragma unroll
    for (int dd = 0; dd < 4; ++dd) kb[dd] = K_lds + KB * SHM_K + KSWZ(r32, (dd * 16 + hi * 8) * 2);
#pragma unroll
    for (int d0 = 0; d0 < 8; ++d0) { const char* a = kb[d0 & 3] + (d0 >> 2) * 128;
        bf16x8 b0 = *reinterpret_cast<const bf16x8*>(a);
        bf16x8 b1 = *reinterpret_cast<const bf16x8*>(a + 32 * 256);
        p0 = __builtin_amdgcn_mfma_f32_32x32x16_bf16(b0, qr[d0], p0, 0, 0, 0);
        p1 = __builtin_amdgcn_mfma_f32_32x32x16_bf16(b1, qr[d0], p1, 0, 0, 0); }
}
template <int VB>
__device__ __forceinline__ void pv_tile(f32x16* o, int vb0, bf16x8 pa0, bf16x8 pa1, bf16x8 pa2, bf16x8 pa3, bool act) {
    if (!act) return;
#define TRRD(dst, off) asm volatile("ds_read_b64_tr_b16 %0, %1 offset:%2" : "=&v"(dst) : "v"(vb0), "i"(off) : "memory")
#define PV_D0(d0) do { s16x4 l0, l1, l2, l3, h0, h1, h2, h3; constexpr int b_ = VB * SHM_V + v_rd_off(d0, 0, 0);     \
        TRRD(l0, b_); TRRD(h0, b_ + 2048); TRRD(l1, b_ + 4096); TRRD(h1, b_ + 6144); TRRD(l2, b_ + 8192); TRRD(h2, b_ + 10240); TRRD(l3, b_ + 12288); TRRD(h3, b_ + 14336); \
        asm volatile("s_waitcnt lgkmcnt(0)" ::: "memory"); SBAR();                 \
        o[d0] = __builtin_amdgcn_mfma_f32_32x32x16_bf16(pa0, (bf16x8){l0[0], l0[1], l0[2], l0[3], h0[0], h0[1], h0[2], h0[3]}, o[d0], 0, 0, 0);   \
        o[d0] = __builtin_amdgcn_mfma_f32_32x32x16_bf16(pa1, (bf16x8){l1[0], l1[1], l1[2], l1[3], h1[0], h1[1], h1[2], h1[3]}, o[d0], 0, 0, 0);   \
        o[d0] = __builtin_amdgcn_mfma_f32_32x32x16_bf16(pa2, (bf16x8){l2[0], l2[1], l2[2], l2[3], h2[0], h2[1], h2[2], h2[3]}, o[d0], 0, 0, 0);   \
        o[d0] = __builtin_amdgcn_mfma_f32_32x32x16_bf16(pa3, (bf16x8){l3[0], l3[1], l3[2], l3[3], h3[0], h3[1], h3[2], h3[3]}, o[d0], 0, 0, 0); } while (0)
    PV_D0(0); PV_D0(1); PV_D0(2); PV_D0(3);
#undef PV_D0
#undef TRRD
}

struct BlockRef { const bf16_t* Q; const bf16_t* K; const bf16_t* V; bf16_t* O; float* L; int P0, pitch, lstride, skv, chain; };
struct Seam { bf16x8 qr[8]; int v; };
typedef __attribute__((address_space(3))) unsigned char lds_u8;
__device__ __forceinline__ int swa_jlo(int P0) { const int lowk = P0 - W + 1; return lowk > 0 ? lowk / KVBLK : 0; }
__device__ __forceinline__ void dma_tile(lds_u8* ldsL, const bf16_t* Kp, const bf16_t* Vp, int pitch, int key0, int slot, int wid, int lane) {
#pragma unroll
    for (int i = 0; i < 2; ++i) {
        const int r = wid * 8 + i * 4 + (lane >> 4), c = (lane & 15) ^ (r & 7);
        __builtin_amdgcn_global_load_lds((const unsigned*)(Kp + (size_t)(key0 + r) * (size_t)pitch + c * 8), (__attribute__((address_space(3))) unsigned*)(ldsL + slot * SHM_K + wid * 2048 + i * 1024), 16, 0, 0);
    }
#pragma unroll
    for (int i = 0; i < 2; ++i) {
        const int ip = 2 * wid + i, sub = 2 * ip + (lane >> 5), kk = (sub >> 2) * 8 + ((lane & 31) >> 2), k = (kk & ~0xC) | ((kk & 4) << 1) | ((kk & 8) >> 1), c = (sub & 3) * 32 + (lane & 3) * 8;
        __builtin_amdgcn_global_load_lds((const unsigned*)(Vp + (size_t)(key0 + k) * (size_t)pitch + c), (__attribute__((address_space(3))) unsigned*)(ldsL + 4 * SHM_K + slot * SHM_V + ip * 1024), 16, 0, 0);
    }
}
#define VMWN(n) asm volatile("s_waitcnt vmcnt(" #n ")" ::: "memory")
#define LBAR() asm volatile("s_waitcnt lgkmcnt(0)\n\ts_barrier" ::: "memory")
__device__ __forceinline__ void swa_prime(const BlockRef& cur, lds_u8* ldsL, Seam& S) {
    int tid_ = threadIdx.x; asm volatile("" : "+v"(tid_));
    const int tid = tid_, wid = __builtin_amdgcn_readfirstlane(tid >> 6), lane = tid & 63, r32 = lane & 31, hi = lane >> 5;
    const int kb0 = swa_jlo(cur.P0) * KVBLK;
    dma_tile(ldsL, cur.K, cur.V, cur.pitch, kb0, 0, wid, lane);
    dma_tile(ldsL, cur.K, cur.V, cur.pitch, kb0 + KVBLK, 1, wid, lane);
    for (int d0 = 0; d0 < 8; ++d0) S.qr[d0] = load8(cur.Q + (size_t)(wid * QBLK + r32) * (size_t)cur.pitch + d0 * 16 + hi * 8);
    S.v = 0;
    VMWN(0); LBAR();
}
#define KRD(dst, base, off) asm volatile("ds_read_b128 %0, %1 offset:%2" : "=v"(dst) : "v"(base), "i"(off) : "memory")
__device__ __forceinline__ void qkt_rt(f32x16& p0, f32x16& p1, const char* K_lds, int kso, int r32, int hi, const bf16x8* qr, bool act) {
    if (!act) { const float NEG = -__builtin_inff();
#pragma unroll
        for (int r = 0; r < 16; ++r) { p0[r] = NEG; p1[r] = NEG; } return; }
    p0 = f32x16{}; p1 = f32x16{};
    int kb[4];
#pragma unroll
    for (int dd = 0; dd < 4; ++dd) kb[dd] = (int)(uintptr_t)K_lds + kso + KSWZ(r32, (dd * 16 + hi * 8) * 2);
    bf16x8 fa[3], fb[3];
#define KLOAD(d0_, s_) do { if (((d0_) >> 2) == 0) { KRD(fa[s_], kb[(d0_) & 3], 0); KRD(fb[s_], kb[(d0_) & 3], 8192); } else { KRD(fa[s_], kb[(d0_) & 3], 128); KRD(fb[s_], kb[(d0_) & 3], 8320); } } while (0)
    KLOAD(0, 0); KLOAD(1, 1);
#pragma unroll
    for (int d0 = 0; d0 < 8; ++d0) {
        if (d0 + 2 < 8) { KLOAD(d0 + 2, (d0 + 2) % 3); asm volatile("s_waitcnt lgkmcnt(4)" ::: "memory"); }
        else if (d0 + 1 < 8) asm volatile("s_waitcnt lgkmcnt(2)" ::: "memory");
        else asm volatile("s_waitcnt lgkmcnt(0)" ::: "memory");
        SBAR();
        p0 = __builtin_amdgcn_mfma_f32_32x32x16_bf16(fa[d0 % 3], qr[d0], p0, 0, 0, 0);
        p1 = __builtin_amdgcn_mfma_f32_32x32x16_bf16(fb[d0 % 3], qr[d0], p1, 0, 0, 0);
        SBAR();
    }
#undef KLOAD
}
#undef KRD
__device__ __forceinline__ void swa_block(const BlockRef& cur, const BlockRef& nxt, bool has_next, char* lds, lds_u8* ldsL, Seam& S) {
    int tid_ = threadIdx.x; asm volatile("" : "+v"(tid_));
    const int tid = tid_, wid = __builtin_amdgcn_readfirstlane(tid >> 6), lane = tid & 63, r32 = lane & 31, hi = lane >> 5;
    const int j_lo = swa_jlo(cur.P0);
    int j_hi = (cur.P0 + QB - 1) / KVBLK + 1; if (j_hi > cur.skv / KVBLK) j_hi = cur.skv / KVBLK;
    const int NT = j_hi - j_lo;
    const int kbn = swa_jlo(nxt.P0) * KVBLK;
    const int qlo = cur.P0 + wid * QBLK, qm = qlo + r32 - 4 * hi;
    const int v0 = S.v;
    const bool chain = has_next && cur.chain != 0, pre = has_next && cur.chain == 0;
    char* K_lds = lds;
    float* ws = (float*)(lds + 4 * SHM_V + 4 * SHM_K) + wid * 64; float* li_l = ws, * al_l = ws + 32;
    float m_reg = -1e30f, l_reg = 0; f32x16 o[4] = {};
    const int vb0 = (int)(uintptr_t)lds + 4 * SHM_K + v_rd_base(lane);
    const bf16_t* Kh = cur.K; const bf16_t* Vh = cur.V; const int pit = cur.pitch;
#define RESC(a) do { if (__any((a) < 1.f)) { if (hi == 0) al_l[r32] = (a); asm volatile("s_waitcnt lgkmcnt(0)" ::: "memory");              \
                     for (int d_ = 0; d_ < 4; ++d_) for (int r = 0; r < 16; ++r) o[d_][r] *= al_l[crow(r, hi)]; } } while (0)
#define KBASE(t) ((j_lo + (t)) * KVBLK)
#define ACT(t) (KBASE(t) <= qlo + QBLK - 1 && KBASE(t) + KVBLK - 1 >= qlo - W + 1)
#define MASKT(P0_, P1_, t) do { const int kb_ = KBASE(t); if (ACT(t) && (kb_ + KVBLK - 1 > qlo || kb_ <= qlo + QBLK - 1 - W)) mask_tile(P0_, P1_, qm - kb_, (unsigned)W); } while (0)
#define SLOT(t) ((v0 + (t)) & 3)
#define ISSUE(t) do { const int tt_ = (t); if (tt_ < NT) dma_tile(ldsL, Kh, Vh, pit, KBASE(tt_), SLOT(tt_), wid, lane); \
                      else if (pre) dma_tile(ldsL, nxt.K, nxt.V, nxt.pitch, kbn + (tt_ - NT) * KVBLK, SLOT(tt_), wid, lane); } while (0)
#define WAITBAR(t) do { if ((t) + 2 < NT || pre) VMWN(4); else VMWN(0); LBAR(); } while (0)
    f32x16 pA0, pA1, pB0, pB1; float mnA, mnB, alA, alB; bf16x8 pa0, pa1, pa2, pa3;
    SBAR(); qkt_rt(pA0, pA1, K_lds, SLOT(0) * SHM_K, r32, hi, S.qr, ACT(0)); SBAR();
    ISSUE(2);
    MASKT(pA0, pA1, 0); partialSM(pA0, pA1, m_reg, mnA, alA);
    WAITBAR(0);
#define HALF_STEP(PX0, PX1, mnX, alX, PY0, PY1, alY, t) do {                                                                  \
        ISSUE((t) + 2);                                                                                                       \
        SBAR(); qkt_rt(PX0, PX1, K_lds, SLOT(t) * SHM_K, r32, hi, S.qr, ACT(t));                                             \
        finishSM(PY0, PY1, alY, l_reg, pa0, pa1, pa2, pa3); SBAR();                                                           \
        pv_tile<0>(o, vb0 + SLOT((t) - 1) * SHM_V, pa0, pa1, pa2, pa3, ACT((t) - 1)); MASKT(PX0, PX1, (t)); partialSM(PX0, PX1, m_reg, mnX, alX);   \
        WAITBAR(t);                                                                                                           \
        RESC(alX); } while (0)
    for (int t = 1; t + 1 < NT; t += 2) {
        HALF_STEP(pB0, pB1, mnB, alB, pA0, pA1, alA, t);
        HALF_STEP(pA0, pA1, mnA, alA, pB0, pB1, alB, t + 1);
    }
    SBAR(); qkt_rt(pB0, pB1, K_lds, SLOT(NT - 1) * SHM_K, r32, hi, S.qr, ACT(NT - 1)); SBAR();
    ISSUE(NT + 1);
    if (has_next) {
#pragma unroll
        for (int d0 = 0; d0 < 8; ++d0) S.qr[d0] = load8(nxt.Q + (size_t)(wid * QBLK + r32) * (size_t)nxt.pitch + d0 * 16 + hi * 8);
    }
    SBAR();
    finishSM(pA0, pA1, alA, l_reg, pa0, pa1, pa2, pa3); SBAR();
    pv_tile<0>(o, vb0 + SLOT(NT - 2) * SHM_V, pa0, pa1, pa2, pa3, ACT(NT - 2));
    MASKT(pB0, pB1, NT - 1); partialSM(pB0, pB1, m_reg, mnB, alB);
    if (pre) VMWN(12); else if (chain) VMWN(8); else VMWN(0);
    LBAR();
    RESC(alB);
    finishSM(pB0, pB1, alB, l_reg, pa0, pa1, pa2, pa3); SBAR(); pv_tile<0>(o, vb0 + SLOT(NT - 1) * SHM_V, pa0, pa1, pa2, pa3, ACT(NT - 1));
    SBAR();
    if (hi == 0) { li_l[r32] = l_reg; cur.L[(size_t)(wid * QBLK + r32) * (size_t)cur.lstride] = m_reg + __builtin_amdgcn_logf(l_reg); }
    asm volatile("s_waitcnt lgkmcnt(0)" ::: "memory");
    float rli[16];
#pragma unroll
    for (int r = 0; r < 16; ++r) rli[r] = __builtin_amdgcn_rcpf(li_l[crow(r, hi)]);
    {
        bf16_t* Ow = cur.O + (size_t)(wid * QBLK) * (size_t)pit;
        char* st = K_lds + (chain ? SLOT(NT - 3) : SLOT(NT - 1)) * SHM_K + wid * 2048;
        const int q0 = lane, q1 = lane + 64;
#pragma unroll
        for (int d0 = 0; d0 < 4; ++d0) {
#pragma unroll
            for (int r = 0; r < 16; ++r) *(bf16_t*)(st + crow(r, hi) * 64 + r32 * 2) = (bf16_t)(cvtpk(o[d0][r] * rli[r], 0.f) & 0xffffu);
            asm volatile("s_waitcnt lgkmcnt(0)" ::: "memory");
            const u32x4 c0 = *(const u32x4*)(st + q0 * 16), c1 = *(const u32x4*)(st + q1 * 16);
            *(u32x4*)(Ow + (size_t)(q0 >> 2) * (size_t)pit + d0 * 32 + (q0 & 3) * 8) = c0;
            *(u32x4*)(Ow + (size_t)(q1 >> 2) * (size_t)pit + d0 * 32 + (q1 & 3) * 8) = c1;
            asm volatile("s_waitcnt lgkmcnt(0)" ::: "memory");
        }
    }
    S.v = chain ? v0 + NT - 2 : v0 + NT;
#undef RESC
#undef KBASE
#undef ACT
#undef MASKT
#undef SLOT
#undef ISSUE
#undef WAITBAR
#undef HALF_STEP
}
#undef VMWN
#undef LBAR
#undef KSWZ
#undef SBAR
}

constexpr int NWAVES = 8;
constexpr int N_LAUNCHES = MK_N_LAUNCHES;
constexpr int PER_PHASE = 5;
#ifndef MK_DUP_PHASE
#define MK_DUP_PHASE -1
#endif
constexpr int DUP_PHASE = MK_DUP_PHASE;
constexpr int BATCH = 4, SEQ = 4096, DM = 2048, M = BATCH * SEQ;
constexpr int NH = 8, HD = 128, DATT = 1024, DPOOL = 1024, DIN = 6144;
constexpr float LN_EPS = 1e-5f;
constexpr float DN_ALPHA = 1.189207115002721f;
constexpr float QSCALE = 1.4426950408889634f * 0.08838834764831845f;

constexpr size_t MiB = 1u << 20;
constexpr size_t WS_CTL = 0, CTL_ZERO_BYTES = 64 * 1024;
constexpr size_t WS_ROPE = 1 * MiB;
constexpr size_t WS_WOUT = 4 * MiB;
constexpr size_t WS_XB = 36 * MiB;
constexpr size_t WS_WIN = 100 * MiB;
constexpr size_t WS_O = 36 * MiB;
constexpr size_t WS_QKV = 132 * MiB;
constexpr size_t WS_Y = 132 * MiB;
constexpr size_t WS_U = 228 * MiB;
constexpr size_t WS_G = 260 * MiB;
constexpr size_t WS_L = 324 * MiB;
constexpr size_t WS_FOLD = 326 * MiB;
constexpr size_t WS_END = 334 * MiB;
constexpr size_t WS_X = 1 * MiB + 512 * 1024;
constexpr int CW_PANEL = 8192;
constexpr int CW_BAR = 1024;

constexpr int RING_BYTES = 131072;
constexpr int LDSCTL_OFF = 143360, MISC_OFF = LDSCTL_OFF + 320;
constexpr int LDS_BYTES = 147456;

#define GAS __attribute__((address_space(1)))
#define LAS __attribute__((address_space(3)))
typedef unsigned short bf16;
typedef unsigned v4u __attribute__((ext_vector_type(4)));
typedef unsigned v2u __attribute__((ext_vector_type(2)));
typedef float f32x4 __attribute__((ext_vector_type(4)));
typedef short bf16x8 __attribute__((ext_vector_type(8)));
typedef GAS unsigned gu32;
#define RLX_AGENT __ATOMIC_RELAXED, __HIP_MEMORY_SCOPE_AGENT
#define LDS_WAIT() asm volatile("s_waitcnt lgkmcnt(0)" ::: "memory")
#define VM_WAIT() asm volatile("s_waitcnt vmcnt(0)" ::: "memory")
__device__ __forceinline__ unsigned pk2(float lo, float hi) { unsigned r; asm volatile("v_cvt_pk_bf16_f32 %0, %1, %2" : "=v"(r) : "v"(lo), "v"(hi)); return r; }
__device__ __forceinline__ float bf_lo(unsigned w) { return __uint_as_float(w << 16); }
__device__ __forceinline__ float bf_hi(unsigned w) { return __uint_as_float(w & 0xffff0000u); }
__device__ __forceinline__ float silu_f(float g) { return g * __builtin_amdgcn_rcpf(1.f + __builtin_amdgcn_exp2f(-1.4426950408889634f * g)); }

#define XB_TMO      128
#define XB_XCNT(j)  (256  + 64 * (j))
#define XB_XSUB(j)  (1280 + 64 * (j))
#define XB_XGEN(j)  (2304 + 64 * (j))
#define XB_TOP      3328
#define XB_TOPGEN   3392
#define XCD_BAR_WORDS 3456
#define XB_SPIN_CAP (1u << 18)

__device__ __forceinline__ unsigned xb_ld(unsigned* p)              { return __hip_atomic_load(p, __ATOMIC_RELAXED, __HIP_MEMORY_SCOPE_AGENT); }
__device__ __forceinline__ unsigned xb_add(unsigned* p, unsigned v) { return __hip_atomic_fetch_add(p, v, __ATOMIC_RELAXED, __HIP_MEMORY_SCOPE_AGENT); }
__device__ __forceinline__ unsigned xb_xcc_id() { return (unsigned)__builtin_amdgcn_s_getreg((3 << 11) | 20) & 0xFu; }
#define XB_SPIN(cond, bar) do { unsigned _sp = 0; while (cond) { __builtin_amdgcn_s_sleep(1); \
    if ((++_sp & 255u) == 0u) { if (xb_ld(&(bar)[XB_TMO])) break; if (_sp > XB_SPIN_CAP) { atomicAdd(&(bar)[XB_TMO], 1u); break; } } } } while (0)

struct XcdBarrier {
    unsigned* bar; unsigned x;
    volatile LAS unsigned* st;
};

__device__ __forceinline__ XcdBarrier xcd_barrier_post(unsigned* bar, volatile LAS unsigned* st) {
    XcdBarrier b; b.bar = bar; b.x = xb_xcc_id(); b.st = st;
    if (threadIdx.x == 0) (void)xb_add(&bar[XB_XCNT(b.x)], 1u);
    return b;
}
__device__ __forceinline__ void xcd_barrier_complete(unsigned* bar, unsigned x, unsigned& nloc, unsigned& nx) {
    const unsigned G = gridDim.x * gridDim.y * gridDim.z;
    unsigned sum, cnt, mine, sp = 0u;
    for (;;) {
        sum = 0u; cnt = 0u; mine = 0u;
#pragma unroll
        for (unsigned j = 0; j < 16; ++j) { const unsigned c = xb_ld(&bar[XB_XCNT(j)]); sum += c; cnt += (c > 0u) ? 1u : 0u; mine = (j == x) ? c : mine; }
        if (sum == G) break;
        __builtin_amdgcn_s_sleep(1);
        if ((++sp & 255u) == 0u) { if (xb_ld(&bar[XB_TMO])) break; if (sp > XB_SPIN_CAP) { atomicAdd(&bar[XB_TMO], 1u); break; } }
    }
    nloc = mine > 0u ? mine : 1u; nx = cnt > 0u ? cnt : 1u;
}

__device__ __forceinline__ void xcd_barrier(const XcdBarrier& b) {
    asm volatile("s_waitcnt vmcnt(0)" ::: "memory");
    __syncthreads();
    if (threadIdx.x == 0) {
        unsigned* bar = b.bar;
        __builtin_amdgcn_s_waitcnt(0);
        unsigned nloc = b.st[0], nx = b.st[1];
        if (nloc == 0u) { xcd_barrier_complete(bar, b.x, nloc, nx); b.st[0] = nloc; b.st[1] = nx; }
        const unsigned old = xb_add(&bar[XB_XSUB(b.x)], 1u);
        const unsigned gen = old / nloc;
        if (old + 1u == (gen + 1u) * nloc) {
            __builtin_amdgcn_fence(__ATOMIC_RELEASE, "agent");
            asm volatile("s_waitcnt vmcnt(0)" ::: "memory");
            const unsigned og = xb_add(&bar[XB_TOP], 1u);
            const unsigned tg = og / nx;
            if (og + 1u == (tg + 1u) * nx) xb_add(&bar[XB_TOPGEN], 1u);
            else XB_SPIN(xb_ld(&bar[XB_TOPGEN]) == tg, bar);
            __builtin_amdgcn_fence(__ATOMIC_ACQUIRE, "agent");
            xb_add(&bar[XB_XGEN(b.x)], 1u);
            asm volatile("s_waitcnt vmcnt(0)" ::: "memory");
        } else {
            XB_SPIN(xb_ld(&bar[XB_XGEN(b.x)]) == gen, bar);
            __builtin_amdgcn_fence(__ATOMIC_ACQUIRE, "agent");
            asm volatile("s_waitcnt vmcnt(0)" ::: "memory");
        }
    }
    __syncthreads();
}

__device__ __forceinline__ void p0_transpose_item(const float* W, int K, int N, bf16* WT, LAS float* scr, int item, int lane) {
    const int nblk = N / 64, kb = item / nblk, nb = item % nblk, k0 = 64 * kb, n0 = 64 * nb;
    f32x4 v[16];
#pragma unroll
    for (int i = 0; i < 16; ++i) v[i] = __builtin_nontemporal_load((const GAS f32x4*)(W + (size_t)(k0 + 4 * i + (lane >> 4)) * N + n0 + 4 * (lane & 15)));
#pragma unroll
    for (int i = 0; i < 16; ++i) { LAS float* d = scr + (4 * i + (lane >> 4)) * 65 + 4 * (lane & 15); d[0] = v[i][0]; d[1] = v[i][1]; d[2] = v[i][2]; d[3] = v[i][3]; }
    LDS_WAIT(); asm volatile("" ::: "memory");
    const int c = lane & 7;
#pragma unroll
    for (int j = 0; j < 8; ++j) { const int n = (lane >> 3) + 8 * j; const LAS float* s = scr + (8 * c) * 65 + n;
        v4u o; o.x = pk2(s[0 * 65], s[1 * 65]); o.y = pk2(s[2 * 65], s[3 * 65]); o.z = pk2(s[4 * 65], s[5 * 65]); o.w = pk2(s[6 * 65], s[7 * 65]);
        *(GAS v4u*)(WT + (size_t)(n0 + n) * K + k0 + 8 * c) = o; }
    LDS_WAIT(); asm volatile("" ::: "memory");
}
__device__ __forceinline__ void sincos_pi(double r, double& s, double& c) {
    const double z = r * r;
    double ss = 0.0, cc = 0.0, term_s = r, term_c = 1.0;
#pragma unroll
    for (int k = 0; k < 16; ++k) { ss += term_s; cc += term_c; term_c = -term_c * z * (1.0 / (double)((2 * k + 1) * (2 * k + 2))); term_s = -term_s * z * (1.0 / (double)((2 * k + 2) * (2 * k + 3))); }
    s = ss; c = cc;
}
__device__ __forceinline__ void p0_prologue(LAS unsigned char* lds, const float* x, const float* w_in, const float* w_pool, const float* w_out, unsigned char* ws, int vcu, int G, int tid, int wave, int lane) {
    LAS float* scr = (LAS float*)(lds + wave * 16896);
    bf16* WinT = (bf16*)(ws + WS_WIN); bf16* WoutT = (bf16*)(ws + WS_WOUT);
    const bool fold = (G == 256) && (vcu < 32);
    if (fold) {
        const int g = vcu >> 3, j = vcu & 7;
        bf16* Ap = (bf16*)(ws + WS_FOLD) + (size_t)vcu * 131072;
        bf16* Bp = Ap + 65536;
        for (int it = wave; it < 16; it += NWAVES) p0_transpose_item(w_pool + (size_t)g * 65536, 256, 256, Ap, scr, it, lane);
        {
            f32x4 a[16], b[16];
#pragma unroll
            for (int k = 0; k < 16; ++k) { const int e = tid + k * (NWAVES * 64), r = e >> 5, c8 = e & 31;
                const float* s = w_in + (size_t)(256 * j + r) * DIN + 3072 + 256 * g + c8 * 8;
                a[k] = __builtin_nontemporal_load((const GAS f32x4*)s); b[k] = __builtin_nontemporal_load((const GAS f32x4*)(s + 4)); }
#pragma unroll
            for (int k = 0; k < 16; ++k) { const int e = tid + k * (NWAVES * 64), r = e >> 5, c8 = e & 31;
                v4u o; o.x = pk2(a[k][0], a[k][1]); o.y = pk2(a[k][2], a[k][3]); o.z = pk2(b[k][0], b[k][1]); o.w = pk2(b[k][2], b[k][3]);
                *(GAS v4u*)(Bp + (size_t)r * 256 + c8 * 8) = o; }
        }
        VM_WAIT(); __syncthreads();
        pg8::Gemm gg{Ap, Bp, 256, 256, 256}; pg8::SchedOne S1; pg8::EpiW E{WinT + (size_t)(3072 + 256 * g) * DM + 256 * j};
        pg8::gemm_phase<pg8::EpiW, pg8::SchedOne, true, true>(lds, gg, S1, E);
    }
    {
        const int nfold = (G == 256) ? 32 : 0;
        const int gw = (vcu - nfold) * NWAVES + wave, NGW = (G - nfold) * NWAVES;
        constexpr int I_IN = (DM / 64) * (DIN / 64), I_OUT = (DM / 64) * (DM / 64), NITEMS = I_IN + I_OUT;
        if (!fold) for (int it = gw; it < NITEMS; it += NGW) {
            int r = it;
            if (r < I_IN) { const int nb = r % (DIN / 64); if (G == 256 && nb >= 48 && nb < 64) continue; p0_transpose_item(w_in, DM, DIN, WinT, scr, r, lane); continue; } r -= I_IN;
            p0_transpose_item(w_out, DM, DM, WoutT, scr, r, lane);
        }
    }
    {
        const size_t gt = (size_t)vcu * (NWAVES * 64) + tid, NT = (size_t)G * (NWAVES * 64);
        bf16* XB = (bf16*)(ws + WS_XB);
        const int nf = (G == 256) ? 32 : 0, slots = fold ? 3 : 5, slot0 = fold ? 3 * vcu : 3 * nf + 5 * (vcu - nf), nslots = 3 * nf + 5 * (G - nf);
        constexpr int XU = 4;
        for (int sl = 0; sl < slots; ++sl) {
            const size_t st = (size_t)(slot0 + sl) * (NWAVES * 64) + tid, SN = (size_t)nslots * (NWAVES * 64);
            for (size_t i = st; i < (size_t)M * DM / 8; i += SN * XU) {
                f32x4 a[XU], b[XU];
#pragma unroll
                for (int k = 0; k < XU; ++k) { const size_t ii = i + (size_t)k * SN; a[k] = (f32x4){0.f, 0.f, 0.f, 0.f}; b[k] = a[k];
                    if (ii < (size_t)M * DM / 8) { a[k] = __builtin_nontemporal_load((const GAS f32x4*)(x + ii * 8)); b[k] = __builtin_nontemporal_load((const GAS f32x4*)(x + ii * 8 + 4)); } }
#pragma unroll
                for (int k = 0; k < XU; ++k) { const size_t ii = i + (size_t)k * SN;
                    v4u o; o.x = pk2(a[k][0], a[k][1]); o.y = pk2(a[k][2], a[k][3]); o.z = pk2(b[k][0], b[k][1]); o.w = pk2(b[k][2], b[k][3]);
                    if (ii < (size_t)M * DM / 8) *(GAS v4u*)(XB + ii * 8) = o; }
            }
        }
        float* rope = (float*)(ws + WS_ROPE);
        for (size_t e = gt; e < 65536; e += NT) {
            const int i = (int)(e & 15), pos = (int)(e >> 4);
            double f;
            switch (i) { case 0: f = 1.0; break; case 1: f = 0.44036660267178046; break; case 2: f = 0.19392274474868576; break; case 3: f = 0.08539710028576561; break;
                case 4: f = 0.03760603093086393; break; case 5: f = 0.016560440080994446; break; case 6: f = 0.007292664737217109; break; case 7: f = 0.003211445994752591; break;
                case 8: f = 0.001414213562373095; break; case 9: f = 0.000622772421914596; break; case 10: f = 0.0002742481756762073; break; case 11: f = 0.00012076973741146504; break;
                case 12: f = 5.318295896944988e-05; break; case 13: f = 2.341999896140934e-05; break; case 14: f = 1.031338537721246e-05; break; default: f = 4.5416704806078695e-06; break; }
            const double ang = (double)pos * f;
            const double k = __builtin_rint(ang * 0.15915494309189535);
            const double r = __builtin_fma(-k, 2.4492935982947064e-16, __builtin_fma(-k, 6.283185307179586, ang));
            double s, c; sincos_pi(r, s, c);
            rope[e] = (float)c; rope[65536 + e] = (float)s;
        }
    }
}

template <int W>
__device__ __forceinline__ void pool_strip(const bf16* V, const bf16* Gt, const float* pool_scale, bf16* Y, int g, int strip, int ch) {
    const int tok0 = strip * 8, t0 = tok0 & 4095, col = g * 256 + ch * 8;
    constexpr int NR = W - 1 + 8;
    v4u rows[NR];
#pragma unroll
    for (int j = 0; j < NR; ++j) { const int dt = j - (W - 1); rows[j] = (v4u){0u, 0u, 0u, 0u}; if (t0 + dt >= 0) rows[j] = *(const GAS v4u*)(V + (size_t)(tok0 + dt) * 1024 + col); }
    const f32x4 sa = *(const GAS f32x4*)(pool_scale + col), sb = *(const GAS f32x4*)(pool_scale + col + 4);
    const float sc[8] = {sa[0], sa[1], sa[2], sa[3], sb[0], sb[1], sb[2], sb[3]};
    float s[8];
#pragma unroll
    for (int k = 0; k < 8; ++k) s[k] = 0.f;
#pragma unroll
    for (int j = 0; j < W - 1; ++j)
#pragma unroll
        for (int k = 0; k < 4; ++k) { s[2 * k] += bf_lo(rows[j][k]); s[2 * k + 1] += bf_hi(rows[j][k]); }
    v4u gts[8];
#pragma unroll
    for (int i = 0; i < 8; ++i) gts[i] = __builtin_nontemporal_load((const GAS v4u*)(Gt + (size_t)(tok0 + i) * 2048 + 1024 + col));
#pragma unroll
    for (int i = 0; i < 8; ++i) {
        const v4u q = rows[W - 1 + i];
        const v4u gt = gts[i];
        const int cnt = (t0 + i + 1 < W) ? t0 + i + 1 : W;
        const float inv = 1.f / (float)cnt;
        v4u o;
#pragma unroll
        for (int k = 0; k < 4; ++k) { const float u0 = bf_lo(q[k]), u1 = bf_hi(q[k]); s[2 * k] += u0; s[2 * k + 1] += u1;
            o[k] = pk2((s[2 * k] * inv - u0) * sc[2 * k] * silu_f(bf_lo(gt[k])), (s[2 * k + 1] * inv - u1) * sc[2 * k + 1] * silu_f(bf_hi(gt[k]))); }
        *(GAS v4u*)(Y + (size_t)(tok0 + i) * 2048 + 1024 + col) = o;
#pragma unroll
        for (int k = 0; k < 4; ++k) { s[2 * k] -= bf_lo(rows[i][k]); s[2 * k + 1] -= bf_hi(rows[i][k]); }
    }
}
__device__ __forceinline__ void pool_phase(const bf16* V, const bf16* Gt, const float* pool_scale, bf16* Y, int vcu, int G, int tid) {
    for (int it = vcu * (NWAVES * 64) + tid; it < 262144; it += G * (NWAVES * 64)) {
        asm volatile("" ::: "memory");
        const int ch = it & 31, sub = (it >> 5) & 1, g = __builtin_amdgcn_readfirstlane((it >> 6) & 3), strip = ((it >> 8) << 1) | sub;
        switch (g) { case 0: pool_strip<2>(V, Gt, pool_scale, Y, 0, strip, ch); break; case 1: pool_strip<4>(V, Gt, pool_scale, Y, 1, strip, ch); break;
                     case 2: pool_strip<8>(V, Gt, pool_scale, Y, 2, strip, ch); break; default: pool_strip<16>(V, Gt, pool_scale, Y, 3, strip, ch); break; }
    }
}

__device__ __forceinline__ void combine_phase(const bf16* O, const float* L, const bf16* Gt, bf16* Y, int vcu, int G, int tid) {
    const size_t gt = (size_t)vcu * (NWAVES * 64) + tid, NT = (size_t)G * (NWAVES * 64);
    constexpr size_t PST = (size_t)32 * 4096 * 128, LST = (size_t)32 * 4096;
    constexpr int CU_ = 4;
    for (size_t idx0 = gt; idx0 < (size_t)32 * 4096 * 16; idx0 += NT * CU_) {
        v4u o1[CU_], o2[CU_], o3[CU_], gv[CU_]; float l1[CU_], l2[CU_], l3[CU_]; size_t yo[CU_];
#pragma unroll
        for (int k = 0; k < CU_; ++k) { const size_t idx = idx0 + (size_t)k * NT;
            const int c8 = (int)(idx & 15), t = (int)((idx >> 4) & 4095), bh = (int)(idx >> 16);
            const size_t oo = ((size_t)bh * 4096 + t) * 128 + c8 * 8, lo = (size_t)bh * 4096 + t;
            o1[k] = *(const GAS v4u*)(O + oo); o2[k] = *(const GAS v4u*)(O + PST + oo); o3[k] = *(const GAS v4u*)(O + 2 * PST + oo);
            l1[k] = L[lo]; l2[k] = L[LST + lo]; l3[k] = L[2 * LST + lo];
            yo[k] = ((size_t)((bh >> 3) * 4096 + t)) * 2048 + (bh & 7) * 128 + c8 * 8;
            gv[k] = *(const GAS v4u*)(Gt + yo[k]); }
#pragma unroll
        for (int k = 0; k < CU_; ++k) {
            const float mx = fmaxf(l1[k], fmaxf(l2[k], l3[k]));
            float w1 = __builtin_amdgcn_exp2f(l1[k] - mx), w2 = __builtin_amdgcn_exp2f(l2[k] - mx), w3 = __builtin_amdgcn_exp2f(l3[k] - mx);
            const float inv = 1.f / (w1 + w2 + w3); w1 *= inv; w2 *= inv; w3 *= inv;
            v4u out;
#define CMB(e) { const float a = (w1 * bf_lo(o1[k][e]) + w2 * bf_lo(o2[k][e]) + w3 * bf_lo(o3[k][e])) * silu_f(bf_lo(gv[k][e])); const float b = (w1 * bf_hi(o1[k][e]) + w2 * bf_hi(o2[k][e]) + w3 * bf_hi(o3[k][e])) * silu_f(bf_hi(gv[k][e])); out[e] = pk2(a, b); }
            CMB(0) CMB(1) CMB(2) CMB(3)
#undef CMB
            *(GAS v4u*)(Y + yo[k]) = out;
        }
    }
}

struct Args { const float* x; const float* w_in; const float* w_pool; const float* pool_scale; const float* w_out; const float* ln_gain; const float* ln_bias; float* out; unsigned char* ws; int ph_lo, ph_hi; };
__global__ void __launch_bounds__(NWAVES * 64, 2) hybrid_fwd(Args args) {
    extern __shared__ __attribute__((aligned(16))) unsigned char lds_raw[];
    LAS unsigned char* lds = (LAS unsigned char*)lds_raw;
    volatile LAS unsigned* MISC = (volatile LAS unsigned*)(lds + MISC_OFF);
    const int tid = threadIdx.x, lane = tid & 63, wave = __builtin_amdgcn_readfirstlane(tid >> 6);
    const int G = gridDim.x; const int bx = blockIdx.x; const int vcu = (G % 8 == 0) ? (bx % 8) * (G / 8) + bx / 8 : bx;
    unsigned char* ws = args.ws;
    gu32* ctl = (gu32*)(ws + WS_CTL);
    for (int u = tid; u < (LDS_BYTES - LDSCTL_OFF) / 4; u += NWAVES * 64) ((LAS unsigned*)(lds + LDSCTL_OFF))[u] = 0u;
    __syncthreads();
    XcdBarrier bar; bar.bar = (unsigned*)(ctl + CW_BAR); bar.x = 0; bar.st = nullptr;
    if (N_LAUNCHES != PER_PHASE) bar = xcd_barrier_post((unsigned*)(ctl + CW_BAR), MISC + 8);
#define GRID_BAR() do { if (N_LAUNCHES != PER_PHASE) xcd_barrier(bar); } while (0)
#if defined(MK_STAMP_PHASE)
#define STAMP(k) do { if (tid == 0) { const unsigned long long t__ = __builtin_amdgcn_s_memrealtime(); MISC[16 + 2 * (k)] = (unsigned)t__; MISC[17 + 2 * (k)] = (unsigned)(t__ >> 32); } } while (0)
#else
#define STAMP(k)
#endif
    STAMP(0);
    const int lo = (N_LAUNCHES == 1) ? 0 : args.ph_lo, hi = (N_LAUNCHES == 1) ? PER_PHASE : args.ph_hi;
#define IN(k) (lo <= (k) && (k) < hi)
#if MK_DUP_PHASE >= 0
#define REP(k) for (int rep_ = 0; rep_ < (DUP_PHASE == (k) ? 2 : 1); ++rep_)
#else
#define REP(k)
#endif
#define BOTH(k) (IN(k) && IN((k) + 1))
    bf16* XB = (bf16*)(ws + WS_XB); bf16* WinT = (bf16*)(ws + WS_WIN); bf16* WoutT = (bf16*)(ws + WS_WOUT);
    bf16* QKV = (bf16*)(ws + WS_QKV); bf16* Ub = (bf16*)(ws + WS_U); bf16* Gb = (bf16*)(ws + WS_G); bf16* Ob = (bf16*)(ws + WS_O); float* Lb = (float*)(ws + WS_L); bf16* Yb = (bf16*)(ws + WS_Y);
    float* rope = (float*)(ws + WS_ROPE);

    REP(0) if (IN(0)) { int t_ = threadIdx.x; asm volatile("" : "+v"(t_)); p0_prologue(lds, args.x, args.w_in, args.w_pool, args.w_out, ws, vcu, G, t_, __builtin_amdgcn_readfirstlane(t_ >> 6), t_ & 63); if (BOTH(0)) GRID_BAR(); STAMP(1); }

    REP(1) if (IN(1)) {
        pg8::Gemm g{XB, WinT, M, DIN, DM}; pg8::StaticOrder S; S.init(M, DIN, G, bx); S.rev = true;
        pg8::EpiH E{QKV, Ub, Gb, rope, QSCALE};
        pg8::gemm_phase<pg8::EpiH, pg8::StaticOrder, true, true>(lds, g, S, E);
        if (BOTH(1)) GRID_BAR();
        STAMP(2);
    }

    REP(2) if (IN(2)) {
#if defined(MK_DUP_SUB) && MK_DUP_SUB == 1
        for (int rs_ = 0; rs_ < 2; ++rs_)
#endif
        if (G == 256) {
            att::Seam S;
            att::BlockRef cur, nxt;
#define MKREF(R, i) do { const int i_ = (i), bh = (vcu >> 3), pt = i_ >> 1, s_ = 2 * (vcu & 7) + (i_ & 1), sh = 2 * pt, dil = 1 << sh;     \
                const int res = s_ >> (4 - sh), qb = s_ & ((16 >> sh) - 1); const size_t hb = (size_t)bh * 4096 * 128, ko = (size_t)res * 128, qo = ko + (size_t)qb * 256 * 128 * dil; \
                R.Q = QKV + hb + qo; R.K = QKV + (size_t)32 * 4096 * 128 + hb + ko; R.V = QKV + (size_t)64 * 4096 * 128 + hb + ko; R.O = Ob + (size_t)(32 * pt) * 4096 * 128 + hb + qo; \
                R.L = Lb + (size_t)(32 * pt + bh) * 4096 + res + qb * 256 * dil; R.P0 = qb * 256; R.pitch = 128 * dil; R.lstride = dil; R.skv = 4096 >> sh; R.chain = ((pt < 2) && !(i_ & 1)) ? 1 : 0; } while (0)
            MKREF(cur, 0);
            att::swa_prime(cur, lds, S);
            for (int i = 0; i < 6; ++i) {
                if (i < 5) MKREF(nxt, i + 1); else nxt = cur;
                att::swa_block(cur, nxt, i < 5, (char*)lds_raw, lds, S);
                cur = nxt;
            }
#undef MKREF
            VM_WAIT(); __syncthreads();
        }
        if (BOTH(2)) GRID_BAR();
        STAMP(3);
    }

    REP(3) if (IN(3)) { int t_ = threadIdx.x; asm volatile("" : "+v"(t_)); combine_phase(Ob, Lb, Gb, Yb, vcu, G, t_);
        pool_phase(Ub, Gb, args.pool_scale, Yb, vcu, G, t_);
        if (BOTH(3)) GRID_BAR(); STAMP(4); }

    REP(4) if (IN(4)) {
        pg8::Gemm g{Yb, WoutT, M, DM, DM}; pg8::SchedLN S{(int)bx};
        pg8::EpiLN E{args.x, args.out, args.ln_gain, args.ln_bias, DN_ALPHA, LN_EPS, (unsigned long long*)(ws + WS_X), (unsigned*)(ctl + CW_PANEL)};
        if (G == 256) pg8::gemm_phase<pg8::EpiLN, pg8::SchedLN, true, true>(lds, g, S, E);
    }
#if defined(MK_STAMP_PHASE)
    STAMP(5);
    if (blockIdx.x == 0 && tid == 0) {
        const unsigned long long a = ((unsigned long long)MISC[17 + 2 * MK_STAMP_PHASE] << 32) | MISC[16 + 2 * MK_STAMP_PHASE], b = ((unsigned long long)MISC[19 + 2 * MK_STAMP_PHASE] << 32) | MISC[18 + 2 * MK_STAMP_PHASE];
        const unsigned long long t0 = __builtin_amdgcn_s_memrealtime(), want = 8ull * (b - a);
        while (__builtin_amdgcn_s_memrealtime() - t0 < want) __builtin_amdgcn_s_sleep(8);
    }
#endif
#undef IN
#undef BOTH
#undef GRID_BAR
}

extern "C" void kernel_launch(void* const* d_in, const int* in_sizes, int n_in, void* d_out, int out_size, void* d_ws, size_t ws_size, hipStream_t stream) {
    static int grid = 0;
    if (grid == 0) {
        if (n_in != 7 || in_sizes[0] != M * DM || out_size != M * DM || ws_size < WS_END) { fprintf(stderr, "kernel_launch: shape mismatch (n_in %d in0 %d out %d ws %zu)\n", n_in, n_in > 0 ? in_sizes[0] : -1, out_size, ws_size); grid = -1; return; }
        int dev = 0, cus = 0, per_cu = 0;
        if (hipGetDevice(&dev) != hipSuccess || hipDeviceGetAttribute(&cus, hipDeviceAttributeMultiprocessorCount, dev) != hipSuccess) { fprintf(stderr, "kernel_launch: device query failed\n"); grid = -1; return; }
        if (hipFuncSetAttribute((const void*)hybrid_fwd, hipFuncAttributeMaxDynamicSharedMemorySize, LDS_BYTES) != hipSuccess) { fprintf(stderr, "kernel_launch: hipFuncSetAttribute failed\n"); grid = -1; return; }
        if (hipOccupancyMaxActiveBlocksPerMultiprocessor(&per_cu, (const void*)hybrid_fwd, NWAVES * 64, LDS_BYTES) != hipSuccess || per_cu < 1)
            fprintf(stderr, "kernel_launch: note: occupancy query reports %d workgroups per CU\n", per_cu);
        (void)hipGetLastError();
        grid = cus;
        if (grid != 256) fprintf(stderr, "kernel_launch: %d CUs: the attention phase is dealt for 256 workgroups\n", grid);
    }
    if (grid < 0) return;
    if (hipMemsetAsync((char*)d_ws + WS_CTL, 0, CTL_ZERO_BYTES, stream) != hipSuccess) { fprintf(stderr, "kernel_launch: memset failed\n"); return; }
    Args a{};
    a.x = (const float*)d_in[0]; a.w_in = (const float*)d_in[1]; a.w_pool = (const float*)d_in[2]; a.pool_scale = (const float*)d_in[3];
    a.w_out = (const float*)d_in[4]; a.ln_gain = (const float*)d_in[5]; a.ln_bias = (const float*)d_in[6]; a.out = (float*)d_out; a.ws = (unsigned char*)d_ws;
    for (int li = 0; li < N_LAUNCHES; ++li) {
        a.ph_lo = (N_LAUNCHES == PER_PHASE) ? li : 0; a.ph_hi = (N_LAUNCHES == PER_PHASE) ? li + 1 : PER_PHASE;
        hipLaunchKernelGGL(hybrid_fwd, dim3(grid), dim3(NWAVES * 64), LDS_BYTES, stream, a);
        const hipError_t le = hipPeekAtLastError();
        if (le != hipSuccess) { fprintf(stderr, "kernel_launch: launch %d failed: %s\n", li, hipGetErrorName(le)); break; }
    }
}
```

```cpp
#define MK_AHEAD 2
#include <hip/hip_runtime.h>
#include <cstdio>
#include <cstdint>

#ifndef MK_N_LAUNCHES
#define MK_N_LAUNCHES 1
#endif

namespace pg8 {
#define PG8_LAS __attribute__((address_space(3)))
typedef unsigned short bf16_t;
typedef short bf16x8 __attribute__((ext_vector_type(8)));
typedef float f32x4 __attribute__((ext_vector_type(4)));
typedef unsigned u32x4 __attribute__((ext_vector_type(4)));
constexpr int BM = 256, BK = 64, HALF = 128, HTB = HALF * BK * 2  , STAGE_BYTES = 8 * HTB, NXCD = 8, WGM = 8;

__host__ __device__ __forceinline__ int lds_byte(int r, int c) { const int st = (r >> 4) * 2 + (c >> 5), rr = r & 15, cc = c & 31, ob = rr * 64 + cc * 2; return st * 1024 + (ob ^ (((ob >> 9) & 1) << 5)); }
__host__ __device__ __forceinline__ void stage_rc(int b, int& R, int& C) { const int st = b / 1024, sb = b % 1024, swz = sb ^ (((sb >> 9) & 1) << 5); R = (st >> 1) * 16 + swz / 64; C = (st & 1) * 32 + (swz % 64) / 2; }
__host__ __device__ __forceinline__ int perm32(int rho) { const int n = rho >> 4, i = rho & 15; return 8 * (i >> 2) + 4 * n + (i & 3); }

struct Unit { int pm, pn; };
struct Gemm { const bf16_t* A; const bf16_t* Bt; int M, N, K; };

struct StaticOrder {
    int nM, nN, nwg, G, c; bool rev = false;
    __host__ __device__ void init(int M, int N, int G_, int c_) { nM = M / BM; nN = N / BM; nwg = nM * nN; G = G_; c = c_; }
    __host__ __device__ bool next(int i, Unit& u) const {
        const long L = (long)i * G + c; if (L >= nwg) return false;
        int wgid = (int)L; { const int q = nwg / NXCD, r = nwg % NXCD, xcd = wgid % NXCD, off = wgid / NXCD; wgid = (xcd < r ? xcd * (q + 1) : r * (q + 1) + (xcd - r) * q) + off; }
        const int nig = WGM * nN, gid = wgid / nig, fm = gid * WGM, gsz = (nM - fm) < WGM ? (nM - fm) : WGM;
        u.pm = fm + ((wgid % nig) % gsz); u.pn = (wgid % nig) / gsz; if (rev) u.pn = nN - 1 - u.pn; return true;
    }
    __device__ __forceinline__ void a_ready(const Unit&) const {}
    __device__ __forceinline__ void done(const Unit&) const {}
};


__device__ __forceinline__ unsigned cvt_pk_bf16(float lo, float hi) { unsigned r; asm volatile("v_cvt_pk_bf16_f32 %0, %1, %2" : "=v"(r) : "v"(lo), "v"(hi)); return r; }

struct EpiH {
    static constexpr bool PERM = true, AFTER_DRAIN = false, LNX = false;
    bf16_t* QKV;
    bf16_t* U;
    bf16_t* G;
    const float* rope;
    float qscale;
    __device__ __forceinline__ void operator()(const f32x4 (&acc)[2][2][4][2], const Unit& u, int wr, int wc, int fr, int fq) const {
        const int pn = u.pn, row0 = u.pm * BM + wr * 64 + fr;
        if (pn < 12) {
            const int which = pn >> 2;
            const bool rot = (which < 2) && (wc == 0);
            const float sc = (which == 0) ? qscale : 1.f;
            const float sgn = (fq < 2) ? -1.f : 1.f;
#pragma unroll
            for (int ai = 0; ai < 2; ++ai)
#pragma unroll
                for (int m = 0; m < 4; ++m) {
                    const int row = row0 + ai * HALF + m * 16, b = row >> 12, t = row & 4095;
                    f32x4 cs[2], sn[2];
                    if (rot) {
#pragma unroll
                        for (int n = 0; n < 2; ++n) { cs[n] = *(const f32x4*)(rope + t * 16 + 8 * (fq & 1) + 4 * n); sn[n] = *(const f32x4*)(rope + 65536 + t * 16 + 8 * (fq & 1) + 4 * n); }
                    }
#pragma unroll
                    for (int bj = 0; bj < 2; ++bj) {
                        const int head = 2 * (pn & 3) + bj;
                        f32x4 v[2] = {acc[ai][bj][m][0], acc[ai][bj][m][1]};
                        if (rot) {
#pragma unroll
                            for (int n = 0; n < 2; ++n)
#pragma unroll
                                for (int j = 0; j < 4; ++j) { const float own = v[n][j], oth = __shfl_xor(own, 32); v[n][j] = own * cs[n][j] + sgn * oth * sn[n][j]; }
                        }
                        u32x4 w; w.x = cvt_pk_bf16(v[0][0] * sc, v[0][1] * sc); w.y = cvt_pk_bf16(v[0][2] * sc, v[0][3] * sc); w.z = cvt_pk_bf16(v[1][0] * sc, v[1][1] * sc); w.w = cvt_pk_bf16(v[1][2] * sc, v[1][3] * sc);
                        *(u32x4*)(QKV + ((size_t)((which * 32 + b * 8 + head) * 4096 + t)) * 128 + wc * 32 + 8 * fq) = w;
                    }
                }
        } else {
            bf16_t* base; int ldc, colt;
            if (pn < 16) { base = U; ldc = 1024; colt = (pn - 12) * BM; } else { base = G; ldc = 2048; colt = (pn - 16) * BM; }
            const int col0 = colt + wc * 32 + 8 * fq;
#pragma unroll
            for (int ai = 0; ai < 2; ++ai)
#pragma unroll
                for (int m = 0; m < 4; ++m) { bf16_t* rowp = base + (size_t)(row0 + ai * HALF + m * 16) * ldc + col0;
#pragma unroll
                    for (int bj = 0; bj < 2; ++bj) { const f32x4 v0 = acc[ai][bj][m][0], v1 = acc[ai][bj][m][1];
                        u32x4 w; w.x = cvt_pk_bf16(v0[0], v0[1]); w.y = cvt_pk_bf16(v0[2], v0[3]); w.z = cvt_pk_bf16(v1[0], v1[1]); w.w = cvt_pk_bf16(v1[2], v1[3]);
                        *(u32x4*)(rowp + bj * HALF) = w; } }
        }
    }
};
struct SchedLN {
    int c;
    __device__ __forceinline__ bool next(int i, Unit& u) const { if (i >= 2) return false; const int k = c >> 3; u.pn = k & 7; u.pm = i * 32 + (c & 7) * 4 + (k >> 3); return true; }
    __device__ __forceinline__ void a_ready(const Unit&) const {}
    __device__ __forceinline__ void done(const Unit&) const {}
};
struct EpiLN {
    static constexpr bool PERM = false, AFTER_DRAIN = false, LNX = true;
    const float* x; float* out; const float* gain; const float* bias; float alpha, eps;
    unsigned long long* xbuf;
    unsigned* cnt;
    typedef float f32x2v __attribute__((ext_vector_type(2)));
    __device__ __forceinline__ void lnx(f32x4 (&acc)[2][2][4][2], const Unit& u, bool, int wr, int wc, int fr, int fq, PG8_LAS unsigned char* lx, int wid, int lane) const {
        PG8_LAS f32x2v* P = (PG8_LAS f32x2v*)lx;
        PG8_LAS f32x2v* S = (PG8_LAS f32x2v*)(lx + 8192);
        const int row0 = u.pm * BM + wr * 64 + fr, col0 = u.pn * BM + wc * 32 + 4 * fq;
#pragma unroll
        for (int ai = 0; ai < 2; ++ai)
#pragma unroll
            for (int m = 0; m < 4; ++m) { const size_t off = (size_t)(row0 + ai * HALF + m * 16) * 2048 + col0;
#pragma unroll
                for (int bj = 0; bj < 2; ++bj)
#pragma unroll
                    for (int n = 0; n < 2; ++n) { const f32x4 xv = __builtin_nontemporal_load((const f32x4*)(x + off + bj * HALF + n * 16)); acc[ai][bj][m][n] = xv * alpha + acc[ai][bj][m][n]; }
                asm volatile("" : "+v"(acc[ai][0][m][0]), "+v"(acc[ai][0][m][1]), "+v"(acc[ai][1][m][0]), "+v"(acc[ai][1][m][1]));
                if (m & 1) asm volatile("" ::: "memory"); }
#pragma unroll
        for (int ai = 0; ai < 2; ++ai)
#pragma unroll
            for (int m = 0; m < 4; ++m) {
                float s = 0.f;
#pragma unroll
                for (int bj = 0; bj < 2; ++bj)
#pragma unroll
                    for (int n = 0; n < 2; ++n) { const f32x4 v = acc[ai][bj][m][n]; s += (v[0] + v[1]) + (v[2] + v[3]); }
                s += __shfl_xor(s, 16); s += __shfl_xor(s, 32);
                const float mw = s * (1.0f / 64.0f); float q = 0.f;
#pragma unroll
                for (int bj = 0; bj < 2; ++bj)
#pragma unroll
                    for (int n = 0; n < 2; ++n) { const f32x4 d = acc[ai][bj][m][n] - mw; q += (d[0] * d[0] + d[1] * d[1]) + (d[2] * d[2] + d[3] * d[3]); }
                q += __shfl_xor(q, 16); q += __shfl_xor(q, 32);
                if (fq == 0) P[(ai * HALF + wr * 64 + m * 16 + fr) * 4 + wc] = (f32x2v){mw, q};
            }
        asm volatile("s_waitcnt lgkmcnt(0)" ::: "memory"); __builtin_amdgcn_s_barrier(); asm volatile("" ::: "memory");
        const int row = wid * 32 + (lane & 31);
        if (lane < 32) {
            const f32x2v a = P[row * 4 + 0], b = P[row * 4 + 1], c = P[row * 4 + 2], d = P[row * 4 + 3];
            const float mt = (a.x + b.x + c.x + d.x) * 0.25f;
            const float da = a.x - mt, db = b.x - mt, dc = c.x - mt, dd = d.x - mt;
            const float m2 = (a.y + b.y) + (c.y + d.y) + 64.0f * ((da * da + db * db) + (dc * dc + dd * dd));
            unsigned long long* slot = xbuf + ((size_t)(u.pm * BM + row) * 8 + u.pn);
            __hip_atomic_store(slot, ((unsigned long long)__float_as_uint(m2) << 32) | __float_as_uint(mt), __ATOMIC_RELAXED, __HIP_MEMORY_SCOPE_AGENT);
        }
        asm volatile("s_waitcnt vmcnt(0)" ::: "memory");
        if (lane == 0) __hip_atomic_fetch_add(cnt + 64 * u.pm, 1u, __ATOMIC_RELAXED, __HIP_MEMORY_SCOPE_AGENT);
        if (wid == 0) {
            unsigned polls = 0;
            while ((unsigned)__builtin_amdgcn_readfirstlane(__hip_atomic_load(cnt + 64 * u.pm, __ATOMIC_RELAXED, __HIP_MEMORY_SCOPE_AGENT)) < 64u) {
                if (++polls > (1u << 22)) break;
                __builtin_amdgcn_s_sleep(2); }
            __builtin_amdgcn_fence(__ATOMIC_ACQUIRE, "agent");
        }
        asm volatile("s_waitcnt vmcnt(0) lgkmcnt(0)" ::: "memory"); __builtin_amdgcn_s_barrier(); asm volatile("" ::: "memory");
        if (lane < 32) {
            const unsigned long long* slot = xbuf + (size_t)(u.pm * BM + row) * 8; float mm[8], qq[8]; float ms = 0.f;
#pragma unroll
            for (int t = 0; t < 8; ++t) { const unsigned long long w = __hip_atomic_load(slot + t, __ATOMIC_RELAXED, __HIP_MEMORY_SCOPE_AGENT); mm[t] = __uint_as_float((unsigned)w); qq[t] = __uint_as_float((unsigned)(w >> 32)); ms += mm[t]; }
            const float mean = ms * 0.125f; float q = 0.f;
#pragma unroll
            for (int t = 0; t < 8; ++t) { const float dm = mm[t] - mean; q += qq[t] + 256.0f * dm * dm; }
            S[row] = (f32x2v){mean, 1.0f / sqrtf(q * (1.0f / 2048.0f) + eps)};
        }
        asm volatile("s_waitcnt lgkmcnt(0)" ::: "memory"); __builtin_amdgcn_s_barrier(); asm volatile("" ::: "memory");
        f32x4 gn[2][2], bs[2][2];
#pragma unroll
        for (int bj = 0; bj < 2; ++bj)
#pragma unroll
            for (int n = 0; n < 2; ++n) { gn[bj][n] = *(const f32x4*)(gain + col0 + bj * HALF + n * 16); bs[bj][n] = *(const f32x4*)(bias + col0 + bj * HALF + n * 16); }
#pragma unroll
        for (int ai = 0; ai < 2; ++ai)
#pragma unroll
            for (int m = 0; m < 4; ++m) { const int r = ai * HALF + wr * 64 + m * 16 + fr; const f32x2v sr = S[r]; const size_t off = (size_t)(u.pm * BM + r) * 2048 + col0;
#pragma unroll
                for (int bj = 0; bj < 2; ++bj)
#pragma unroll
                    for (int n = 0; n < 2; ++n) __builtin_nontemporal_store((acc[ai][bj][m][n] - sr.x) * sr.y * gn[bj][n] + bs[bj][n], (f32x4*)(out + off + bj * HALF + n * 16)); }
    }
};

struct SchedOne {
    __device__ __forceinline__ bool next(int i, Unit& u) const { if (i != 0) return false; u.pm = 0; u.pn = 0; return true; }
    __device__ __forceinline__ void a_ready(const Unit&) const {}
    __device__ __forceinline__ void done(const Unit&) const {}
};
struct EpiW {
    static constexpr bool PERM = true, AFTER_DRAIN = false, LNX = false;
    bf16_t* O;
    __device__ __forceinline__ void operator()(const f32x4 (&acc)[2][2][4][2], const Unit&, int wr, int wc, int fr, int fq) const {
        const int row0 = wr * 64 + fr, col0 = wc * 32 + 8 * fq;
#pragma unroll
        for (int ai = 0; ai < 2; ++ai)
#pragma unroll
            for (int m = 0; m < 4; ++m) { bf16_t* rowp = O + (size_t)(row0 + ai * HALF + m * 16) * 2048 + col0;
#pragma unroll
                for (int bj = 0; bj < 2; ++bj) { const f32x4 v0 = acc[ai][bj][m][0], v1 = acc[ai][bj][m][1];
                    u32x4 w; w.x = cvt_pk_bf16(v0[0], v0[1]); w.y = cvt_pk_bf16(v0[2], v0[3]); w.z = cvt_pk_bf16(v1[0], v1[1]); w.w = cvt_pk_bf16(v1[2], v1[3]);
                    *(u32x4*)(rowp + bj * HALF) = w; } }
    }
};

template <class Epi, class Sched, bool ALIGN_EPI = false, bool SP2 = false>
__device__ __forceinline__ void gemm_phase(PG8_LAS unsigned char* lds, const Gemm g, const Sched& S, const Epi& E) {
    int tid_ = threadIdx.x; asm volatile("" : "+v"(tid_));
    const int tid = tid_, wid = __builtin_amdgcn_readfirstlane(tid >> 6), lane = tid & 63, wr = wid >> 2, wc = wid & 3, fr = lane & 15, fq = lane >> 4;
    const int K = g.K, nt = K / BK;
    unsigned voffA[2], voffB[2];
#pragma unroll
    for (int i = 0; i < 2; ++i) { int R, C; stage_rc(tid * 16 + i * 8192, R, C); const int Rb = Epi::PERM ? ((R & ~31) + perm32(R & 31)) : R;
        voffA[i] = (unsigned)(R * K + C) * 2u; voffB[i] = (unsigned)(Rb * K + C) * 2u; }
    const size_t kstep = (size_t)(BK * 2);
    const size_t hstep = (size_t)HALF * K * 2;
    const size_t tstep = 2 * hstep;
    const unsigned ldsw = (unsigned)wid * 1024u;
    const int aoff = lds_byte(wr * 64 + fr, fq * 8), boff = lds_byte(wc * 32 + fr, fq * 8);
#define PG8_SA(b, h) (((b) * 2 + (h)) * HTB)
#define PG8_SB(b, h) ((4 + (b) * 2 + (h)) * HTB)
#define PG8_STAGE(bufoff, gbase, voff) do { _Pragma("unroll") for (int _i = 0; _i < 2; ++_i) \
        __builtin_amdgcn_global_load_lds((const unsigned*)((const char*)(gbase) + (voff)[_i]), (PG8_LAS unsigned*)(lds + (bufoff) + ldsw + _i * 8192), 16, 0, 0); } while (0)
#define PG8_LDA(dst, b, h) do { _Pragma("unroll") for (int m = 0; m < 4; ++m) _Pragma("unroll") for (int k = 0; k < 2; ++k) dst[m][k] = *(const PG8_LAS bf16x8*)(lds + PG8_SA(b, h) + aoff + m * 2048 + k * 1024); } while (0)
#define PG8_LDB(dst, b, h) do { _Pragma("unroll") for (int n = 0; n < 2; ++n) _Pragma("unroll") for (int k = 0; k < 2; ++k) dst[n][k] = *(const PG8_LAS bf16x8*)(lds + PG8_SB(b, h) + boff + n * 2048 + k * 1024); } while (0)
#define PG8_MMA(ai, bj, At, Bt) do { __builtin_amdgcn_s_setprio(1); _Pragma("unroll") for (int m = 0; m < 4; ++m) _Pragma("unroll") for (int n = 0; n < 2; ++n) _Pragma("unroll") for (int k = 0; k < 2; ++k) \
        acc[ai][bj][m][n] = __builtin_amdgcn_mfma_f32_16x16x32_bf16(Bt[n][k], At[m][k], acc[ai][bj][m][n], 0, 0, 0); __builtin_amdgcn_s_setprio(0); } while (0)
#define PG8_WAIT_V(n) asm volatile("s_waitcnt vmcnt(" #n ")" ::: "memory")
#define PG8_WAIT_L(n) asm volatile("s_waitcnt lgkmcnt(" #n ")" ::: "memory")
#define PG8_BAR __builtin_amdgcn_s_barrier()
#define PG8_SCHED __builtin_amdgcn_sched_barrier(0)
    Unit cur, nxt; int ui = 0;
    if (!S.next(0, cur)) return;
    f32x4 acc[2][2][4][2];
#pragma unroll
    for (int a = 0; a < 2; ++a)
#pragma unroll
        for (int b = 0; b < 2; ++b)
#pragma unroll
            for (int m = 0; m < 4; ++m)
#pragma unroll
                for (int n = 0; n < 2; ++n) acc[a][b][m][n] = (f32x4){0.f, 0.f, 0.f, 0.f};
    bf16x8 At[4][2], B0[2][2], B1[2][2];
    const char* cA = (const char*)g.A + (size_t)cur.pm * tstep; const char* cB = (const char*)g.Bt + (size_t)cur.pn * tstep;
    S.a_ready(cur);
    if constexpr (SP2) {
        PG8_STAGE(PG8_SB(0, 0), cB, voffB); PG8_STAGE(PG8_SB(0, 1), cB + hstep, voffB); PG8_STAGE(PG8_SA(0, 0), cA, voffA); PG8_STAGE(PG8_SA(0, 1), cA + hstep, voffA);
        if (wr == 1) PG8_BAR;
        PG8_WAIT_V(2); PG8_BAR;
        PG8_STAGE(PG8_SB(1, 0), cB + kstep, voffB); PG8_STAGE(PG8_SA(1, 0), cA + kstep, voffA); PG8_STAGE(PG8_SB(1, 1), cB + hstep + kstep, voffB);
        PG8_WAIT_V(6); PG8_BAR;
    } else {
        PG8_STAGE(PG8_SB(0, 0), cB, voffB); PG8_STAGE(PG8_SA(0, 0), cA, voffA); PG8_STAGE(PG8_SB(0, 1), cB + hstep, voffB); PG8_STAGE(PG8_SA(0, 1), cA + hstep, voffA);
        if (wr == 1) PG8_BAR;
        PG8_WAIT_V(4); PG8_BAR;
        PG8_STAGE(PG8_SB(1, 0), cB + kstep, voffB); PG8_STAGE(PG8_SA(1, 0), cA + kstep, voffA); PG8_STAGE(PG8_SB(1, 1), cB + hstep + kstep, voffB);
        PG8_WAIT_V(6); PG8_BAR;
    }
    for (;;) {
        const bool has_next = S.next(ui + 1, nxt);
        const char* nA = has_next ? (const char*)g.A + (size_t)nxt.pm * tstep : cA; const char* nB = has_next ? (const char*)g.Bt + (size_t)nxt.pn * tstep : cB;
        for (int t = 0; t < nt; t += 2) {
            const bool last = (t == nt - 2);
            const char* a1 = cA + (size_t)(t + 1) * kstep;
            const char* a2 = last ? nA : cA + (size_t)(t + 2) * kstep; const char* b2 = last ? nB : cB + (size_t)(t + 2) * kstep;
            const char* a3 = a2 + kstep; const char* b3 = b2 + kstep;
            if (last && has_next) S.a_ready(nxt);
            if constexpr (SP2) {
            PG8_LDB(B0, 0, 0); PG8_LDB(B1, 0, 1); PG8_SCHED; PG8_LDA(At, 0, 0); PG8_STAGE(PG8_SA(1, 1), a1 + hstep, voffA);
            PG8_WAIT_V(8); PG8_WAIT_L(0); PG8_BAR; PG8_MMA(0, 0, At, B0); PG8_MMA(0, 1, At, B1); PG8_BAR; PG8_SCHED;
            PG8_LDA(At, 0, 1); PG8_STAGE(PG8_SB(0, 0), b2, voffB); PG8_STAGE(PG8_SB(0, 1), b2 + hstep, voffB); PG8_STAGE(PG8_SA(0, 0), a2, voffA);
            PG8_WAIT_V(8); PG8_WAIT_L(0); PG8_BAR; PG8_MMA(1, 0, At, B0); PG8_MMA(1, 1, At, B1); PG8_BAR; PG8_SCHED;
            PG8_LDB(B0, 1, 0); PG8_LDB(B1, 1, 1); PG8_SCHED; PG8_LDA(At, 1, 0); PG8_STAGE(PG8_SA(0, 1), a2 + hstep, voffA);
            PG8_WAIT_V(8); PG8_WAIT_L(0); PG8_BAR; PG8_MMA(0, 0, At, B0); PG8_MMA(0, 1, At, B1); PG8_BAR; PG8_SCHED;
            PG8_LDA(At, 1, 1); PG8_STAGE(PG8_SB(1, 0), b3, voffB); PG8_STAGE(PG8_SB(1, 1), b3 + hstep, voffB); PG8_STAGE(PG8_SA(1, 0), a3, voffA);
            PG8_WAIT_V(8); PG8_WAIT_L(0); PG8_BAR; PG8_MMA(1, 0, At, B0); PG8_MMA(1, 1, At, B1); PG8_BAR; PG8_SCHED;
            } else {
            PG8_LDB(B0, 0, 0); PG8_SCHED; PG8_LDA(At, 0, 0); PG8_STAGE(PG8_SA(1, 1), a1 + hstep, voffA);
            PG8_WAIT_L(8); PG8_BAR; PG8_WAIT_L(0); PG8_MMA(0, 0, At, B0); PG8_BAR; PG8_SCHED;
            PG8_LDB(B1, 0, 1); PG8_STAGE(PG8_SB(0, 0), b2, voffB);
            PG8_BAR; PG8_WAIT_L(0); PG8_MMA(0, 1, At, B1); PG8_BAR;
            PG8_LDA(At, 0, 1); PG8_STAGE(PG8_SA(0, 0), a2, voffA);
            PG8_BAR; PG8_WAIT_L(0); PG8_MMA(1, 0, At, B0); PG8_BAR; PG8_SCHED;
            PG8_STAGE(PG8_SB(0, 1), b2 + hstep, voffB);
            PG8_WAIT_V(6); PG8_BAR; PG8_MMA(1, 1, At, B1); PG8_BAR;
            PG8_LDB(B0, 1, 0); PG8_SCHED; PG8_LDA(At, 1, 0); PG8_STAGE(PG8_SA(0, 1), a2 + hstep, voffA);
            PG8_WAIT_L(8); PG8_BAR; PG8_WAIT_L(0); PG8_MMA(0, 0, At, B0); PG8_BAR; PG8_SCHED;
            PG8_LDB(B1, 1, 1); PG8_STAGE(PG8_SB(1, 0), b3, voffB);
            PG8_BAR; PG8_WAIT_L(0); PG8_MMA(0, 1, At, B1); PG8_BAR;
            PG8_LDA(At, 1, 1); PG8_STAGE(PG8_SA(1, 0), a3, voffA);
            PG8_BAR; PG8_WAIT_L(0); PG8_MMA(1, 0, At, B0); PG8_BAR; PG8_SCHED;
            PG8_STAGE(PG8_SB(1, 1), b3 + hstep, voffB);
            PG8_WAIT_V(6); PG8_BAR; PG8_MMA(1, 1, At, B1); PG8_BAR;
            }
        }
        if constexpr (ALIGN_EPI) { if (wr == 0) PG8_BAR; }
        if constexpr (Epi::LNX) { E.lnx(acc, cur, !has_next, wr, wc, fr, fq, lds + STAGE_BYTES, wid, lane); } else if constexpr (!Epi::AFTER_DRAIN) { E(acc, cur, wr, wc, fr, fq); S.done(cur); }
        if (!has_next) break;
#pragma unroll
        for (int a = 0; a < 2; ++a)
#pragma unroll
            for (int b = 0; b < 2; ++b)
#pragma unroll
                for (int m = 0; m < 4; ++m)
#pragma unroll
                    for (int n = 0; n < 2; ++n) acc[a][b][m][n] = (f32x4){0.f, 0.f, 0.f, 0.f};
        cur = nxt; cA = nA; cB = nB; ++ui;
        if constexpr (ALIGN_EPI) { if (wr == 1) PG8_BAR; }
    }
    PG8_WAIT_V(0);
    if constexpr (!ALIGN_EPI) { if (wr == 0) PG8_BAR; }
    PG8_BAR;
    if constexpr (Epi::AFTER_DRAIN) { E.fused(acc, cur, wr, wc, fr, fq, lds, wid, lane); S.done(cur); }
#undef PG8_SA
#undef PG8_SB
#undef PG8_STAGE
#undef PG8_LDA
#undef PG8_LDB
#undef PG8_MMA
#undef PG8_WAIT_V
#undef PG8_WAIT_L
#undef PG8_BAR
#undef PG8_SCHED
}
}

namespace att {
typedef unsigned short bf16_t;
typedef short bf16x8 __attribute__((ext_vector_type(8)));
typedef short s16x4 __attribute__((ext_vector_type(4)));
typedef float f32x16 __attribute__((ext_vector_type(16)));
typedef float f32x4 __attribute__((ext_vector_type(4)));
typedef unsigned u32x4 __attribute__((ext_vector_type(4)));
constexpr int D = 128, NW = 8, QBLK = 32, KVBLK = 64, QB = NW * QBLK;
constexpr int SHM_V = KVBLK * D * 2, SHM_K = KVBLK * D * 2;
constexpr int SCR_OFF = 4 * SHM_V + 4 * SHM_K, STG_OFF = SCR_OFF + NW * 64 * 4;
constexpr int LDS_BYTES = STG_OFF + NW * 2048;
constexpr float THR = 8.f;
constexpr int W = 129;

#define KSWZ(row, colB) ((row) * 256 + ((colB) ^ (((row) & 7) << 4)))
#define SBAR() __builtin_amdgcn_sched_barrier(0)
__device__ __forceinline__ int v_st(int k, int c) { const int kk = (k & ~0xC) | ((k & 4) << 1) | ((k & 8) >> 1); return ((kk >> 3) * 4 + (c >> 5)) * 512 + ((kk & 7) * 32 + (c & 31)) * 2; }
__device__ __forceinline__ int v_rd_base(int lane) { return ((lane & 3) << 3) | (((lane >> 2) & 3) << 6) | (((lane >> 4) & 1) << 5) | (((lane >> 5) & 1) << 8); }
constexpr int v_rd_off(int d0, int ks, int half) { return d0 * 512 + ks * 4096 + half * 2048; }
__device__ __forceinline__ int crow(int r, int hi) { return (r & 3) + 8 * (r >> 2) + 4 * hi; }
__device__ __forceinline__ unsigned cvtpk(float lo, float hi) { unsigned r; asm volatile("v_cvt_pk_bf16_f32 %0, %1, %2" : "=v"(r) : "v"(lo), "v"(hi)); return r; }
__device__ __forceinline__ bf16x8 load8(const bf16_t* p) { return *reinterpret_cast<const bf16x8*>(p); }
__device__ __forceinline__ void mask_tile(f32x16& p0, f32x16& p1, int dq, unsigned Wm) {
    const float NEG = -__builtin_inff();
#pragma unroll
    for (int r = 0; r < 16; ++r) {
        const int c = (r & 3) + 8 * (r >> 2);
        if ((unsigned)(dq - c) >= Wm) p0[r] = NEG;
        if ((unsigned)(dq - c - 32) >= Wm) p1[r] = NEG;
    }
}
__device__ __forceinline__ void partialSM(f32x16& p0, f32x16& p1, float& m_reg, float& mn, float& alpha) {
    float pmax = p0[0]; for (int r = 1; r < 16; ++r) pmax = fmaxf(pmax, p0[r]); for (int r = 0; r < 16; ++r) pmax = fmaxf(pmax, p1[r]);
    { auto rr = __builtin_amdgcn_permlane32_swap(__float_as_uint(pmax), __float_as_uint(pmax), false, false);
      pmax = fmaxf(__uint_as_float(rr[0]), __uint_as_float(rr[1])); }
    if (__builtin_expect(__all((pmax - m_reg) <= THR), 1)) { mn = m_reg; alpha = 1.f; }
    else { mn = fmaxf(m_reg, pmax); alpha = __builtin_amdgcn_exp2f(m_reg - mn); m_reg = mn; }
    for (int r = 0; r < 16; ++r) p0[r] = p0[r] - mn; for (int r = 0; r < 16; ++r) p1[r] = p1[r] - mn;
    for (int r = 0; r < 16; ++r) p0[r] = __builtin_amdgcn_exp2f(p0[r]);
}
__device__ __forceinline__ void finishSM(f32x16& p0, f32x16& p1, float alpha, float& l_reg, bf16x8& pa0, bf16x8& pa1, bf16x8& pa2, bf16x8& pa3) {
    for (int r = 0; r < 16; ++r) p1[r] = __builtin_amdgcn_exp2f(p1[r]);
    float ps = 0; for (int r = 0; r < 16; ++r) ps += p0[r]; for (int r = 0; r < 16; ++r) ps += p1[r];
    { auto rr = __builtin_amdgcn_permlane32_swap(__float_as_uint(ps), __float_as_uint(ps), false, false);
      ps = __uint_as_float(rr[0]) + __uint_as_float(rr[1]); }
    l_reg = l_reg * alpha + ps;
#define PK4(P, B_, OUT) do { unsigned a0 = cvtpk(P[B_+0], P[B_+1]), a1 = cvtpk(P[B_+2], P[B_+3]);                          \
        unsigned b0 = cvtpk(P[B_+4], P[B_+5]), b1 = cvtpk(P[B_+6], P[B_+7]);                                             \
        auto r0 = __builtin_amdgcn_permlane32_swap(a0, b0, false, false); auto r1 = __builtin_amdgcn_permlane32_swap(a1, b1, false, false); \
        u32x4 w = {r0[0], r1[0], r0[1], r1[1]}; OUT = *reinterpret_cast<bf16x8*>(&w); } while (0)
    PK4(p0, 0, pa0); PK4(p0, 8, pa1); PK4(p1, 0, pa2); PK4(p1, 8, pa3);
#undef PK4
}
template <int KB>
__device__ __forceinline__ void qkt(f32x16& p0, f32x16& p1, const char* K_lds, int r32, int hi, const bf16x8* qr, bool act) {
    if (!act) { const float NEG = -__builtin_inff();
#pragma unroll
        for (int r = 0; r < 16; ++r) { p0[r] = NEG; p1[r] = NEG; } return; }
    p0 = f32x16{}; p1 = f32x16{};
    const char* kb[4];
#pragma unroll
    for (int dd = 0; dd < 4; ++dd) kb[dd] = K_lds + KB * SHM_K + KSWZ(r32, (dd * 16 + hi * 8) * 2);
#pragma unroll
    for (int d0 = 0; d0 < 8; ++d0) { const char* a = kb[d0 & 3] + (d0 >> 2) * 128;
        bf16x8 b0 = *reinterpret_cast<const bf16x8*>(a);
        bf16x8 b1 = *reinterpret_cast<const bf16x8*>(a + 32 * 256);
        p0 = __builtin_amdgcn_mfma_f32_32x32x16_bf16(b0, qr[d0], p0, 0, 0, 0);
        p1 = __builtin_amdgcn_mfma_f32_32x32x16_bf16(b1, qr[d0], p1, 0, 0, 0); }
}
template <int VB>
__device__ __forceinline__ void pv_tile(f32x16* o, int vb0, bf16x8 pa0, bf16x8 pa1, bf16x8 pa2, bf16x8 pa3, bool act) {
    if (!act) return;
#define TRRD(dst, off) asm volatile("ds_read_b64_tr_b16 %0, %1 offset:%2" : "=&v"(dst) : "v"(vb0), "i"(off) : "memory")
#define PV_D0(d0) do { s16x4 l0, l1, l2, l3, h0, h1, h2, h3; constexpr int b_ = VB * SHM_V + v_rd_off(d0, 0, 0);     \
        TRRD(l0, b_); TRRD(h0, b_ + 2048); TRRD(l1, b_ + 4096); TRRD(h1, b_ + 6144); TRRD(l2, b_ + 8192); TRRD(h2, b_ + 10240); TRRD(l3, b_ + 12288); TRRD(h3, b_ + 14336); \
        asm volatile("s_waitcnt lgkmcnt(0)" ::: "memory"); SBAR();                 \
        o[d0] = __builtin_amdgcn_mfma_f32_32x32x16_bf16(pa0, (bf16x8){l0[0], l0[1], l0[2], l0[3], h0[0], h0[1], h0[2], h0[3]}, o[d0], 0, 0, 0);   \
        o[d0] = __builtin_amdgcn_mfma_f32_32x32x16_bf16(pa1, (bf16x8){l1[0], l1[1], l1[2], l1[3], h1[0], h1[1], h1[2], h1[3]}, o[d0], 0, 0, 0);   \
        o[d0] = __builtin_amdgcn_mfma_f32_32x32x16_bf16(pa2, (bf16x8){l2[0], l2[1], l2[2], l2[3], h2[0], h2[1], h2[2], h2[3]}, o[d0], 0, 0, 0);   \
        o[d0] = __builtin_amdgcn_mfma_f32_32x32x16_bf16(pa3, (bf16x8){l3[0], l3[1], l3[2], l3[3], h3[0], h3[1], h3[2], h3[3]}, o[d0], 0, 0, 0); } while (0)
    PV_D0(0); PV_D0(1); PV_D0(2); PV_D0(3);
#undef PV_D0
#undef TRRD
}

struct Chain { const bf16_t* Q; const bf16_t* K; const bf16_t* V; bf16_t* O; float* L; int P0, M, pitch, lstride; };
struct Carry { bf16x8 qr[8]; int v; };
typedef __attribute__((address_space(3))) unsigned char lds_u8;
constexpr int AHEAD = MK_AHEAD;
__device__ __forceinline__ void dma_tile(lds_u8* ldsL, const bf16_t* Kp, const bf16_t* Vp, int pitch, int key0, int slot, int wid, int lane) {
#pragma unroll
    for (int i = 0; i < 2; ++i) {
        const int r = wid * 8 + i * 4 + (lane >> 4), c = (lane & 15) ^ (r & 7);
        __builtin_amdgcn_global_load_lds((const unsigned*)(Kp + (size_t)(key0 + r) * (size_t)pitch + c * 8), (__attribute__((address_space(3))) unsigned*)(ldsL + slot * SHM_K + wid * 2048 + i * 1024), 16, 0, 0);
    }
#pragma unroll
    for (int i = 0; i < 2; ++i) {
        const int ip = 2 * wid + i, sub = 2 * ip + (lane >> 5), kk = (sub >> 2) * 8 + ((lane & 31) >> 2), k = (kk & ~0xC) | ((kk & 4) << 1) | ((kk & 8) >> 1), c = (sub & 3) * 32 + (lane & 3) * 8;
        __builtin_amdgcn_global_load_lds((const unsigned*)(Vp + (size_t)(key0 + k) * (size_t)pitch + c), (__attribute__((address_space(3))) unsigned*)(ldsL + 4 * SHM_K + slot * SHM_V + ip * 1024), 16, 0, 0);
    }
}
#define VMWN(n) asm volatile("s_waitcnt vmcnt(" #n ")" ::: "memory")
#define LBAR() asm volatile("s_waitcnt lgkmcnt(0)\n\ts_barrier" ::: "memory")
#define LGKM0() asm volatile("s_waitcnt lgkmcnt(0)" ::: "memory")
__device__ __forceinline__ void vm_wait_le(int n) {
    if (n >= 20) VMWN(20); else if (n >= 16) VMWN(16); else if (n >= 12) VMWN(12); else if (n >= 8) VMWN(8); else if (n >= 4) VMWN(4); else VMWN(0);
}
#define QLD(dst, ptr, off) asm volatile("global_load_dwordx4 %0, %1, off offset:%2" : "+v"(dst) : "v"(ptr), "i"(off) : "memory")
#define QLD0(dst, ptr, off) asm volatile("global_load_dwordx4 %0, %1, off offset:%2" : "=v"(dst) : "v"(ptr), "i"(off) : "memory")
#define DSW32(addr, val, off) asm volatile("ds_write_b32 %0, %1 offset:%2" :: "v"(addr), "v"(val), "i"(off) : "memory")
#define DSW16(addr, val, off) asm volatile("ds_write_b16 %0, %1 offset:%2" :: "v"(addr), "v"(val), "i"(off) : "memory")
#define DSR32(dst, addr, off) asm volatile("ds_read_b32 %0, %1 offset:%2" : "=v"(dst) : "v"(addr), "i"(off) : "memory")
#define DSR128(dst, addr, off) asm volatile("ds_read_b128 %0, %1 offset:%2" : "=v"(dst) : "v"(addr), "i"(off) : "memory")
__device__ __forceinline__ void swc_prime(const Chain& c, lds_u8* ldsL, Carry& S) {
    int tid_ = threadIdx.x; asm volatile("" : "+v"(tid_));
    const int tid = tid_, wid = __builtin_amdgcn_readfirstlane(tid >> 6), lane = tid & 63, r32 = lane & 31, hi = lane >> 5;
    const int a0 = c.P0 / KVBLK - 2 + (c.P0 ? 0 : 2);
#pragma unroll
    for (int j = 0; j < AHEAD; ++j) dma_tile(ldsL, c.K, c.V, c.pitch, (a0 + j) * KVBLK, j, wid, lane);
    { const bf16_t* qp = c.Q + (size_t)(c.P0 + wid * QBLK + r32) * (size_t)c.pitch + hi * 8;
      QLD0(S.qr[0], qp, 0); QLD0(S.qr[1], qp, 32); QLD0(S.qr[2], qp, 64); QLD0(S.qr[3], qp, 96); QLD0(S.qr[4], qp, 128); QLD0(S.qr[5], qp, 160); QLD0(S.qr[6], qp, 192); QLD0(S.qr[7], qp, 224); }
    S.v = 0;
    VMWN(0); LBAR();
}
#define KRD(dst, base, off) asm volatile("ds_read_b128 %0, %1 offset:%2" : "=v"(dst) : "v"(base), "i"(off) : "memory")
__device__ __forceinline__ void qkt_rt(f32x16& p0, f32x16& p1, const char* K_lds, int kso, int r32, int hi, const bf16x8* qr) {
    p0 = f32x16{}; p1 = f32x16{};
    int kb[4];
#pragma unroll
    for (int dd = 0; dd < 4; ++dd) kb[dd] = (int)(uintptr_t)K_lds + kso + KSWZ(r32, (dd * 16 + hi * 8) * 2);
    bf16x8 fa[3], fb[3];
#define KLOAD(d0_, s_) do { if (((d0_) >> 2) == 0) { KRD(fa[s_], kb[(d0_) & 3], 0); KRD(fb[s_], kb[(d0_) & 3], 8192); } else { KRD(fa[s_], kb[(d0_) & 3], 128); KRD(fb[s_], kb[(d0_) & 3], 8320); } } while (0)
    KLOAD(0, 0); KLOAD(1, 1);
#pragma unroll
    for (int d0 = 0; d0 < 8; ++d0) {
        if (d0 + 2 < 8) { KLOAD(d0 + 2, (d0 + 2) % 3); asm volatile("s_waitcnt lgkmcnt(4)" ::: "memory"); }
        else if (d0 + 1 < 8) asm volatile("s_waitcnt lgkmcnt(2)" ::: "memory");
        else asm volatile("s_waitcnt lgkmcnt(0)" ::: "memory");
        SBAR();
        p0 = __builtin_amdgcn_mfma_f32_32x32x16_bf16(fa[d0 % 3], qr[d0], p0, 0, 0, 0);
        p1 = __builtin_amdgcn_mfma_f32_32x32x16_bf16(fb[d0 % 3], qr[d0], p1, 0, 0, 0);
        SBAR();
    }
#undef KLOAD
}
#undef KRD
__device__ __forceinline__ void swc_chain(const Chain& cur, const Chain& nxt, bool has_next, char* lds, lds_u8* ldsL, Carry& S) {
    int tid_ = threadIdx.x; asm volatile("" : "+v"(tid_));
    const int tid = tid_, wid = __builtin_amdgcn_readfirstlane(tid >> 6), lane = tid & 63, r32 = lane & 31, hi = lane >> 5, wh = wid >> 1;
    const int s0 = cur.P0 ? 0 : 2, T = 4 * cur.M + 2 - s0;
    const int A0 = cur.P0 / KVBLK - 2;
    const int a0n = nxt.P0 / KVBLK - 2 + (nxt.P0 ? 0 : 2);
    const int v0 = S.v;
    char* K_lds = lds;
    const int scr = (int)(uintptr_t)lds + SCR_OFF + wid * 256;
    const int li_wr = scr + r32 * 4, li_rd = scr + 16 * hi, al_wr = scr + 128 + r32 * 4, al_rd = scr + 128 + 16 * hi;
    const int stg = (int)(uintptr_t)lds + STG_OFF + wid * 2048;
    const int st_wr = stg + hi * 256 + r32 * 2, st_rd = stg + lane * 16;
    float m_reg = -1e30f, l_reg = 0; f32x16 o[4] = {};
    bool fresh = true, prev_issued = true;
    const int vb0 = (int)(uintptr_t)lds + 4 * SHM_K + v_rd_base(lane);
    const int pit = cur.pitch;
#define CROFF(r) (((r) & 3) + 8 * ((r) >> 2))
    for (int k = 0; k <= T; ++k) {
        const int sg = s0 + k, d = sg - wh, n = d >> 2, ph = d & 3;
        const bool inu = (unsigned)n < (unsigned)cur.M;
        bool issued = false;
        { const int j = k + AHEAD, slot = (v0 + j) & 3;
          if (j < T) { dma_tile(ldsL, cur.K, cur.V, pit, (A0 + s0 + j) * KVBLK, slot, wid, lane); issued = true; }
          else if (j > T && has_next) { dma_tile(ldsL, nxt.K, nxt.V, nxt.pitch, (a0n + (j - T - 1)) * KVBLK, slot, wid, lane); issued = true; } }
        int newer = issued ? 4 : 0;
        if (AHEAD == 3 && prev_issued) newer += 4;
        if (inu && ph < 3) {
            const int qlo = cur.P0 + 256 * n + wid * QBLK, qm = qlo + r32 - 4 * hi, kb_ = (A0 + sg) * KVBLK, so = (v0 + k) & 3;
            f32x16 p0, p1; float mn, alpha; bf16x8 pa0, pa1, pa2, pa3;
            SBAR(); qkt_rt(p0, p1, K_lds, so * SHM_K, r32, hi, S.qr); SBAR();
            if (ph == 2 && (n + 1 < cur.M || has_next)) {
                const bf16_t* qp = (n + 1 < cur.M) ? cur.Q + (size_t)(qlo + 256 + r32) * (size_t)pit + hi * 8
                                                   : nxt.Q + (size_t)(nxt.P0 + wid * QBLK + r32) * (size_t)nxt.pitch + hi * 8;
                QLD(S.qr[0], qp, 0); QLD(S.qr[1], qp, 32); QLD(S.qr[2], qp, 64); QLD(S.qr[3], qp, 96); QLD(S.qr[4], qp, 128); QLD(S.qr[5], qp, 160); QLD(S.qr[6], qp, 192); QLD(S.qr[7], qp, 224);
                newer += 8;
            }
            if (kb_ + KVBLK - 1 > qlo || kb_ <= qlo + QBLK - 1 - W) mask_tile(p0, p1, qm - kb_, (unsigned)W);
            partialSM(p0, p1, m_reg, mn, alpha);
            finishSM(p0, p1, alpha, l_reg, pa0, pa1, pa2, pa3);
            if (!fresh && __any(alpha < 1.f)) {
                if (hi == 0) DSW32(al_wr, alpha, 0);
                LGKM0();
                float al[16];
#pragma unroll
                for (int r = 0; r < 16; ++r) DSR32(al[r], al_rd, CROFF(r) * 4);
                LGKM0();
#pragma unroll
                for (int d_ = 0; d_ < 4; ++d_)
#pragma unroll
                    for (int r = 0; r < 16; ++r) o[d_][r] *= al[r];
            }
            fresh = false;
            SBAR();
            pv_tile<0>(o, vb0 + so * SHM_V, pa0, pa1, pa2, pa3, true);
            SBAR();
        } else if (inu) {
            const int qlo = cur.P0 + 256 * n + wid * QBLK;
            if (hi == 0) { DSW32(li_wr, l_reg, 0); cur.L[(size_t)(qlo + r32) * (size_t)cur.lstride] = m_reg + __builtin_amdgcn_logf(l_reg); }
            LGKM0();
            float rli[16];
#pragma unroll
            for (int r = 0; r < 16; ++r) DSR32(rli[r], li_rd, CROFF(r) * 4);
            LGKM0();
#pragma unroll
            for (int r = 0; r < 16; ++r) rli[r] = __builtin_amdgcn_rcpf(rli[r]);
            bf16_t* Ow = cur.O + (size_t)qlo * (size_t)pit;
            const int q0 = lane, q1 = lane + 64;
#pragma unroll
            for (int d0 = 0; d0 < 4; ++d0) {
#pragma unroll
                for (int r = 0; r < 16; ++r) { const unsigned w_ = cvtpk(o[d0][r] * rli[r], 0.f); DSW16(st_wr, w_, CROFF(r) * 64); }
                LGKM0();
                u32x4 c0, c1; DSR128(c0, st_rd, 0); DSR128(c1, st_rd, 1024);
                LGKM0();
                *(u32x4*)(Ow + (size_t)(q0 >> 2) * (size_t)pit + d0 * 32 + (q0 & 3) * 8) = c0;
                *(u32x4*)(Ow + (size_t)(q1 >> 2) * (size_t)pit + d0 * 32 + (q1 & 3) * 8) = c1;
            }
            newer = (issued ? 4 : 0) + 8;
            m_reg = -1e30f; l_reg = 0; fresh = true;
#pragma unroll
            for (int d_ = 0; d_ < 4; ++d_) o[d_] = f32x16{};
        }
        vm_wait_le(newer); LBAR();
        prev_issued = issued;
    }
#undef CROFF
    S.v = v0 + T + 1;
}
#undef QLD
#undef QLD0
#undef DSW32
#undef DSW16
#undef DSR32
#undef DSR128
#undef LGKM0
#undef VMWN
#undef LBAR
#undef KSWZ
#undef SBAR
}

constexpr int NWAVES = 8;
constexpr int N_LAUNCHES = MK_N_LAUNCHES;
constexpr int PER_PHASE = 5;
#ifndef MK_DUP_PHASE
#define MK_DUP_PHASE -1
#endif
constexpr int DUP_PHASE = MK_DUP_PHASE;
constexpr int BATCH = 4, SEQ = 4096, DM = 2048, M = BATCH * SEQ;
constexpr int NH = 8, HD = 128, DATT = 1024, DPOOL = 1024, DIN = 6144;
constexpr float LN_EPS = 1e-5f;
constexpr float DN_ALPHA = 1.189207115002721f;
constexpr float QSCALE = 1.4426950408889634f * 0.08838834764831845f;

constexpr size_t MiB = 1u << 20;
constexpr size_t WS_CTL = 0, CTL_ZERO_BYTES = 64 * 1024;
constexpr size_t WS_ROPE = 1 * MiB;
constexpr size_t WS_WOUT = 4 * MiB;
constexpr size_t WS_XB = 36 * MiB;
constexpr size_t WS_WIN = 100 * MiB;
constexpr size_t WS_O = 36 * MiB;
constexpr size_t WS_QKV = 132 * MiB;
constexpr size_t WS_Y = 132 * MiB;
constexpr size_t WS_U = 228 * MiB;
constexpr size_t WS_G = 260 * MiB;
constexpr size_t WS_L = 324 * MiB;
constexpr size_t WS_FOLD = 326 * MiB;
constexpr size_t WS_END = 334 * MiB;
constexpr size_t WS_X = 1 * MiB + 512 * 1024;
constexpr int CW_PANEL = 8192;
constexpr int CW_BAR = 1024;

constexpr int RING_BYTES = 131072;
constexpr int LDSCTL_OFF = 159744, MISC_OFF = LDSCTL_OFF + 320;
constexpr int LDS_BYTES = 163840;

#define GAS __attribute__((address_space(1)))
#define LAS __attribute__((address_space(3)))
typedef unsigned short bf16;
typedef unsigned v4u __attribute__((ext_vector_type(4)));
typedef unsigned v2u __attribute__((ext_vector_type(2)));
typedef float f32x4 __attribute__((ext_vector_type(4)));
typedef short bf16x8 __attribute__((ext_vector_type(8)));
typedef GAS unsigned gu32;
#define RLX_AGENT __ATOMIC_RELAXED, __HIP_MEMORY_SCOPE_AGENT
#define LDS_WAIT() asm volatile("s_waitcnt lgkmcnt(0)" ::: "memory")
#define VM_WAIT() asm volatile("s_waitcnt vmcnt(0)" ::: "memory")
__device__ __forceinline__ unsigned pk2(float lo, float hi) { unsigned r; asm volatile("v_cvt_pk_bf16_f32 %0, %1, %2" : "=v"(r) : "v"(lo), "v"(hi)); return r; }
__device__ __forceinline__ float bf_lo(unsigned w) { return __uint_as_float(w << 16); }
__device__ __forceinline__ float bf_hi(unsigned w) { return __uint_as_float(w & 0xffff0000u); }
__device__ __forceinline__ float silu_f(float g) { return g * __builtin_amdgcn_rcpf(1.f + __builtin_amdgcn_exp2f(-1.4426950408889634f * g)); }

#define XB_TMO      128
#define XB_XCNT(j)  (256  + 64 * (j))
#define XB_XSUB(j)  (1280 + 64 * (j))
#define XB_XGEN(j)  (2304 + 64 * (j))
#define XB_TOP      3328
#define XB_TOPGEN   3392
#define XCD_BAR_WORDS 3456
#define XB_SPIN_CAP (1u << 18)

__device__ __forceinline__ unsigned xb_ld(unsigned* p)              { return __hip_atomic_load(p, __ATOMIC_RELAXED, __HIP_MEMORY_SCOPE_AGENT); }
__device__ __forceinline__ unsigned xb_add(unsigned* p, unsigned v) { return __hip_atomic_fetch_add(p, v, __ATOMIC_RELAXED, __HIP_MEMORY_SCOPE_AGENT); }
__device__ __forceinline__ unsigned xb_xcc_id() { return (unsigned)__builtin_amdgcn_s_getreg((3 << 11) | 20) & 0xFu; }
#define XB_SPIN(cond, bar) do { unsigned _sp = 0; while (cond) { __builtin_amdgcn_s_sleep(1); \
    if ((++_sp & 255u) == 0u) { if (xb_ld(&(bar)[XB_TMO])) break; if (_sp > XB_SPIN_CAP) { atomicAdd(&(bar)[XB_TMO], 1u); break; } } } } while (0)

struct XcdBarrier {
    unsigned* bar; unsigned x;
    volatile LAS unsigned* st;
};

__device__ __forceinline__ XcdBarrier xcd_barrier_post(unsigned* bar, volatile LAS unsigned* st) {
    XcdBarrier b; b.bar = bar; b.x = xb_xcc_id(); b.st = st;
    if (threadIdx.x == 0) (void)xb_add(&bar[XB_XCNT(b.x)], 1u);
    return b;
}
__device__ __forceinline__ void xcd_barrier_complete(unsigned* bar, unsigned x, unsigned& nloc, unsigned& nx) {
    const unsigned G = gridDim.x * gridDim.y * gridDim.z;
    unsigned sum, cnt, mine, sp = 0u;
    for (;;) {
        sum = 0u; cnt = 0u; mine = 0u;
#pragma unroll
        for (unsigned j = 0; j < 16; ++j) { const unsigned c = xb_ld(&bar[XB_XCNT(j)]); sum += c; cnt += (c > 0u) ? 1u : 0u; mine = (j == x) ? c : mine; }
        if (sum == G) break;
        __builtin_amdgcn_s_sleep(1);
        if ((++sp & 255u) == 0u) { if (xb_ld(&bar[XB_TMO])) break; if (sp > XB_SPIN_CAP) { atomicAdd(&bar[XB_TMO], 1u); break; } }
    }
    nloc = mine > 0u ? mine : 1u; nx = cnt > 0u ? cnt : 1u;
}

__device__ __forceinline__ void xcd_barrier(const XcdBarrier& b) {
    asm volatile("s_waitcnt vmcnt(0)" ::: "memory");
    __syncthreads();
    if (threadIdx.x == 0) {
        unsigned* bar = b.bar;
        __builtin_amdgcn_s_waitcnt(0);
        unsigned nloc = b.st[0], nx = b.st[1];
        if (nloc == 0u) { xcd_barrier_complete(bar, b.x, nloc, nx); b.st[0] = nloc; b.st[1] = nx; }
        const unsigned old = xb_add(&bar[XB_XSUB(b.x)], 1u);
        const unsigned gen = old / nloc;
        if (old + 1u == (gen + 1u) * nloc) {
            __builtin_amdgcn_fence(__ATOMIC_RELEASE, "agent");
            asm volatile("s_waitcnt vmcnt(0)" ::: "memory");
            const unsigned og = xb_add(&bar[XB_TOP], 1u);
            const unsigned tg = og / nx;
            if (og + 1u == (tg + 1u) * nx) xb_add(&bar[XB_TOPGEN], 1u);
            else XB_SPIN(xb_ld(&bar[XB_TOPGEN]) == tg, bar);
            __builtin_amdgcn_fence(__ATOMIC_ACQUIRE, "agent");
            xb_add(&bar[XB_XGEN(b.x)], 1u);
            asm volatile("s_waitcnt vmcnt(0)" ::: "memory");
        } else {
            XB_SPIN(xb_ld(&bar[XB_XGEN(b.x)]) == gen, bar);
            __builtin_amdgcn_fence(__ATOMIC_ACQUIRE, "agent");
            asm volatile("s_waitcnt vmcnt(0)" ::: "memory");
        }
    }
    __syncthreads();
}

__device__ __forceinline__ void p0_transpose_item(const float* W, int K, int N, bf16* WT, LAS float* scr, int item, int lane) {
    const int nblk = N / 64, kb = item / nblk, nb = item % nblk, k0 = 64 * kb, n0 = 64 * nb;
    f32x4 v[16];
#pragma unroll
    for (int i = 0; i < 16; ++i) v[i] = __builtin_nontemporal_load((const GAS f32x4*)(W + (size_t)(k0 + 4 * i + (lane >> 4)) * N + n0 + 4 * (lane & 15)));
#pragma unroll
    for (int i = 0; i < 16; ++i) { LAS float* d = scr + (4 * i + (lane >> 4)) * 65 + 4 * (lane & 15); d[0] = v[i][0]; d[1] = v[i][1]; d[2] = v[i][2]; d[3] = v[i][3]; }
    LDS_WAIT(); asm volatile("" ::: "memory");
    const int c = lane & 7;
#pragma unroll
    for (int j = 0; j < 8; ++j) { const int n = (lane >> 3) + 8 * j; const LAS float* s = scr + (8 * c) * 65 + n;
        v4u o; o.x = pk2(s[0 * 65], s[1 * 65]); o.y = pk2(s[2 * 65], s[3 * 65]); o.z = pk2(s[4 * 65], s[5 * 65]); o.w = pk2(s[6 * 65], s[7 * 65]);
        *(GAS v4u*)(WT + (size_t)(n0 + n) * K + k0 + 8 * c) = o; }
    LDS_WAIT(); asm volatile("" ::: "memory");
}
__device__ __forceinline__ void sincos_pi(double r, double& s, double& c) {
    const double z = r * r;
    double ss = 0.0, cc = 0.0, term_s = r, term_c = 1.0;
#pragma unroll
    for (int k = 0; k < 16; ++k) { ss += term_s; cc += term_c; term_c = -term_c * z * (1.0 / (double)((2 * k + 1) * (2 * k + 2))); term_s = -term_s * z * (1.0 / (double)((2 * k + 2) * (2 * k + 3))); }
    s = ss; c = cc;
}
__device__ __forceinline__ void p0_prologue(LAS unsigned char* lds, const float* x, const float* w_in, const float* w_pool, const float* w_out, unsigned char* ws, int vcu, int G, int tid, int wave, int lane) {
    LAS float* scr = (LAS float*)(lds + wave * 16896);
    bf16* WinT = (bf16*)(ws + WS_WIN); bf16* WoutT = (bf16*)(ws + WS_WOUT);
    const bool fold = (G == 256) && (vcu < 32);
    if (fold) {
        const int g = vcu >> 3, j = vcu & 7;
        bf16* Ap = (bf16*)(ws + WS_FOLD) + (size_t)vcu * 131072;
        bf16* Bp = Ap + 65536;
        for (int it = wave; it < 16; it += NWAVES) p0_transpose_item(w_pool + (size_t)g * 65536, 256, 256, Ap, scr, it, lane);
        {
            f32x4 a[16], b[16];
#pragma unroll
            for (int k = 0; k < 16; ++k) { const int e = tid + k * (NWAVES * 64), r = e >> 5, c8 = e & 31;
                const float* s = w_in + (size_t)(256 * j + r) * DIN + 3072 + 256 * g + c8 * 8;
                a[k] = __builtin_nontemporal_load((const GAS f32x4*)s); b[k] = __builtin_nontemporal_load((const GAS f32x4*)(s + 4)); }
#pragma unroll
            for (int k = 0; k < 16; ++k) { const int e = tid + k * (NWAVES * 64), r = e >> 5, c8 = e & 31;
                v4u o; o.x = pk2(a[k][0], a[k][1]); o.y = pk2(a[k][2], a[k][3]); o.z = pk2(b[k][0], b[k][1]); o.w = pk2(b[k][2], b[k][3]);
                *(GAS v4u*)(Bp + (size_t)r * 256 + c8 * 8) = o; }
        }
        VM_WAIT(); __syncthreads();
        pg8::Gemm gg{Ap, Bp, 256, 256, 256}; pg8::SchedOne S1; pg8::EpiW E{WinT + (size_t)(3072 + 256 * g) * DM + 256 * j};
        pg8::gemm_phase<pg8::EpiW, pg8::SchedOne, true, true>(lds, gg, S1, E);
    }
    {
        const int nfold = (G == 256) ? 32 : 0;
        const int gw = (vcu - nfold) * NWAVES + wave, NGW = (G - nfold) * NWAVES;
        constexpr int I_IN = (DM / 64) * (DIN / 64), I_OUT = (DM / 64) * (DM / 64), NITEMS = I_IN + I_OUT;
        if (!fold) for (int it = gw; it < NITEMS; it += NGW) {
            int r = it;
            if (r < I_IN) { const int nb = r % (DIN / 64); if (G == 256 && nb >= 48 && nb < 64) continue; p0_transpose_item(w_in, DM, DIN, WinT, scr, r, lane); continue; } r -= I_IN;
            p0_transpose_item(w_out, DM, DM, WoutT, scr, r, lane);
        }
    }
    {
        const size_t gt = (size_t)vcu * (NWAVES * 64) + tid, NT = (size_t)G * (NWAVES * 64);
        bf16* XB = (bf16*)(ws + WS_XB);
        const int nf = (G == 256) ? 32 : 0, slots = fold ? 3 : 5, slot0 = fold ? 3 * vcu : 3 * nf + 5 * (vcu - nf), nslots = 3 * nf + 5 * (G - nf);
        constexpr int XU = 4;
        for (int sl = 0; sl < slots; ++sl) {
            const size_t st = (size_t)(slot0 + sl) * (NWAVES * 64) + tid, SN = (size_t)nslots * (NWAVES * 64);
            for (size_t i = st; i < (size_t)M * DM / 8; i += SN * XU) {
                f32x4 a[XU], b[XU];
#pragma unroll
                for (int k = 0; k < XU; ++k) { const size_t ii = i + (size_t)k * SN; a[k] = (f32x4){0.f, 0.f, 0.f, 0.f}; b[k] = a[k];
                    if (ii < (size_t)M * DM / 8) { a[k] = __builtin_nontemporal_load((const GAS f32x4*)(x + ii * 8)); b[k] = __builtin_nontemporal_load((const GAS f32x4*)(x + ii * 8 + 4)); } }
#pragma unroll
                for (int k = 0; k < XU; ++k) { const size_t ii = i + (size_t)k * SN;
                    v4u o; o.x = pk2(a[k][0], a[k][1]); o.y = pk2(a[k][2], a[k][3]); o.z = pk2(b[k][0], b[k][1]); o.w = pk2(b[k][2], b[k][3]);
                    if (ii < (size_t)M * DM / 8) *(GAS v4u*)(XB + ii * 8) = o; }
            }
        }
        float* rope = (float*)(ws + WS_ROPE);
        for (size_t e = gt; e < 65536; e += NT) {
            const int i = (int)(e & 15), pos = (int)(e >> 4);
            double f;
            switch (i) { case 0: f = 1.0; break; case 1: f = 0.44036660267178046; break; case 2: f = 0.19392274474868576; break; case 3: f = 0.08539710028576561; break;
                case 4: f = 0.03760603093086393; break; case 5: f = 0.016560440080994446; break; case 6: f = 0.007292664737217109; break; case 7: f = 0.003211445994752591; break;
                case 8: f = 0.001414213562373095; break; case 9: f = 0.000622772421914596; break; case 10: f = 0.0002742481756762073; break; case 11: f = 0.00012076973741146504; break;
                case 12: f = 5.318295896944988e-05; break; case 13: f = 2.341999896140934e-05; break; case 14: f = 1.031338537721246e-05; break; default: f = 4.5416704806078695e-06; break; }
            const double ang = (double)pos * f;
            const double k = __builtin_rint(ang * 0.15915494309189535);
            const double r = __builtin_fma(-k, 2.4492935982947064e-16, __builtin_fma(-k, 6.283185307179586, ang));
            double s, c; sincos_pi(r, s, c);
            rope[e] = (float)c; rope[65536 + e] = (float)s;
        }
    }
}

template <int W>
__device__ __forceinline__ void pool_strip(const bf16* V, const bf16* Gt, const float* pool_scale, bf16* Y, int g, int strip, int ch) {
    const int tok0 = strip * 8, t0 = tok0 & 4095, col = g * 256 + ch * 8;
    constexpr int NR = W - 1 + 8;
    v4u rows[NR];
#pragma unroll
    for (int j = 0; j < NR; ++j) { const int dt = j - (W - 1); rows[j] = (v4u){0u, 0u, 0u, 0u}; if (t0 + dt >= 0) rows[j] = *(const GAS v4u*)(V + (size_t)(tok0 + dt) * 1024 + col); }
    const f32x4 sa = *(const GAS f32x4*)(pool_scale + col), sb = *(const GAS f32x4*)(pool_scale + col + 4);
    const float sc[8] = {sa[0], sa[1], sa[2], sa[3], sb[0], sb[1], sb[2], sb[3]};
    float s[8];
#pragma unroll
    for (int k = 0; k < 8; ++k) s[k] = 0.f;
#pragma unroll
    for (int j = 0; j < W - 1; ++j)
#pragma unroll
        for (int k = 0; k < 4; ++k) { s[2 * k] += bf_lo(rows[j][k]); s[2 * k + 1] += bf_hi(rows[j][k]); }
    v4u gts[8];
#pragma unroll
    for (int i = 0; i < 8; ++i) gts[i] = __builtin_nontemporal_load((const GAS v4u*)(Gt + (size_t)(tok0 + i) * 2048 + 1024 + col));
#pragma unroll
    for (int i = 0; i < 8; ++i) {
        const v4u q = rows[W - 1 + i];
        const v4u gt = gts[i];
        const int cnt = (t0 + i + 1 < W) ? t0 + i + 1 : W;
        const float inv = 1.f / (float)cnt;
        v4u o;
#pragma unroll
        for (int k = 0; k < 4; ++k) { const float u0 = bf_lo(q[k]), u1 = bf_hi(q[k]); s[2 * k] += u0; s[2 * k + 1] += u1;
            o[k] = pk2((s[2 * k] * inv - u0) * sc[2 * k] * silu_f(bf_lo(gt[k])), (s[2 * k + 1] * inv - u1) * sc[2 * k + 1] * silu_f(bf_hi(gt[k]))); }
        *(GAS v4u*)(Y + (size_t)(tok0 + i) * 2048 + 1024 + col) = o;
#pragma unroll
        for (int k = 0; k < 4; ++k) { s[2 * k] -= bf_lo(rows[i][k]); s[2 * k + 1] -= bf_hi(rows[i][k]); }
    }
}
__device__ __forceinline__ void pool_phase(const bf16* V, const bf16* Gt, const float* pool_scale, bf16* Y, int vcu, int G, int tid) {
    for (int it = vcu * (NWAVES * 64) + tid; it < 262144; it += G * (NWAVES * 64)) {
        asm volatile("" ::: "memory");
        const int ch = it & 31, sub = (it >> 5) & 1, g = __builtin_amdgcn_readfirstlane((it >> 6) & 3), strip = ((it >> 8) << 1) | sub;
        switch (g) { case 0: pool_strip<2>(V, Gt, pool_scale, Y, 0, strip, ch); break; case 1: pool_strip<4>(V, Gt, pool_scale, Y, 1, strip, ch); break;
                     case 2: pool_strip<8>(V, Gt, pool_scale, Y, 2, strip, ch); break; default: pool_strip<16>(V, Gt, pool_scale, Y, 3, strip, ch); break; }
    }
}

__device__ __forceinline__ void combine_phase(const bf16* O, const float* L, const bf16* Gt, bf16* Y, int vcu, int G, int tid) {
    const size_t gt = (size_t)vcu * (NWAVES * 64) + tid, NT = (size_t)G * (NWAVES * 64);
    constexpr size_t PST = (size_t)32 * 4096 * 128, LST = (size_t)32 * 4096;
    constexpr int CU_ = 4;
    for (size_t idx0 = gt; idx0 < (size_t)32 * 4096 * 16; idx0 += NT * CU_) {
        v4u o1[CU_], o2[CU_], o3[CU_], gv[CU_]; float l1[CU_], l2[CU_], l3[CU_]; size_t yo[CU_];
#pragma unroll
        for (int k = 0; k < CU_; ++k) { const size_t idx = idx0 + (size_t)k * NT;
            const int c8 = (int)(idx & 15), t = (int)((idx >> 4) & 4095), bh = (int)(idx >> 16);
            const size_t oo = ((size_t)bh * 4096 + t) * 128 + c8 * 8, lo = (size_t)bh * 4096 + t;
            o1[k] = *(const GAS v4u*)(O + oo); o2[k] = *(const GAS v4u*)(O + PST + oo); o3[k] = *(const GAS v4u*)(O + 2 * PST + oo);
            l1[k] = L[lo]; l2[k] = L[LST + lo]; l3[k] = L[2 * LST + lo];
            yo[k] = ((size_t)((bh >> 3) * 4096 + t)) * 2048 + (bh & 7) * 128 + c8 * 8;
            gv[k] = *(const GAS v4u*)(Gt + yo[k]); }
#pragma unroll
        for (int k = 0; k < CU_; ++k) {
            const float mx = fmaxf(l1[k], fmaxf(l2[k], l3[k]));
            float w1 = __builtin_amdgcn_exp2f(l1[k] - mx), w2 = __builtin_amdgcn_exp2f(l2[k] - mx), w3 = __builtin_amdgcn_exp2f(l3[k] - mx);
            const float inv = 1.f / (w1 + w2 + w3); w1 *= inv; w2 *= inv; w3 *= inv;
            v4u out;
#define CMB(e) { const float a = (w1 * bf_lo(o1[k][e]) + w2 * bf_lo(o2[k][e]) + w3 * bf_lo(o3[k][e])) * silu_f(bf_lo(gv[k][e])); const float b = (w1 * bf_hi(o1[k][e]) + w2 * bf_hi(o2[k][e]) + w3 * bf_hi(o3[k][e])) * silu_f(bf_hi(gv[k][e])); out[e] = pk2(a, b); }
            CMB(0) CMB(1) CMB(2) CMB(3)
#undef CMB
            *(GAS v4u*)(Y + yo[k]) = out;
        }
    }
}

struct Args { const float* x; const float* w_in; const float* w_pool; const float* pool_scale; const float* w_out; const float* ln_gain; const float* ln_bias; float* out; unsigned char* ws; int ph_lo, ph_hi; };
__global__ void __launch_bounds__(NWAVES * 64, 2) hybrid_fwd(Args args) {
    extern __shared__ __attribute__((aligned(16))) unsigned char lds_raw[];
    LAS unsigned char* lds = (LAS unsigned char*)lds_raw;
    volatile LAS unsigned* MISC = (volatile LAS unsigned*)(lds + MISC_OFF);
    const int tid = threadIdx.x, lane = tid & 63, wave = __builtin_amdgcn_readfirstlane(tid >> 6);
    const int G = gridDim.x; const int bx = blockIdx.x; const int vcu = (G % 8 == 0) ? (bx % 8) * (G / 8) + bx / 8 : bx;
    unsigned char* ws = args.ws;
    gu32* ctl = (gu32*)(ws + WS_CTL);
    for (int u = tid; u < (LDS_BYTES - LDSCTL_OFF) / 4; u += NWAVES * 64) ((LAS unsigned*)(lds + LDSCTL_OFF))[u] = 0u;
    __syncthreads();
    XcdBarrier bar; bar.bar = (unsigned*)(ctl + CW_BAR); bar.x = 0; bar.st = nullptr;
    if (N_LAUNCHES != PER_PHASE) bar = xcd_barrier_post((unsigned*)(ctl + CW_BAR), MISC + 8);
#define GRID_BAR() do { if (N_LAUNCHES != PER_PHASE) xcd_barrier(bar); } while (0)
#if defined(MK_STAMP_PHASE)
#define STAMP(k) do { if (tid == 0) { const unsigned long long t__ = __builtin_amdgcn_s_memrealtime(); MISC[16 + 2 * (k)] = (unsigned)t__; MISC[17 + 2 * (k)] = (unsigned)(t__ >> 32); } } while (0)
#else
#define STAMP(k)
#endif
    STAMP(0);
    const int lo = (N_LAUNCHES == 1) ? 0 : args.ph_lo, hi = (N_LAUNCHES == 1) ? PER_PHASE : args.ph_hi;
#define IN(k) (lo <= (k) && (k) < hi)
#if MK_DUP_PHASE >= 0
#define REP(k) for (int rep_ = 0; rep_ < (DUP_PHASE == (k) ? 2 : 1); ++rep_)
#else
#define REP(k)
#endif
#define BOTH(k) (IN(k) && IN((k) + 1))
    bf16* XB = (bf16*)(ws + WS_XB); bf16* WinT = (bf16*)(ws + WS_WIN); bf16* WoutT = (bf16*)(ws + WS_WOUT);
    bf16* QKV = (bf16*)(ws + WS_QKV); bf16* Ub = (bf16*)(ws + WS_U); bf16* Gb = (bf16*)(ws + WS_G); bf16* Ob = (bf16*)(ws + WS_O); float* Lb = (float*)(ws + WS_L); bf16* Yb = (bf16*)(ws + WS_Y);
    float* rope = (float*)(ws + WS_ROPE);

    REP(0) if (IN(0)) { int t_ = threadIdx.x; asm volatile("" : "+v"(t_)); p0_prologue(lds, args.x, args.w_in, args.w_pool, args.w_out, ws, vcu, G, t_, __builtin_amdgcn_readfirstlane(t_ >> 6), t_ & 63); if (BOTH(0)) GRID_BAR(); STAMP(1); }

    REP(1) if (IN(1)) {
        pg8::Gemm g{XB, WinT, M, DIN, DM}; pg8::StaticOrder S; S.init(M, DIN, G, bx); S.rev = true;
        pg8::EpiH E{QKV, Ub, Gb, rope, QSCALE};
        pg8::gemm_phase<pg8::EpiH, pg8::StaticOrder, true, true>(lds, g, S, E);
        if (BOTH(1)) GRID_BAR();
        STAMP(2);
    }

    REP(2) if (IN(2)) {
#if defined(MK_DUP_SUB) && MK_DUP_SUB == 1
        for (int rs_ = 0; rs_ < 2; ++rs_)
#endif
        if (G == 256) {
            att::Carry S;
            att::Chain cur, nxt;
#define MKCH(R, c) do { const int c_ = (c), bh = (vcu >> 3), kk = vcu & 7, pt = c_ ? 2 : (kk >> 2), res = c_ ? 2 * kk + c_ - 1 : (kk < 4 ? 0 : kk - 4), dil = 1 << (2 * pt); \
                const size_t hb = (size_t)bh * 4096 * 128 + (size_t)res * 128; \
                R.Q = QKV + hb; R.K = QKV + (size_t)32 * 4096 * 128 + hb; R.V = QKV + (size_t)64 * 4096 * 128 + hb; R.O = Ob + (size_t)(32 * pt) * 4096 * 128 + hb; \
                R.L = Lb + (size_t)(32 * pt + bh) * 4096 + res; R.P0 = (c_ == 0 && kk < 4) ? 1024 * kk : 0; R.M = c_ ? 1 : 4; R.pitch = 128 * dil; R.lstride = dil; } while (0)
            MKCH(cur, 0);
            att::swc_prime(cur, lds, S);
            for (int i = 0; i < 3; ++i) {
                if (i < 2) MKCH(nxt, i + 1); else nxt = cur;
                att::swc_chain(cur, nxt, i < 2, (char*)lds_raw, lds, S);
                cur = nxt;
            }
#undef MKCH
            VM_WAIT(); __syncthreads();
        }
        if (BOTH(2)) GRID_BAR();
        STAMP(3);
    }

    REP(3) if (IN(3)) { int t_ = threadIdx.x; asm volatile("" : "+v"(t_)); combine_phase(Ob, Lb, Gb, Yb, vcu, G, t_);
        pool_phase(Ub, Gb, args.pool_scale, Yb, vcu, G, t_);
        if (BOTH(3)) GRID_BAR(); STAMP(4); }

    REP(4) if (IN(4)) {
        pg8::Gemm g{Yb, WoutT, M, DM, DM}; pg8::SchedLN S{(int)bx};
        pg8::EpiLN E{args.x, args.out, args.ln_gain, args.ln_bias, DN_ALPHA, LN_EPS, (unsigned long long*)(ws + WS_X), (unsigned*)(ctl + CW_PANEL)};
        if (G == 256) pg8::gemm_phase<pg8::EpiLN, pg8::SchedLN, true, true>(lds, g, S, E);
    }
#if defined(MK_STAMP_PHASE)
    STAMP(5);
    if (blockIdx.x == 0 && tid == 0) {
        const unsigned long long a = ((unsigned long long)MISC[17 + 2 * MK_STAMP_PHASE] << 32) | MISC[16 + 2 * MK_STAMP_PHASE], b = ((unsigned long long)MISC[19 + 2 * MK_STAMP_PHASE] << 32) | MISC[18 + 2 * MK_STAMP_PHASE];
        const unsigned long long t0 = __builtin_amdgcn_s_memrealtime(), want = 8ull * (b - a);
        while (__builtin_amdgcn_s_memrealtime() - t0 < want) __builtin_amdgcn_s_sleep(8);
    }
#endif
#undef IN
#undef BOTH
#undef GRID_BAR
}

extern "C" void kernel_launch(void* const* d_in, const int* in_sizes, int n_in, void* d_out, int out_size, void* d_ws, size_t ws_size, hipStream_t stream) {
    static int grid = 0;
    if (grid == 0) {
        if (n_in != 7 || in_sizes[0] != M * DM || out_size != M * DM || ws_size < WS_END) { fprintf(stderr, "kernel_launch: shape mismatch (n_in %d in0 %d out %d ws %zu)\n", n_in, n_in > 0 ? in_sizes[0] : -1, out_size, ws_size); grid = -1; return; }
        int dev = 0, cus = 0, per_cu = 0;
        if (hipGetDevice(&dev) != hipSuccess || hipDeviceGetAttribute(&cus, hipDeviceAttributeMultiprocessorCount, dev) != hipSuccess) { fprintf(stderr, "kernel_launch: device query failed\n"); grid = -1; return; }
        if (hipFuncSetAttribute((const void*)hybrid_fwd, hipFuncAttributeMaxDynamicSharedMemorySize, LDS_BYTES) != hipSuccess) { fprintf(stderr, "kernel_launch: hipFuncSetAttribute failed\n"); grid = -1; return; }
        if (hipOccupancyMaxActiveBlocksPerMultiprocessor(&per_cu, (const void*)hybrid_fwd, NWAVES * 64, LDS_BYTES) != hipSuccess || per_cu < 1)
            fprintf(stderr, "kernel_launch: note: occupancy query reports %d workgroups per CU\n", per_cu);
        (void)hipGetLastError();
        grid = cus;
        if (grid != 256) fprintf(stderr, "kernel_launch: %d CUs: the attention phase is dealt for 256 workgroups\n", grid);
    }
    if (grid < 0) return;
    if (hipMemsetAsync((char*)d_ws + WS_CTL, 0, CTL_ZERO_BYTES, stream) != hipSuccess) { fprintf(stderr, "kernel_launch: memset failed\n"); return; }
    Args a{};
    a.x = (const float*)d_in[0]; a.w_in = (const float*)d_in[1]; a.w_pool = (const float*)d_in[2]; a.pool_scale = (const float*)d_in[3];
    a.w_out = (const float*)d_in[4]; a.ln_gain = (const float*)d_in[5]; a.ln_bias = (const float*)d_in[6]; a.out = (float*)d_out; a.ws = (unsigned char*)d_ws;
    for (int li = 0; li < N_LAUNCHES; ++li) {
        a.ph_lo = (N_LAUNCHES == PER_PHASE) ? li : 0; a.ph_hi = (N_LAUNCHES == PER_PHASE) ? li + 1 : PER_PHASE;
        hipLaunchKernelGGL(hybrid_fwd, dim3(grid), dim3(NWAVES * 64), LDS_BYTES, stream, a);
        const hipError_t le = hipPeekAtLastError();
        if (le != hipSuccess) { fprintf(stderr, "kernel_launch: launch %d failed: %s\n", li, hipGetErrorName(le)); break; }
    }
}
```

```cpp
#define MK_AHEAD 2
#include <hip/hip_runtime.h>
#include <cstdio>
#include <cstdint>

#ifndef MK_N_LAUNCHES
#define MK_N_LAUNCHES 1
#endif

namespace pg8 {
#define PG8_LAS __attribute__((address_space(3)))
typedef unsigned short bf16_t;
typedef short bf16x8 __attribute__((ext_vector_type(8)));
typedef float f32x4 __attribute__((ext_vector_type(4)));
typedef unsigned u32x4 __attribute__((ext_vector_type(4)));
constexpr int BM = 256, BK = 64, HALF = 128, HTB = HALF * BK * 2  , STAGE_BYTES = 8 * HTB, NXCD = 8, WGM = 8;

__host__ __device__ __forceinline__ int lds_byte(int r, int c) { const int st = (r >> 4) * 2 + (c >> 5), rr = r & 15, cc = c & 31, ob = rr * 64 + cc * 2; return st * 1024 + (ob ^ (((ob >> 9) & 1) << 5)); }
__host__ __device__ __forceinline__ void stage_rc(int b, int& R, int& C) { const int st = b / 1024, sb = b % 1024, swz = sb ^ (((sb >> 9) & 1) << 5); R = (st >> 1) * 16 + swz / 64; C = (st & 1) * 32 + (swz % 64) / 2; }
__host__ __device__ __forceinline__ int perm32(int rho) { const int n = rho >> 4, i = rho & 15; return 8 * (i >> 2) + 4 * n + (i & 3); }

struct Unit { int pm, pn; };
struct Gemm { const bf16_t* A; const bf16_t* Bt; int M, N, K; };

struct StaticOrder {
    int nM, nN, nwg, G, c; bool rev = false;
    __host__ __device__ void init(int M, int N, int G_, int c_) { nM = M / BM; nN = N / BM; nwg = nM * nN; G = G_; c = c_; }
    __host__ __device__ bool next(int i, Unit& u) const {
        const long L = (long)i * G + c; if (L >= nwg) return false;
        int wgid = (int)L; { const int q = nwg / NXCD, r = nwg % NXCD, xcd = wgid % NXCD, off = wgid / NXCD; wgid = (xcd < r ? xcd * (q + 1) : r * (q + 1) + (xcd - r) * q) + off; }
        const int nig = WGM * nN, gid = wgid / nig, fm = gid * WGM, gsz = (nM - fm) < WGM ? (nM - fm) : WGM;
        u.pm = fm + ((wgid % nig) % gsz); u.pn = (wgid % nig) / gsz; if (rev) u.pn = nN - 1 - u.pn; return true;
    }
    __device__ __forceinline__ void a_ready(const Unit&) const {}
    __device__ __forceinline__ void done(const Unit&) const {}
};


__device__ __forceinline__ unsigned cvt_pk_bf16(float lo, float hi) { unsigned r; asm volatile("v_cvt_pk_bf16_f32 %0, %1, %2" : "=v"(r) : "v"(lo), "v"(hi)); return r; }

struct EpiH {
    static constexpr bool PERM = true, AFTER_DRAIN = false, LNX = false;
    bf16_t* QKV;
    bf16_t* U;
    bf16_t* G;
    const float* rope;
    float qscale;
    __device__ __forceinline__ void operator()(const f32x4 (&acc)[2][2][4][2], const Unit& u, int wr, int wc, int fr, int fq) const {
        const int pn = u.pn, row0 = u.pm * BM + wr * 64 + fr;
        if (pn < 12) {
            const int which = pn >> 2;
            const bool rot = (which < 2) && (wc == 0);
            const float sc = (which == 0) ? qscale : 1.f;
            const float sgn = (fq < 2) ? -1.f : 1.f;
#pragma unroll
            for (int ai = 0; ai < 2; ++ai)
#pragma unroll
                for (int m = 0; m < 4; ++m) {
                    const int row = row0 + ai * HALF + m * 16, b = row >> 12, t = row & 4095;
                    f32x4 cs[2], sn[2];
                    if (rot) {
#pragma unroll
                        for (int n = 0; n < 2; ++n) { cs[n] = *(const f32x4*)(rope + t * 16 + 8 * (fq & 1) + 4 * n); sn[n] = *(const f32x4*)(rope + 65536 + t * 16 + 8 * (fq & 1) + 4 * n); }
                    }
#pragma unroll
                    for (int bj = 0; bj < 2; ++bj) {
                        const int head = 2 * (pn & 3) + bj;
                        f32x4 v[2] = {acc[ai][bj][m][0], acc[ai][bj][m][1]};
                        if (rot) {
#pragma unroll
                            for (int n = 0; n < 2; ++n)
#pragma unroll
                                for (int j = 0; j < 4; ++j) { const float own = v[n][j], oth = __shfl_xor(own, 32); v[n][j] = own * cs[n][j] + sgn * oth * sn[n][j]; }
                        }
                        u32x4 w; w.x = cvt_pk_bf16(v[0][0] * sc, v[0][1] * sc); w.y = cvt_pk_bf16(v[0][2] * sc, v[0][3] * sc); w.z = cvt_pk_bf16(v[1][0] * sc, v[1][1] * sc); w.w = cvt_pk_bf16(v[1][2] * sc, v[1][3] * sc);
                        *(u32x4*)(QKV + ((size_t)((which * 32 + b * 8 + head) * 4096 + t)) * 128 + wc * 32 + 8 * fq) = w;
                    }
                }
        } else {
            bf16_t* base; int ldc, colt;
            if (pn < 16) { base = U; ldc = 1024; colt = (pn - 12) * BM; } else { base = G; ldc = 2048; colt = (pn - 16) * BM; }
            const int col0 = colt + wc * 32 + 8 * fq;
#pragma unroll
            for (int ai = 0; ai < 2; ++ai)
#pragma unroll
                for (int m = 0; m < 4; ++m) { bf16_t* rowp = base + (size_t)(row0 + ai * HALF + m * 16) * ldc + col0;
#pragma unroll
                    for (int bj = 0; bj < 2; ++bj) { const f32x4 v0 = acc[ai][bj][m][0], v1 = acc[ai][bj][m][1];
                        u32x4 w; w.x = cvt_pk_bf16(v0[0], v0[1]); w.y = cvt_pk_bf16(v0[2], v0[3]); w.z = cvt_pk_bf16(v1[0], v1[1]); w.w = cvt_pk_bf16(v1[2], v1[3]);
                        *(u32x4*)(rowp + bj * HALF) = w; } }
        }
    }
};
struct SchedLN {
    int c;
    __device__ __forceinline__ bool next(int i, Unit& u) const { if (i >= 2) return false; const int k = c >> 3; u.pn = k & 7; u.pm = i * 32 + (c & 7) * 4 + (k >> 3); return true; }
    __device__ __forceinline__ void a_ready(const Unit&) const {}
    __device__ __forceinline__ void done(const Unit&) const {}
};
struct EpiLN {
    static constexpr bool PERM = false, AFTER_DRAIN = false, LNX = true;
    const float* x; float* out; const float* gain; const float* bias; float alpha, eps;
    unsigned long long* xbuf;
    unsigned* cnt;
    typedef float f32x2v __attribute__((ext_vector_type(2)));
    __device__ __forceinline__ void lnx(f32x4 (&acc)[2][2][4][2], const Unit& u, bool, int wr, int wc, int fr, int fq, PG8_LAS unsigned char* lx, int wid, int lane) const {
        PG8_LAS f32x2v* P = (PG8_LAS f32x2v*)lx;
        PG8_LAS f32x2v* S = (PG8_LAS f32x2v*)(lx + 8192);
        const int row0 = u.pm * BM + wr * 64 + fr, col0 = u.pn * BM + wc * 32 + 4 * fq;
#pragma unroll
        for (int ai = 0; ai < 2; ++ai)
#pragma unroll
            for (int m = 0; m < 4; ++m) { const size_t off = (size_t)(row0 + ai * HALF + m * 16) * 2048 + col0;
#pragma unroll
                for (int bj = 0; bj < 2; ++bj)
#pragma unroll
                    for (int n = 0; n < 2; ++n) { const f32x4 xv = __builtin_nontemporal_load((const f32x4*)(x + off + bj * HALF + n * 16)); acc[ai][bj][m][n] = xv * alpha + acc[ai][bj][m][n]; }
                asm volatile("" : "+v"(acc[ai][0][m][0]), "+v"(acc[ai][0][m][1]), "+v"(acc[ai][1][m][0]), "+v"(acc[ai][1][m][1]));
                if (m & 1) asm volatile("" ::: "memory"); }
#pragma unroll
        for (int ai = 0; ai < 2; ++ai)
#pragma unroll
            for (int m = 0; m < 4; ++m) {
                float s = 0.f;
#pragma unroll
                for (int bj = 0; bj < 2; ++bj)
#pragma unroll
                    for (int n = 0; n < 2; ++n) { const f32x4 v = acc[ai][bj][m][n]; s += (v[0] + v[1]) + (v[2] + v[3]); }
                s += __shfl_xor(s, 16); s += __shfl_xor(s, 32);
                const float mw = s * (1.0f / 64.0f); float q = 0.f;
#pragma unroll
                for (int bj = 0; bj < 2; ++bj)
#pragma unroll
                    for (int n = 0; n < 2; ++n) { const f32x4 d = acc[ai][bj][m][n] - mw; q += (d[0] * d[0] + d[1] * d[1]) + (d[2] * d[2] + d[3] * d[3]); }
                q += __shfl_xor(q, 16); q += __shfl_xor(q, 32);
                if (fq == 0) P[(ai * HALF + wr * 64 + m * 16 + fr) * 4 + wc] = (f32x2v){mw, q};
            }
        asm volatile("s_waitcnt lgkmcnt(0)" ::: "memory"); __builtin_amdgcn_s_barrier(); asm volatile("" ::: "memory");
        const int row = wid * 32 + (lane & 31);
        if (lane < 32) {
            const f32x2v a = P[row * 4 + 0], b = P[row * 4 + 1], c = P[row * 4 + 2], d = P[row * 4 + 3];
            const float mt = (a.x + b.x + c.x + d.x) * 0.25f;
            const float da = a.x - mt, db = b.x - mt, dc = c.x - mt, dd = d.x - mt;
            const float m2 = (a.y + b.y) + (c.y + d.y) + 64.0f * ((da * da + db * db) + (dc * dc + dd * dd));
            unsigned long long* slot = xbuf + ((size_t)(u.pm * BM + row) * 8 + u.pn);
            __hip_atomic_store(slot, ((unsigned long long)__float_as_uint(m2) << 32) | __float_as_uint(mt), __ATOMIC_RELAXED, __HIP_MEMORY_SCOPE_AGENT);
        }
        asm volatile("s_waitcnt vmcnt(0)" ::: "memory");
        if (lane == 0) __hip_atomic_fetch_add(cnt + 64 * u.pm, 1u, __ATOMIC_RELAXED, __HIP_MEMORY_SCOPE_AGENT);
        if (wid == 0) {
            unsigned polls = 0;
            while ((unsigned)__builtin_amdgcn_readfirstlane(__hip_atomic_load(cnt + 64 * u.pm, __ATOMIC_RELAXED, __HIP_MEMORY_SCOPE_AGENT)) < 64u) {
                if (++polls > (1u << 22)) break;
                __builtin_amdgcn_s_sleep(2); }
            __builtin_amdgcn_fence(__ATOMIC_ACQUIRE, "agent");
        }
        asm volatile("s_waitcnt vmcnt(0) lgkmcnt(0)" ::: "memory"); __builtin_amdgcn_s_barrier(); asm volatile("" ::: "memory");
        if (lane < 32) {
            const unsigned long long* slot = xbuf + (size_t)(u.pm * BM + row) * 8; float mm[8], qq[8]; float ms = 0.f;
#pragma unroll
            for (int t = 0; t < 8; ++t) { const unsigned long long w = __hip_atomic_load(slot + t, __ATOMIC_RELAXED, __HIP_MEMORY_SCOPE_AGENT); mm[t] = __uint_as_float((unsigned)w); qq[t] = __uint_as_float((unsigned)(w >> 32)); ms += mm[t]; }
            const float mean = ms * 0.125f; float q = 0.f;
#pragma unroll
            for (int t = 0; t < 8; ++t) { const float dm = mm[t] - mean; q += qq[t] + 256.0f * dm * dm; }
            S[row] = (f32x2v){mean, 1.0f / sqrtf(q * (1.0f / 2048.0f) + eps)};
        }
        asm volatile("s_waitcnt lgkmcnt(0)" ::: "memory"); __builtin_amdgcn_s_barrier(); asm volatile("" ::: "memory");
        f32x4 gn[2][2], bs[2][2];
#pragma unroll
        for (int bj = 0; bj < 2; ++bj)
#pragma unroll
            for (int n = 0; n < 2; ++n) { gn[bj][n] = *(const f32x4*)(gain + col0 + bj * HALF + n * 16); bs[bj][n] = *(const f32x4*)(bias + col0 + bj * HALF + n * 16); }
#pragma unroll
        for (int ai = 0; ai < 2; ++ai)
#pragma unroll
            for (int m = 0; m < 4; ++m) { const int r = ai * HALF + wr * 64 + m * 16 + fr; const f32x2v sr = S[r]; const size_t off = (size_t)(u.pm * BM + r) * 2048 + col0;
#pragma unroll
                for (int bj = 0; bj < 2; ++bj)
#pragma unroll
                    for (int n = 0; n < 2; ++n) __builtin_nontemporal_store((acc[ai][bj][m][n] - sr.x) * sr.y * gn[bj][n] + bs[bj][n], (f32x4*)(out + off + bj * HALF + n * 16)); }
    }
};

struct SchedOne {
    __device__ __forceinline__ bool next(int i, Unit& u) const { if (i != 0) return false; u.pm = 0; u.pn = 0; return true; }
    __device__ __forceinline__ void a_ready(const Unit&) const {}
    __device__ __forceinline__ void done(const Unit&) const {}
};
struct EpiW {
    static constexpr bool PERM = true, AFTER_DRAIN = false, LNX = false;
    bf16_t* O;
    __device__ __forceinline__ void operator()(const f32x4 (&acc)[2][2][4][2], const Unit&, int wr, int wc, int fr, int fq) const {
        const int row0 = wr * 64 + fr, col0 = wc * 32 + 8 * fq;
#pragma unroll
        for (int ai = 0; ai < 2; ++ai)
#pragma unroll
            for (int m = 0; m < 4; ++m) { bf16_t* rowp = O + (size_t)(row0 + ai * HALF + m * 16) * 2048 + col0;
#pragma unroll
                for (int bj = 0; bj < 2; ++bj) { const f32x4 v0 = acc[ai][bj][m][0], v1 = acc[ai][bj][m][1];
                    u32x4 w; w.x = cvt_pk_bf16(v0[0], v0[1]); w.y = cvt_pk_bf16(v0[2], v0[3]); w.z = cvt_pk_bf16(v1[0], v1[1]); w.w = cvt_pk_bf16(v1[2], v1[3]);
                    *(u32x4*)(rowp + bj * HALF) = w; } }
    }
};

template <class Epi, class Sched, bool ALIGN_EPI = false, bool SP2 = false>
__device__ __forceinline__ void gemm_phase(PG8_LAS unsigned char* lds, const Gemm g, const Sched& S, const Epi& E) {
    int tid_ = threadIdx.x; asm volatile("" : "+v"(tid_));
    const int tid = tid_, wid = __builtin_amdgcn_readfirstlane(tid >> 6), lane = tid & 63, wr = wid >> 2, wc = wid & 3, fr = lane & 15, fq = lane >> 4;
    const int K = g.K, nt = K / BK;
    unsigned voffA[2], voffB[2];
#pragma unroll
    for (int i = 0; i < 2; ++i) { int R, C; stage_rc(tid * 16 + i * 8192, R, C); const int Rb = Epi::PERM ? ((R & ~31) + perm32(R & 31)) : R;
        voffA[i] = (unsigned)(R * K + C) * 2u; voffB[i] = (unsigned)(Rb * K + C) * 2u; }
    const size_t kstep = (size_t)(BK * 2);
    const size_t hstep = (size_t)HALF * K * 2;
    const size_t tstep = 2 * hstep;
    const unsigned ldsw = (unsigned)wid * 1024u;
    const int aoff = lds_byte(wr * 64 + fr, fq * 8), boff = lds_byte(wc * 32 + fr, fq * 8);
#define PG8_SA(b, h) (((b) * 2 + (h)) * HTB)
#define PG8_SB(b, h) ((4 + (b) * 2 + (h)) * HTB)
#define PG8_STAGE(bufoff, gbase, voff) do { _Pragma("unroll") for (int _i = 0; _i < 2; ++_i) \
        __builtin_amdgcn_global_load_lds((const unsigned*)((const char*)(gbase) + (voff)[_i]), (PG8_LAS unsigned*)(lds + (bufoff) + ldsw + _i * 8192), 16, 0, 0); } while (0)
#define PG8_LDA(dst, b, h) do { _Pragma("unroll") for (int m = 0; m < 4; ++m) _Pragma("unroll") for (int k = 0; k < 2; ++k) dst[m][k] = *(const PG8_LAS bf16x8*)(lds + PG8_SA(b, h) + aoff + m * 2048 + k * 1024); } while (0)
#define PG8_LDB(dst, b, h) do { _Pragma("unroll") for (int n = 0; n < 2; ++n) _Pragma("unroll") for (int k = 0; k < 2; ++k) dst[n][k] = *(const PG8_LAS bf16x8*)(lds + PG8_SB(b, h) + boff + n * 2048 + k * 1024); } while (0)
#define PG8_MMA(ai, bj, At, Bt) do { __builtin_amdgcn_s_setprio(1); _Pragma("unroll") for (int m = 0; m < 4; ++m) _Pragma("unroll") for (int n = 0; n < 2; ++n) _Pragma("unroll") for (int k = 0; k < 2; ++k) \
        acc[ai][bj][m][n] = __builtin_amdgcn_mfma_f32_16x16x32_bf16(Bt[n][k], At[m][k], acc[ai][bj][m][n], 0, 0, 0); __builtin_amdgcn_s_setprio(0); } while (0)
#define PG8_WAIT_V(n) asm volatile("s_waitcnt vmcnt(" #n ")" ::: "memory")
#define PG8_WAIT_L(n) asm volatile("s_waitcnt lgkmcnt(" #n ")" ::: "memory")
#define PG8_BAR __builtin_amdgcn_s_barrier()
#define PG8_SCHED __builtin_amdgcn_sched_barrier(0)
    Unit cur, nxt; int ui = 0;
    if (!S.next(0, cur)) return;
    f32x4 acc[2][2][4][2];
#pragma unroll
    for (int a = 0; a < 2; ++a)
#pragma unroll
        for (int b = 0; b < 2; ++b)
#pragma unroll
            for (int m = 0; m < 4; ++m)
#pragma unroll
                for (int n = 0; n < 2; ++n) acc[a][b][m][n] = (f32x4){0.f, 0.f, 0.f, 0.f};
    bf16x8 At[4][2], B0[2][2], B1[2][2];
    const char* cA = (const char*)g.A + (size_t)cur.pm * tstep; const char* cB = (const char*)g.Bt + (size_t)cur.pn * tstep;
    S.a_ready(cur);
    if constexpr (SP2) {
        PG8_STAGE(PG8_SB(0, 0), cB, voffB); PG8_STAGE(PG8_SB(0, 1), cB + hstep, voffB); PG8_STAGE(PG8_SA(0, 0), cA, voffA); PG8_STAGE(PG8_SA(0, 1), cA + hstep, voffA);
        if (wr == 1) PG8_BAR;
        PG8_WAIT_V(2); PG8_BAR;
        PG8_STAGE(PG8_SB(1, 0), cB + kstep, voffB); PG8_STAGE(PG8_SA(1, 0), cA + kstep, voffA); PG8_STAGE(PG8_SB(1, 1), cB + hstep + kstep, voffB);
        PG8_WAIT_V(6); PG8_BAR;
    } else {
        PG8_STAGE(PG8_SB(0, 0), cB, voffB); PG8_STAGE(PG8_SA(0, 0), cA, voffA); PG8_STAGE(PG8_SB(0, 1), cB + hstep, voffB); PG8_STAGE(PG8_SA(0, 1), cA + hstep, voffA);
        if (wr == 1) PG8_BAR;
        PG8_WAIT_V(4); PG8_BAR;
        PG8_STAGE(PG8_SB(1, 0), cB + kstep, voffB); PG8_STAGE(PG8_SA(1, 0), cA + kstep, voffA); PG8_STAGE(PG8_SB(1, 1), cB + hstep + kstep, voffB);
        PG8_WAIT_V(6); PG8_BAR;
    }
    for (;;) {
        const bool has_next = S.next(ui + 1, nxt);
        const char* nA = has_next ? (const char*)g.A + (size_t)nxt.pm * tstep : cA; const char* nB = has_next ? (const char*)g.Bt + (size_t)nxt.pn * tstep : cB;
        for (int t = 0; t < nt; t += 2) {
            const bool last = (t == nt - 2);
            const char* a1 = cA + (size_t)(t + 1) * kstep;
            const char* a2 = last ? nA : cA + (size_t)(t + 2) * kstep; const char* b2 = last ? nB : cB + (size_t)(t + 2) * kstep;
            const char* a3 = a2 + kstep; const char* b3 = b2 + kstep;
            if (last && has_next) S.a_ready(nxt);
            if constexpr (SP2) {
            PG8_LDB(B0, 0, 0); PG8_LDB(B1, 0, 1); PG8_SCHED; PG8_LDA(At, 0, 0); PG8_STAGE(PG8_SA(1, 1), a1 + hstep, voffA);
            PG8_WAIT_V(8); PG8_WAIT_L(0); PG8_BAR; PG8_MMA(0, 0, At, B0); PG8_MMA(0, 1, At, B1); PG8_BAR; PG8_SCHED;
            PG8_LDA(At, 0, 1); PG8_STAGE(PG8_SB(0, 0), b2, voffB); PG8_STAGE(PG8_SB(0, 1), b2 + hstep, voffB); PG8_STAGE(PG8_SA(0, 0), a2, voffA);
            PG8_WAIT_V(8); PG8_WAIT_L(0); PG8_BAR; PG8_MMA(1, 0, At, B0); PG8_MMA(1, 1, At, B1); PG8_BAR; PG8_SCHED;
            PG8_LDB(B0, 1, 0); PG8_LDB(B1, 1, 1); PG8_SCHED; PG8_LDA(At, 1, 0); PG8_STAGE(PG8_SA(0, 1), a2 + hstep, voffA);
            PG8_WAIT_V(8); PG8_WAIT_L(0); PG8_BAR; PG8_MMA(0, 0, At, B0); PG8_MMA(0, 1, At, B1); PG8_BAR; PG8_SCHED;
            PG8_LDA(At, 1, 1); PG8_STAGE(PG8_SB(1, 0), b3, voffB); PG8_STAGE(PG8_SB(1, 1), b3 + hstep, voffB); PG8_STAGE(PG8_SA(1, 0), a3, voffA);
            PG8_WAIT_V(8); PG8_WAIT_L(0); PG8_BAR; PG8_MMA(1, 0, At, B0); PG8_MMA(1, 1, At, B1); PG8_BAR; PG8_SCHED;
            } else {
            PG8_LDB(B0, 0, 0); PG8_SCHED; PG8_LDA(At, 0, 0); PG8_STAGE(PG8_SA(1, 1), a1 + hstep, voffA);
            PG8_WAIT_L(8); PG8_BAR; PG8_WAIT_L(0); PG8_MMA(0, 0, At, B0); PG8_BAR; PG8_SCHED;
            PG8_LDB(B1, 0, 1); PG8_STAGE(PG8_SB(0, 0), b2, voffB);
            PG8_BAR; PG8_WAIT_L(0); PG8_MMA(0, 1, At, B1); PG8_BAR;
            PG8_LDA(At, 0, 1); PG8_STAGE(PG8_SA(0, 0), a2, voffA);
            PG8_BAR; PG8_WAIT_L(0); PG8_MMA(1, 0, At, B0); PG8_BAR; PG8_SCHED;
            PG8_STAGE(PG8_SB(0, 1), b2 + hstep, voffB);
            PG8_WAIT_V(6); PG8_BAR; PG8_MMA(1, 1, At, B1); PG8_BAR;
            PG8_LDB(B0, 1, 0); PG8_SCHED; PG8_LDA(At, 1, 0); PG8_STAGE(PG8_SA(0, 1), a2 + hstep, voffA);
            PG8_WAIT_L(8); PG8_BAR; PG8_WAIT_L(0); PG8_MMA(0, 0, At, B0); PG8_BAR; PG8_SCHED;
            PG8_LDB(B1, 1, 1); PG8_STAGE(PG8_SB(1, 0), b3, voffB);
            PG8_BAR; PG8_WAIT_L(0); PG8_MMA(0, 1, At, B1); PG8_BAR;
            PG8_LDA(At, 1, 1); PG8_STAGE(PG8_SA(1, 0), a3, voffA);
            PG8_BAR; PG8_WAIT_L(0); PG8_MMA(1, 0, At, B0); PG8_BAR; PG8_SCHED;
            PG8_STAGE(PG8_SB(1, 1), b3 + hstep, voffB);
            PG8_WAIT_V(6); PG8_BAR; PG8_MMA(1, 1, At, B1); PG8_BAR;
            }
        }
        if constexpr (ALIGN_EPI) { if (wr == 0) PG8_BAR; }
        if constexpr (Epi::LNX) { E.lnx(acc, cur, !has_next, wr, wc, fr, fq, lds + STAGE_BYTES, wid, lane); } else if constexpr (!Epi::AFTER_DRAIN) { E(acc, cur, wr, wc, fr, fq); S.done(cur); }
        if (!has_next) break;
#pragma unroll
        for (int a = 0; a < 2; ++a)
#pragma unroll
            for (int b = 0; b < 2; ++b)
#pragma unroll
                for (int m = 0; m < 4; ++m)
#pragma unroll
                    for (int n = 0; n < 2; ++n) acc[a][b][m][n] = (f32x4){0.f, 0.f, 0.f, 0.f};
        cur = nxt; cA = nA; cB = nB; ++ui;
        if constexpr (ALIGN_EPI) { if (wr == 1) PG8_BAR; }
    }
    PG8_WAIT_V(0);
    if constexpr (!ALIGN_EPI) { if (wr == 0) PG8_BAR; }
    PG8_BAR;
    if constexpr (Epi::AFTER_DRAIN) { E.fused(acc, cur, wr, wc, fr, fq, lds, wid, lane); S.done(cur); }
#undef PG8_SA
#undef PG8_SB
#undef PG8_STAGE
#undef PG8_LDA
#undef PG8_LDB
#undef PG8_MMA
#undef PG8_WAIT_V
#undef PG8_WAIT_L
#undef PG8_BAR
#undef PG8_SCHED
}
}

namespace att {
typedef unsigned short bf16_t;
typedef short bf16x8 __attribute__((ext_vector_type(8)));
typedef short s16x4 __attribute__((ext_vector_type(4)));
typedef float f32x16 __attribute__((ext_vector_type(16)));
typedef float f32x4 __attribute__((ext_vector_type(4)));
typedef unsigned u32x4 __attribute__((ext_vector_type(4)));
constexpr int D = 128, NW = 8, QBLK = 32, KVBLK = 64, QB = NW * QBLK;
constexpr int SHM_V = KVBLK * D * 2, SHM_K = KVBLK * D * 2;
constexpr int SCR_OFF = 4 * SHM_V + 4 * SHM_K, STG_OFF = SCR_OFF + NW * 64 * 4;
constexpr int LDS_BYTES = STG_OFF + NW * 2048;
constexpr float THR = 8.f;
constexpr int W = 129;

#define KSWZ(row, colB) ((row) * 256 + ((colB) ^ (((row) & 7) << 4)))
#define SBAR() __builtin_amdgcn_sched_barrier(0)
__device__ __forceinline__ int v_st(int k, int c) { const int kk = (k & ~0xC) | ((k & 4) << 1) | ((k & 8) >> 1); return ((kk >> 3) * 4 + (c >> 5)) * 512 + ((kk & 7) * 32 + (c & 31)) * 2; }
__device__ __forceinline__ int v_rd_base(int lane) { return ((lane & 3) << 3) | (((lane >> 2) & 3) << 6) | (((lane >> 4) & 1) << 5) | (((lane >> 5) & 1) << 8); }
constexpr int v_rd_off(int d0, int ks, int half) { return d0 * 512 + ks * 4096 + half * 2048; }
__device__ __forceinline__ int crow(int r, int hi) { return (r & 3) + 8 * (r >> 2) + 4 * hi; }
__device__ __forceinline__ unsigned cvtpk(float lo, float hi) { unsigned r; asm volatile("v_cvt_pk_bf16_f32 %0, %1, %2" : "=v"(r) : "v"(lo), "v"(hi)); return r; }
__device__ __forceinline__ bf16x8 load8(const bf16_t* p) { return *reinterpret_cast<const bf16x8*>(p); }
__device__ __forceinline__ void mask_tile(f32x16& p0, f32x16& p1, int dq, unsigned Wm) {
    const float NEG = -__builtin_inff();
#pragma unroll
    for (int r = 0; r < 16; ++r) {
        const int c = (r & 3) + 8 * (r >> 2);
        if ((unsigned)(dq - c) >= Wm) p0[r] = NEG;
        if ((unsigned)(dq - c - 32) >= Wm) p1[r] = NEG;
    }
}
__device__ __forceinline__ void partialSM(f32x16& p0, f32x16& p1, float& m_reg, float& mn, float& alpha) {
    float pmax = p0[0]; for (int r = 1; r < 16; ++r) pmax = fmaxf(pmax, p0[r]); for (int r = 0; r < 16; ++r) pmax = fmaxf(pmax, p1[r]);
    { auto rr = __builtin_amdgcn_permlane32_swap(__float_as_uint(pmax), __float_as_uint(pmax), false, false);
      pmax = fmaxf(__uint_as_float(rr[0]), __uint_as_float(rr[1])); }
    if (__builtin_expect(__all((pmax - m_reg) <= THR), 1)) { mn = m_reg; alpha = 1.f; }
    else { mn = fmaxf(m_reg, pmax); alpha = __builtin_amdgcn_exp2f(m_reg - mn); m_reg = mn; }
    for (int r = 0; r < 16; ++r) p0[r] = p0[r] - mn; for (int r = 0; r < 16; ++r) p1[r] = p1[r] - mn;
    for (int r = 0; r < 16; ++r) p0[r] = __builtin_amdgcn_exp2f(p0[r]);
}
__device__ __forceinline__ void finishSM(f32x16& p0, f32x16& p1, float alpha, float& l_reg, bf16x8& pa0, bf16x8& pa1, bf16x8& pa2, bf16x8& pa3) {
    for (int r = 0; r < 16; ++r) p1[r] = __builtin_amdgcn_exp2f(p1[r]);
    float ps = 0; for (int r = 0; r < 16; ++r) ps += p0[r]; for (int r = 0; r < 16; ++r) ps += p1[r];
    { auto rr = __builtin_amdgcn_permlane32_swap(__float_as_uint(ps), __float_as_uint(ps), false, false);
      ps = __uint_as_float(rr[0]) + __uint_as_float(rr[1]); }
    l_reg = l_reg * alpha + ps;
#define PK4(P, B_, OUT) do { unsigned a0 = cvtpk(P[B_+0], P[B_+1]), a1 = cvtpk(P[B_+2], P[B_+3]);                          \
        unsigned b0 = cvtpk(P[B_+4], P[B_+5]), b1 = cvtpk(P[B_+6], P[B_+7]);                                             \
        auto r0 = __builtin_amdgcn_permlane32_swap(a0, b0, false, false); auto r1 = __builtin_amdgcn_permlane32_swap(a1, b1, false, false); \
        u32x4 w = {r0[0], r1[0], r0[1], r1[1]}; OUT = *reinterpret_cast<bf16x8*>(&w); } while (0)
    PK4(p0, 0, pa0); PK4(p0, 8, pa1); PK4(p1, 0, pa2); PK4(p1, 8, pa3);
#undef PK4
}
template <int KB>
__device__ __forceinline__ void qkt(f32x16& p0, f32x16& p1, const char* K_lds, int r32, int hi, const bf16x8* qr, bool act) {
    if (!act) { const float NEG = -__builtin_inff();
#pragma unroll
        for (int r = 0; r < 16; ++r) { p0[r] = NEG; p1[r] = NEG; } return; }
    p0 = f32x16{}; p1 = f32x16{};
    const char* kb[4];
#pragma unroll
    for (int dd = 0; dd < 4; ++dd) kb[dd] = K_lds + KB * SHM_K + KSWZ(r32, (dd * 16 + hi * 8) * 2);
#pragma unroll
    for (int d0 = 0; d0 < 8; ++d0) { const char* a = kb[d0 & 3] + (d0 >> 2) * 128;
        bf16x8 b0 = *reinterpret_cast<const bf16x8*>(a);
        bf16x8 b1 = *reinterpret_cast<const bf16x8*>(a + 32 * 256);
        p0 = __builtin_amdgcn_mfma_f32_32x32x16_bf16(b0, qr[d0], p0, 0, 0, 0);
        p1 = __builtin_amdgcn_mfma_f32_32x32x16_bf16(b1, qr[d0], p1, 0, 0, 0); }
}
template <int VB>
__device__ __forceinline__ void pv_tile(f32x16* o, int vb0, bf16x8 pa0, bf16x8 pa1, bf16x8 pa2, bf16x8 pa3, bool act) {
    if (!act) return;
#define TRRD(dst, off) asm volatile("ds_read_b64_tr_b16 %0, %1 offset:%2" : "=&v"(dst) : "v"(vb0), "i"(off) : "memory")
#define PV_D0(d0) do { s16x4 l0, l1, l2, l3, h0, h1, h2, h3; constexpr int b_ = VB * SHM_V + v_rd_off(d0, 0, 0);     \
        TRRD(l0, b_); TRRD(h0, b_ + 2048); TRRD(l1, b_ + 4096); TRRD(h1, b_ + 6144); TRRD(l2, b_ + 8192); TRRD(h2, b_ + 10240); TRRD(l3, b_ + 12288); TRRD(h3, b_ + 14336); \
        asm volatile("s_waitcnt lgkmcnt(0)" ::: "memory"); SBAR();                 \
        o[d0] = __builtin_amdgcn_mfma_f32_32x32x16_bf16(pa0, (bf16x8){l0[0], l0[1], l0[2], l0[3], h0[0], h0[1], h0[2], h0[3]}, o[d0], 0, 0, 0);   \
        o[d0] = __builtin_amdgcn_mfma_f32_32x32x16_bf16(pa1, (bf16x8){l1[0], l1[1], l1[2], l1[3], h1[0], h1[1], h1[2], h1[3]}, o[d0], 0, 0, 0);   \
        o[d0] = __builtin_amdgcn_mfma_f32_32x32x16_bf16(pa2, (bf16x8){l2[0], l2[1], l2[2], l2[3], h2[0], h2[1], h2[2], h2[3]}, o[d0], 0, 0, 0);   \
        o[d0] = __builtin_amdgcn_mfma_f32_32x32x16_bf16(pa3, (bf16x8){l3[0], l3[1], l3[2], l3[3], h3[0], h3[1], h3[2], h3[3]}, o[d0], 0, 0, 0); } while (0)
    PV_D0(0); PV_D0(1); PV_D0(2); PV_D0(3);
#undef PV_D0
#undef TRRD
}

__device__ __forceinline__ void pv_tile_p(f32x16* o, int vb0, bf16x8 pa0, bf16x8 pa1, bf16x8 pa2, bf16x8 pa3) {
#define TRRD(dst, off) asm volatile("ds_read_b64_tr_b16 %0, %1 offset:%2" : "=&v"(dst) : "v"(vb0), "i"(off) : "memory")
#define PVRD(S, ks) do { TRRD(S##l0, (ks) * 4096); TRRD(S##h0, (ks) * 4096 + 2048); TRRD(S##l1, 512 + (ks) * 4096); TRRD(S##h1, 512 + (ks) * 4096 + 2048); \
                         TRRD(S##l2, 1024 + (ks) * 4096); TRRD(S##h2, 1024 + (ks) * 4096 + 2048); TRRD(S##l3, 1536 + (ks) * 4096); TRRD(S##h3, 1536 + (ks) * 4096 + 2048); } while (0)
#define PVMF(S, pa) do { \
        o[0] = __builtin_amdgcn_mfma_f32_32x32x16_bf16((bf16x8){S##l0[0], S##l0[1], S##l0[2], S##l0[3], S##h0[0], S##h0[1], S##h0[2], S##h0[3]}, pa, o[0], 0, 0, 0); \
        o[1] = __builtin_amdgcn_mfma_f32_32x32x16_bf16((bf16x8){S##l1[0], S##l1[1], S##l1[2], S##l1[3], S##h1[0], S##h1[1], S##h1[2], S##h1[3]}, pa, o[1], 0, 0, 0); \
        o[2] = __builtin_amdgcn_mfma_f32_32x32x16_bf16((bf16x8){S##l2[0], S##l2[1], S##l2[2], S##l2[3], S##h2[0], S##h2[1], S##h2[2], S##h2[3]}, pa, o[2], 0, 0, 0); \
        o[3] = __builtin_amdgcn_mfma_f32_32x32x16_bf16((bf16x8){S##l3[0], S##l3[1], S##l3[2], S##l3[3], S##h3[0], S##h3[1], S##h3[2], S##h3[3]}, pa, o[3], 0, 0, 0); } while (0)
    s16x4 Al0, Ah0, Al1, Ah1, Al2, Ah2, Al3, Ah3, Bl0, Bh0, Bl1, Bh1, Bl2, Bh2, Bl3, Bh3;
    PVRD(A, 0); PVRD(B, 1);
    asm volatile("s_waitcnt lgkmcnt(8)" ::: "memory"); SBAR(); PVMF(A, pa0); SBAR();
    PVRD(A, 2);
    asm volatile("s_waitcnt lgkmcnt(8)" ::: "memory"); SBAR(); PVMF(B, pa1); SBAR();
    PVRD(B, 3);
    asm volatile("s_waitcnt lgkmcnt(8)" ::: "memory"); SBAR(); PVMF(A, pa2); SBAR();
    asm volatile("s_waitcnt lgkmcnt(0)" ::: "memory"); SBAR(); PVMF(B, pa3); SBAR();
#undef PVMF
#undef PVRD
#undef TRRD
}

struct Chain { const bf16_t* Q; const bf16_t* K; const bf16_t* V; bf16_t* O; float* L; int P0, M, pitch, lstride; };
struct Carry { bf16x8 qr[8]; int v; };
typedef __attribute__((address_space(3))) unsigned char lds_u8;
constexpr int AHEAD = MK_AHEAD;
#ifndef MK_EPI_REP
#define MK_EPI_REP 1
#endif
#ifndef MK_QKT_REP
#define MK_QKT_REP 1
#endif
__device__ __forceinline__ void dma_tile(lds_u8* ldsL, const bf16_t* Kp, const bf16_t* Vp, int pitch, int key0, int slot, int wid, int lane) {
#pragma unroll
    for (int i = 0; i < 2; ++i) {
        const int r = wid * 8 + i * 4 + (lane >> 4), c = (lane & 15) ^ (r & 7);
        __builtin_amdgcn_global_load_lds((const unsigned*)(Kp + (size_t)(key0 + r) * (size_t)pitch + c * 8), (__attribute__((address_space(3))) unsigned*)(ldsL + slot * SHM_K + wid * 2048 + i * 1024), 16, 0, 0);
    }
#pragma unroll
    for (int i = 0; i < 2; ++i) {
        const int ip = 2 * wid + i, sub = 2 * ip + (lane >> 5), kk = (sub >> 2) * 8 + ((lane & 31) >> 2), k = (kk & ~0xC) | ((kk & 4) << 1) | ((kk & 8) >> 1), c = (sub & 3) * 32 + (lane & 3) * 8;
        __builtin_amdgcn_global_load_lds((const unsigned*)(Vp + (size_t)(key0 + k) * (size_t)pitch + c), (__attribute__((address_space(3))) unsigned*)(ldsL + 4 * SHM_K + slot * SHM_V + ip * 1024), 16, 0, 0);
    }
}
#define VMWN(n) asm volatile("s_waitcnt vmcnt(" #n ")" ::: "memory")
#define LBAR() asm volatile("s_waitcnt lgkmcnt(0)\n\ts_barrier" ::: "memory")
#define LGKM0() asm volatile("s_waitcnt lgkmcnt(0)" ::: "memory")
__device__ __forceinline__ void vm_wait_le(int n) {
    if (n >= 20) VMWN(20); else if (n >= 16) VMWN(16); else if (n >= 12) VMWN(12); else if (n >= 8) VMWN(8); else if (n >= 4) VMWN(4); else VMWN(0);
}
#define QLD(dst, ptr, off) asm volatile("global_load_dwordx4 %0, %1, off offset:%2" : "+v"(dst) : "v"(ptr), "i"(off) : "memory")
#define QLD0(dst, ptr, off) asm volatile("global_load_dwordx4 %0, %1, off offset:%2" : "=v"(dst) : "v"(ptr), "i"(off) : "memory")
#define DSW32(addr, val, off) asm volatile("ds_write_b32 %0, %1 offset:%2" :: "v"(addr), "v"(val), "i"(off) : "memory")
#define DSW16(addr, val, off) asm volatile("ds_write_b16 %0, %1 offset:%2" :: "v"(addr), "v"(val), "i"(off) : "memory")
#define DSR32(dst, addr, off) asm volatile("ds_read_b32 %0, %1 offset:%2" : "=v"(dst) : "v"(addr), "i"(off) : "memory")
#define DSR128(dst, addr, off) asm volatile("ds_read_b128 %0, %1 offset:%2" : "=v"(dst) : "v"(addr), "i"(off) : "memory")
__device__ __forceinline__ void swc_prime(const Chain& c, lds_u8* ldsL, Carry& S) {
    int tid_ = threadIdx.x; asm volatile("" : "+v"(tid_));
    const int tid = tid_, wid = __builtin_amdgcn_readfirstlane(tid >> 6), lane = tid & 63, r32 = lane & 31, hi = lane >> 5;
    const int a0 = c.P0 / KVBLK - 2 + (c.P0 ? 0 : 2);
#pragma unroll
    for (int j = 0; j < AHEAD; ++j) dma_tile(ldsL, c.K, c.V, c.pitch, (a0 + j) * KVBLK, j, wid, lane);
    { const bf16_t* qp = c.Q + (size_t)(c.P0 + wid * QBLK + r32) * (size_t)c.pitch + hi * 8;
      QLD0(S.qr[0], qp, 0); QLD0(S.qr[1], qp, 32); QLD0(S.qr[2], qp, 64); QLD0(S.qr[3], qp, 96); QLD0(S.qr[4], qp, 128); QLD0(S.qr[5], qp, 160); QLD0(S.qr[6], qp, 192); QLD0(S.qr[7], qp, 224); }
    S.v = 0;
    VMWN(0); LBAR();
}
#define KRD(dst, base, off) asm volatile("ds_read_b128 %0, %1 offset:%2" : "=v"(dst) : "v"(base), "i"(off) : "memory")
__device__ __forceinline__ void qkt_rt(f32x16& p0, f32x16& p1, const char* K_lds, int kso, int r32, int hi, const bf16x8* qr) {
    p0 = f32x16{}; p1 = f32x16{};
    int kb[4];
#pragma unroll
    for (int dd = 0; dd < 4; ++dd) kb[dd] = (int)(uintptr_t)K_lds + kso + KSWZ(r32, (dd * 16 + hi * 8) * 2);
    bf16x8 fa[3], fb[3];
#define KLOAD(d0_, s_) do { if (((d0_) >> 2) == 0) { KRD(fa[s_], kb[(d0_) & 3], 0); KRD(fb[s_], kb[(d0_) & 3], 8192); } else { KRD(fa[s_], kb[(d0_) & 3], 128); KRD(fb[s_], kb[(d0_) & 3], 8320); } } while (0)
    KLOAD(0, 0); KLOAD(1, 1);
#pragma unroll
    for (int d0 = 0; d0 < 8; ++d0) {
        if (d0 + 2 < 8) { KLOAD(d0 + 2, (d0 + 2) % 3); asm volatile("s_waitcnt lgkmcnt(4)" ::: "memory"); }
        else if (d0 + 1 < 8) asm volatile("s_waitcnt lgkmcnt(2)" ::: "memory");
        else asm volatile("s_waitcnt lgkmcnt(0)" ::: "memory");
        SBAR();
        p0 = __builtin_amdgcn_mfma_f32_32x32x16_bf16(fa[d0 % 3], qr[d0], p0, 0, 0, 0);
        p1 = __builtin_amdgcn_mfma_f32_32x32x16_bf16(fb[d0 % 3], qr[d0], p1, 0, 0, 0);
        SBAR();
    }
#undef KLOAD
}
#undef KRD
__device__ __forceinline__ void swc_chain(const Chain& cur, const Chain& nxt, bool has_next, char* lds, lds_u8* ldsL, Carry& S) {
    int tid_ = threadIdx.x; asm volatile("" : "+v"(tid_));
    const int tid = tid_, wid = __builtin_amdgcn_readfirstlane(tid >> 6), lane = tid & 63, r32 = lane & 31, hi = lane >> 5, wh = wid >> 1;
    const int s0 = cur.P0 ? 0 : 2, T = 4 * cur.M + 2 - s0;
    const int A0 = cur.P0 / KVBLK - 2;
    const int a0n = nxt.P0 / KVBLK - 2 + (nxt.P0 ? 0 : 2);
    const int v0 = S.v;
    char* K_lds = lds;
    float m_reg = -1e30f, l_reg = 0; f32x16 o[4] = {};
    bool fresh = true, issued = true;
    const int vb0 = (int)(uintptr_t)lds + 4 * SHM_K + v_rd_base(lane);
    const int pit = cur.pitch;
#define CROFF(r) (((r) & 3) + 8 * ((r) >> 2))
#define ISSUE(j_) do { const int j = (j_), slot = (v0 + j) & 3; issued = false; \
        if (j < T) { dma_tile(ldsL, cur.K, cur.V, pit, (A0 + s0 + j) * KVBLK, slot, wid, lane); issued = true; } \
        else if (j > T && has_next) { dma_tile(ldsL, nxt.K, nxt.V, nxt.pitch, (a0n + (j - T - 1)) * KVBLK, slot, wid, lane); issued = true; } } while (0)
    for (int k = 0; k <= T; ++k) {
        const int sg = s0 + k, d = sg - wh, n = d >> 2, ph = d & 3, so = (v0 + k) & 3;
        const bool inu = (unsigned)n < (unsigned)cur.M, comp = inu && ph < 3;
        ISSUE(k + 2);
        int newer8 = 0;
        if (comp) {
            const int qlo = cur.P0 + 256 * n + wid * QBLK, qm = qlo + r32 - 4 * hi, kb_ = (A0 + sg) * KVBLK;
            f32x16 p0, p1; float mn, alpha; bf16x8 pa0, pa1, pa2, pa3;
            for (int rep_ = 0; rep_ < MK_QKT_REP; ++rep_) { SBAR(); qkt_rt(p0, p1, K_lds, so * SHM_K, r32, hi, S.qr); SBAR(); }
            if (ph == 2 && (n + 1 < cur.M || has_next)) {
                const bf16_t* qp = (n + 1 < cur.M) ? cur.Q + (size_t)(qlo + 256 + r32) * (size_t)pit + hi * 8
                                                   : nxt.Q + (size_t)(nxt.P0 + wid * QBLK + r32) * (size_t)nxt.pitch + hi * 8;
                QLD(S.qr[0], qp, 0); QLD(S.qr[1], qp, 32); QLD(S.qr[2], qp, 64); QLD(S.qr[3], qp, 96); QLD(S.qr[4], qp, 128); QLD(S.qr[5], qp, 160); QLD(S.qr[6], qp, 192); QLD(S.qr[7], qp, 224);
                newer8 = 8;
            }
            if (kb_ + KVBLK - 1 > qlo || kb_ <= qlo + QBLK - 1 - W) mask_tile(p0, p1, qm - kb_, (unsigned)W);
            partialSM(p0, p1, m_reg, mn, alpha);
            finishSM(p0, p1, alpha, l_reg, pa0, pa1, pa2, pa3);
            if (!fresh && __any(alpha < 1.f)) {
#pragma unroll
                for (int d_ = 0; d_ < 4; ++d_)
#pragma unroll
                    for (int r = 0; r < 16; ++r) o[d_][r] *= alpha;
            }
            fresh = false;
            SBAR(); pv_tile_p(o, vb0 + so * SHM_V, pa0, pa1, pa2, pa3); SBAR();
        } else if (inu) {
            const int qlo = cur.P0 + 256 * n + wid * QBLK;
            if (hi == 0) cur.L[(size_t)(qlo + r32) * (size_t)cur.lstride] = m_reg + __builtin_amdgcn_logf(l_reg);
            const float inv = __builtin_amdgcn_rcpf(l_reg);
            bf16_t* Ow = cur.O + (size_t)(qlo + r32) * (size_t)pit + 8 * hi;
#pragma unroll
            for (int d0 = 0; d0 < 4; ++d0)
#pragma unroll
                for (int h = 0; h < 2; ++h) {
                    const unsigned a0 = cvtpk(o[d0][8 * h + 0] * inv, o[d0][8 * h + 1] * inv), a1 = cvtpk(o[d0][8 * h + 2] * inv, o[d0][8 * h + 3] * inv);
                    const unsigned b0 = cvtpk(o[d0][8 * h + 4] * inv, o[d0][8 * h + 5] * inv), b1 = cvtpk(o[d0][8 * h + 6] * inv, o[d0][8 * h + 7] * inv);
                    auto r0 = __builtin_amdgcn_permlane32_swap(a0, b0, false, false); auto r1 = __builtin_amdgcn_permlane32_swap(a1, b1, false, false);
                    const u32x4 w_ = {r0[0], r1[0], r0[1], r1[1]};
                    *(u32x4*)(Ow + d0 * 32 + 16 * h) = w_;
                }
            newer8 = 8;
            m_reg = -1e30f; l_reg = 0; fresh = true;
#pragma unroll
            for (int d_ = 0; d_ < 4; ++d_) o[d_] = f32x16{};
        }
        vm_wait_le((issued ? 4 : 0) + newer8); LBAR();
    }
#undef ISSUE
#undef CROFF
    S.v = v0 + T + 1;
}
#undef QLD
#undef QLD0
#undef DSW32
#undef DSW16
#undef DSR32
#undef DSR128
#undef LGKM0
#undef VMWN
#undef LBAR
#undef KSWZ
#undef SBAR
}

constexpr int NWAVES = 8;
constexpr int N_LAUNCHES = MK_N_LAUNCHES;
constexpr int PER_PHASE = 5;
#ifndef MK_DUP_PHASE
#define MK_DUP_PHASE -1
#endif
constexpr int DUP_PHASE = MK_DUP_PHASE;
constexpr int BATCH = 4, SEQ = 4096, DM = 2048, M = BATCH * SEQ;
constexpr int NH = 8, HD = 128, DATT = 1024, DPOOL = 1024, DIN = 6144;
constexpr float LN_EPS = 1e-5f;
constexpr float DN_ALPHA = 1.189207115002721f;
constexpr float QSCALE = 1.4426950408889634f * 0.08838834764831845f;

constexpr size_t MiB = 1u << 20;
constexpr size_t WS_CTL = 0, CTL_ZERO_BYTES = 64 * 1024;
constexpr size_t WS_ROPE = 1 * MiB;
constexpr size_t WS_WOUT = 4 * MiB;
constexpr size_t WS_XB = 36 * MiB;
constexpr size_t WS_WIN = 100 * MiB;
constexpr size_t WS_O = 36 * MiB;
constexpr size_t WS_QKV = 132 * MiB;
constexpr size_t WS_Y = 132 * MiB;
constexpr size_t WS_U = 228 * MiB;
constexpr size_t WS_G = 260 * MiB;
constexpr size_t WS_L = 324 * MiB;
constexpr size_t WS_FOLD = 326 * MiB;
constexpr size_t WS_END = 334 * MiB;
constexpr size_t WS_X = 1 * MiB + 512 * 1024;
constexpr int CW_PANEL = 8192;
constexpr int CW_BAR = 1024;

constexpr int RING_BYTES = 131072;
constexpr int LDSCTL_OFF = 159744, MISC_OFF = LDSCTL_OFF + 320;
constexpr int LDS_BYTES = 163840;

#define GAS __attribute__((address_space(1)))
#define LAS __attribute__((address_space(3)))
typedef unsigned short bf16;
typedef unsigned v4u __attribute__((ext_vector_type(4)));
typedef unsigned v2u __attribute__((ext_vector_type(2)));
typedef float f32x4 __attribute__((ext_vector_type(4)));
typedef short bf16x8 __attribute__((ext_vector_type(8)));
typedef GAS unsigned gu32;
#define RLX_AGENT __ATOMIC_RELAXED, __HIP_MEMORY_SCOPE_AGENT
#define LDS_WAIT() asm volatile("s_waitcnt lgkmcnt(0)" ::: "memory")
#define VM_WAIT() asm volatile("s_waitcnt vmcnt(0)" ::: "memory")
__device__ __forceinline__ unsigned pk2(float lo, float hi) { unsigned r; asm volatile("v_cvt_pk_bf16_f32 %0, %1, %2" : "=v"(r) : "v"(lo), "v"(hi)); return r; }
__device__ __forceinline__ float bf_lo(unsigned w) { return __uint_as_float(w << 16); }
__device__ __forceinline__ float bf_hi(unsigned w) { return __uint_as_float(w & 0xffff0000u); }
__device__ __forceinline__ float silu_f(float g) { return g * __builtin_amdgcn_rcpf(1.f + __builtin_amdgcn_exp2f(-1.4426950408889634f * g)); }

#define XB_TMO      128
#define XB_XCNT(j)  (256  + 64 * (j))
#define XB_XSUB(j)  (1280 + 64 * (j))
#define XB_XGEN(j)  (2304 + 64 * (j))
#define XB_TOP      3328
#define XB_TOPGEN   3392
#define XCD_BAR_WORDS 3456
#define XB_SPIN_CAP (1u << 18)

__device__ __forceinline__ unsigned xb_ld(unsigned* p)              { return __hip_atomic_load(p, __ATOMIC_RELAXED, __HIP_MEMORY_SCOPE_AGENT); }
__device__ __forceinline__ unsigned xb_add(unsigned* p, unsigned v) { return __hip_atomic_fetch_add(p, v, __ATOMIC_RELAXED, __HIP_MEMORY_SCOPE_AGENT); }
__device__ __forceinline__ unsigned xb_xcc_id() { return (unsigned)__builtin_amdgcn_s_getreg((3 << 11) | 20) & 0xFu; }
#define XB_SPIN(cond, bar) do { unsigned _sp = 0; while (cond) { __builtin_amdgcn_s_sleep(1); \
    if ((++_sp & 255u) == 0u) { if (xb_ld(&(bar)[XB_TMO])) break; if (_sp > XB_SPIN_CAP) { atomicAdd(&(bar)[XB_TMO], 1u); break; } } } } while (0)

struct XcdBarrier {
    unsigned* bar; unsigned x;
    volatile LAS unsigned* st;
};

__device__ __forceinline__ XcdBarrier xcd_barrier_post(unsigned* bar, volatile LAS unsigned* st) {
    XcdBarrier b; b.bar = bar; b.x = xb_xcc_id(); b.st = st;
    if (threadIdx.x == 0) (void)xb_add(&bar[XB_XCNT(b.x)], 1u);
    return b;
}
__device__ __forceinline__ void xcd_barrier_complete(unsigned* bar, unsigned x, unsigned& nloc, unsigned& nx) {
    const unsigned G = gridDim.x * gridDim.y * gridDim.z;
    unsigned sum, cnt, mine, sp = 0u;
    for (;;) {
        sum = 0u; cnt = 0u; mine = 0u;
#pragma unroll
        for (unsigned j = 0; j < 16; ++j) { const unsigned c = xb_ld(&bar[XB_XCNT(j)]); sum += c; cnt += (c > 0u) ? 1u : 0u; mine = (j == x) ? c : mine; }
        if (sum == G) break;
        __builtin_amdgcn_s_sleep(1);
        if ((++sp & 255u) == 0u) { if (xb_ld(&bar[XB_TMO])) break; if (sp > XB_SPIN_CAP) { atomicAdd(&bar[XB_TMO], 1u); break; } }
    }
    nloc = mine > 0u ? mine : 1u; nx = cnt > 0u ? cnt : 1u;
}

__device__ __forceinline__ void xcd_barrier(const XcdBarrier& b) {
    asm volatile("s_waitcnt vmcnt(0)" ::: "memory");
    __syncthreads();
    if (threadIdx.x == 0) {
        unsigned* bar = b.bar;
        __builtin_amdgcn_s_waitcnt(0);
        unsigned nloc = b.st[0], nx = b.st[1];
        if (nloc == 0u) { xcd_barrier_complete(bar, b.x, nloc, nx); b.st[0] = nloc; b.st[1] = nx; }
        const unsigned old = xb_add(&bar[XB_XSUB(b.x)], 1u);
        const unsigned gen = old / nloc;
        if (old + 1u == (gen + 1u) * nloc) {
            __builtin_amdgcn_fence(__ATOMIC_RELEASE, "agent");
            asm volatile("s_waitcnt vmcnt(0)" ::: "memory");
            const unsigned og = xb_add(&bar[XB_TOP], 1u);
            const unsigned tg = og / nx;
            if (og + 1u == (tg + 1u) * nx) xb_add(&bar[XB_TOPGEN], 1u);
            else XB_SPIN(xb_ld(&bar[XB_TOPGEN]) == tg, bar);
            __builtin_amdgcn_fence(__ATOMIC_ACQUIRE, "agent");
            xb_add(&bar[XB_XGEN(b.x)], 1u);
            asm volatile("s_waitcnt vmcnt(0)" ::: "memory");
        } else {
            XB_SPIN(xb_ld(&bar[XB_XGEN(b.x)]) == gen, bar);
            __builtin_amdgcn_fence(__ATOMIC_ACQUIRE, "agent");
            asm volatile("s_waitcnt vmcnt(0)" ::: "memory");
        }
    }
    __syncthreads();
}

__device__ __forceinline__ void p0_transpose_item(const float* W, int K, int N, bf16* WT, LAS float* scr, int item, int lane) {
    const int nblk = N / 64, kb = item / nblk, nb = item % nblk, k0 = 64 * kb, n0 = 64 * nb;
    f32x4 v[16];
#pragma unroll
    for (int i = 0; i < 16; ++i) v[i] = __builtin_nontemporal_load((const GAS f32x4*)(W + (size_t)(k0 + 4 * i + (lane >> 4)) * N + n0 + 4 * (lane & 15)));
#pragma unroll
    for (int i = 0; i < 16; ++i) { LAS float* d = scr + (4 * i + (lane >> 4)) * 65 + 4 * (lane & 15); d[0] = v[i][0]; d[1] = v[i][1]; d[2] = v[i][2]; d[3] = v[i][3]; }
    LDS_WAIT(); asm volatile("" ::: "memory");
    const int c = lane & 7;
#pragma unroll
    for (int j = 0; j < 8; ++j) { const int n = (lane >> 3) + 8 * j; const LAS float* s = scr + (8 * c) * 65 + n;
        v4u o; o.x = pk2(s[0 * 65], s[1 * 65]); o.y = pk2(s[2 * 65], s[3 * 65]); o.z = pk2(s[4 * 65], s[5 * 65]); o.w = pk2(s[6 * 65], s[7 * 65]);
        *(GAS v4u*)(WT + (size_t)(n0 + n) * K + k0 + 8 * c) = o; }
    LDS_WAIT(); asm volatile("" ::: "memory");
}
__device__ __forceinline__ void sincos_pi(double r, double& s, double& c) {
    const double z = r * r;
    double ss = 0.0, cc = 0.0, term_s = r, term_c = 1.0;
#pragma unroll
    for (int k = 0; k < 16; ++k) { ss += term_s; cc += term_c; term_c = -term_c * z * (1.0 / (double)((2 * k + 1) * (2 * k + 2))); term_s = -term_s * z * (1.0 / (double)((2 * k + 2) * (2 * k + 3))); }
    s = ss; c = cc;
}
__device__ __forceinline__ void p0_prologue(LAS unsigned char* lds, const float* x, const float* w_in, const float* w_pool, const float* w_out, unsigned char* ws, int vcu, int G, int tid, int wave, int lane) {
    LAS float* scr = (LAS float*)(lds + wave * 16896);
    bf16* WinT = (bf16*)(ws + WS_WIN); bf16* WoutT = (bf16*)(ws + WS_WOUT);
    const bool fold = (G == 256) && (vcu < 32);
    if (fold) {
        const int g = vcu >> 3, j = vcu & 7;
        bf16* Ap = (bf16*)(ws + WS_FOLD) + (size_t)vcu * 131072;
        bf16* Bp = Ap + 65536;
        for (int it = wave; it < 16; it += NWAVES) p0_transpose_item(w_pool + (size_t)g * 65536, 256, 256, Ap, scr, it, lane);
        {
            f32x4 a[16], b[16];
#pragma unroll
            for (int k = 0; k < 16; ++k) { const int e = tid + k * (NWAVES * 64), r = e >> 5, c8 = e & 31;
                const float* s = w_in + (size_t)(256 * j + r) * DIN + 3072 + 256 * g + c8 * 8;
                a[k] = __builtin_nontemporal_load((const GAS f32x4*)s); b[k] = __builtin_nontemporal_load((const GAS f32x4*)(s + 4)); }
#pragma unroll
            for (int k = 0; k < 16; ++k) { const int e = tid + k * (NWAVES * 64), r = e >> 5, c8 = e & 31;
                v4u o; o.x = pk2(a[k][0], a[k][1]); o.y = pk2(a[k][2], a[k][3]); o.z = pk2(b[k][0], b[k][1]); o.w = pk2(b[k][2], b[k][3]);
                *(GAS v4u*)(Bp + (size_t)r * 256 + c8 * 8) = o; }
        }
        VM_WAIT(); __syncthreads();
        pg8::Gemm gg{Ap, Bp, 256, 256, 256}; pg8::SchedOne S1; pg8::EpiW E{WinT + (size_t)(3072 + 256 * g) * DM + 256 * j};
        pg8::gemm_phase<pg8::EpiW, pg8::SchedOne, true, true>(lds, gg, S1, E);
    }
    {
        const int nfold = (G == 256) ? 32 : 0;
        const int gw = (vcu - nfold) * NWAVES + wave, NGW = (G - nfold) * NWAVES;
        constexpr int I_IN = (DM / 64) * (DIN / 64), I_OUT = (DM / 64) * (DM / 64), NITEMS = I_IN + I_OUT;
        if (!fold) for (int it = gw; it < NITEMS; it += NGW) {
            int r = it;
            if (r < I_IN) { const int nb = r % (DIN / 64); if (G == 256 && nb >= 48 && nb < 64) continue; p0_transpose_item(w_in, DM, DIN, WinT, scr, r, lane); continue; } r -= I_IN;
            p0_transpose_item(w_out, DM, DM, WoutT, scr, r, lane);
        }
    }
    {
        const size_t gt = (size_t)vcu * (NWAVES * 64) + tid, NT = (size_t)G * (NWAVES * 64);
        bf16* XB = (bf16*)(ws + WS_XB);
        const int nf = (G == 256) ? 32 : 0, slots = fold ? 3 : 5, slot0 = fold ? 3 * vcu : 3 * nf + 5 * (vcu - nf), nslots = 3 * nf + 5 * (G - nf);
        constexpr int XU = 4;
        for (int sl = 0; sl < slots; ++sl) {
            const size_t st = (size_t)(slot0 + sl) * (NWAVES * 64) + tid, SN = (size_t)nslots * (NWAVES * 64);
            for (size_t i = st; i < (size_t)M * DM / 8; i += SN * XU) {
                f32x4 a[XU], b[XU];
#pragma unroll
                for (int k = 0; k < XU; ++k) { const size_t ii = i + (size_t)k * SN; a[k] = (f32x4){0.f, 0.f, 0.f, 0.f}; b[k] = a[k];
                    if (ii < (size_t)M * DM / 8) { a[k] = __builtin_nontemporal_load((const GAS f32x4*)(x + ii * 8)); b[k] = __builtin_nontemporal_load((const GAS f32x4*)(x + ii * 8 + 4)); } }
#pragma unroll
                for (int k = 0; k < XU; ++k) { const size_t ii = i + (size_t)k * SN;
                    v4u o; o.x = pk2(a[k][0], a[k][1]); o.y = pk2(a[k][2], a[k][3]); o.z = pk2(b[k][0], b[k][1]); o.w = pk2(b[k][2], b[k][3]);
                    if (ii < (size_t)M * DM / 8) *(GAS v4u*)(XB + ii * 8) = o; }
            }
        }
        float* rope = (float*)(ws + WS_ROPE);
        for (size_t e = gt; e < 65536; e += NT) {
            const int i = (int)(e & 15), pos = (int)(e >> 4);
            double f;
            switch (i) { case 0: f = 1.0; break; case 1: f = 0.44036660267178046; break; case 2: f = 0.19392274474868576; break; case 3: f = 0.08539710028576561; break;
                case 4: f = 0.03760603093086393; break; case 5: f = 0.016560440080994446; break; case 6: f = 0.007292664737217109; break; case 7: f = 0.003211445994752591; break;
                case 8: f = 0.001414213562373095; break; case 9: f = 0.000622772421914596; break; case 10: f = 0.0002742481756762073; break; case 11: f = 0.00012076973741146504; break;
                case 12: f = 5.318295896944988e-05; break; case 13: f = 2.341999896140934e-05; break; case 14: f = 1.031338537721246e-05; break; default: f = 4.5416704806078695e-06; break; }
            const double ang = (double)pos * f;
            const double k = __builtin_rint(ang * 0.15915494309189535);
            const double r = __builtin_fma(-k, 2.4492935982947064e-16, __builtin_fma(-k, 6.283185307179586, ang));
            double s, c; sincos_pi(r, s, c);
            rope[e] = (float)c; rope[65536 + e] = (float)s;
        }
    }
}

template <int W>
__device__ __forceinline__ void pool_strip(const bf16* V, const bf16* Gt, const float* pool_scale, bf16* Y, int g, int strip, int ch) {
    const int tok0 = strip * 8, t0 = tok0 & 4095, col = g * 256 + ch * 8;
    constexpr int NR = W - 1 + 8;
    v4u rows[NR];
#pragma unroll
    for (int j = 0; j < NR; ++j) { const int dt = j - (W - 1); rows[j] = (v4u){0u, 0u, 0u, 0u}; if (t0 + dt >= 0) rows[j] = *(const GAS v4u*)(V + (size_t)(tok0 + dt) * 1024 + col); }
    const f32x4 sa = *(const GAS f32x4*)(pool_scale + col), sb = *(const GAS f32x4*)(pool_scale + col + 4);
    const float sc[8] = {sa[0], sa[1], sa[2], sa[3], sb[0], sb[1], sb[2], sb[3]};
    float s[8];
#pragma unroll
    for (int k = 0; k < 8; ++k) s[k] = 0.f;
#pragma unroll
    for (int j = 0; j < W - 1; ++j)
#pragma unroll
        for (int k = 0; k < 4; ++k) { s[2 * k] += bf_lo(rows[j][k]); s[2 * k + 1] += bf_hi(rows[j][k]); }
    v4u gts[8];
#pragma unroll
    for (int i = 0; i < 8; ++i) gts[i] = __builtin_nontemporal_load((const GAS v4u*)(Gt + (size_t)(tok0 + i) * 2048 + 1024 + col));
#pragma unroll
    for (int i = 0; i < 8; ++i) {
        const v4u q = rows[W - 1 + i];
        const v4u gt = gts[i];
        const int cnt = (t0 + i + 1 < W) ? t0 + i + 1 : W;
        const float inv = 1.f / (float)cnt;
        v4u o;
#pragma unroll
        for (int k = 0; k < 4; ++k) { const float u0 = bf_lo(q[k]), u1 = bf_hi(q[k]); s[2 * k] += u0; s[2 * k + 1] += u1;
            o[k] = pk2((s[2 * k] * inv - u0) * sc[2 * k] * silu_f(bf_lo(gt[k])), (s[2 * k + 1] * inv - u1) * sc[2 * k + 1] * silu_f(bf_hi(gt[k]))); }
        *(GAS v4u*)(Y + (size_t)(tok0 + i) * 2048 + 1024 + col) = o;
#pragma unroll
        for (int k = 0; k < 4; ++k) { s[2 * k] -= bf_lo(rows[i][k]); s[2 * k + 1] -= bf_hi(rows[i][k]); }
    }
}
__device__ __forceinline__ void pool_phase(const bf16* V, const bf16* Gt, const float* pool_scale, bf16* Y, int vcu, int G, int tid) {
    for (int it = vcu * (NWAVES * 64) + tid; it < 262144; it += G * (NWAVES * 64)) {
        asm volatile("" ::: "memory");
        const int ch = it & 31, sub = (it >> 5) & 1, g = __builtin_amdgcn_readfirstlane((it >> 6) & 3), strip = ((it >> 8) << 1) | sub;
        switch (g) { case 0: pool_strip<2>(V, Gt, pool_scale, Y, 0, strip, ch); break; case 1: pool_strip<4>(V, Gt, pool_scale, Y, 1, strip, ch); break;
                     case 2: pool_strip<8>(V, Gt, pool_scale, Y, 2, strip, ch); break; default: pool_strip<16>(V, Gt, pool_scale, Y, 3, strip, ch); break; }
    }
}

__device__ __forceinline__ void combine_phase(const bf16* O, const float* L, const bf16* Gt, bf16* Y, int vcu, int G, int tid) {
    const size_t gt = (size_t)vcu * (NWAVES * 64) + tid, NT = (size_t)G * (NWAVES * 64);
    constexpr size_t PST = (size_t)32 * 4096 * 128, LST = (size_t)32 * 4096;
    constexpr int CU_ = 4;
    for (size_t idx0 = gt; idx0 < (size_t)32 * 4096 * 16; idx0 += NT * CU_) {
        v4u o1[CU_], o2[CU_], o3[CU_], gv[CU_]; float l1[CU_], l2[CU_], l3[CU_]; size_t yo[CU_];
#pragma unroll
        for (int k = 0; k < CU_; ++k) { const size_t idx = idx0 + (size_t)k * NT;
            const int c8 = (int)(idx & 15), t = (int)((idx >> 4) & 4095), bh = (int)(idx >> 16);
            const size_t oo = ((size_t)bh * 4096 + t) * 128 + c8 * 8, lo = (size_t)bh * 4096 + t;
            o1[k] = *(const GAS v4u*)(O + oo); o2[k] = *(const GAS v4u*)(O + PST + oo); o3[k] = *(const GAS v4u*)(O + 2 * PST + oo);
            l1[k] = L[lo]; l2[k] = L[LST + lo]; l3[k] = L[2 * LST + lo];
            yo[k] = ((size_t)((bh >> 3) * 4096 + t)) * 2048 + (bh & 7) * 128 + c8 * 8;
            gv[k] = *(const GAS v4u*)(Gt + yo[k]); }
#pragma unroll
        for (int k = 0; k < CU_; ++k) {
            const float mx = fmaxf(l1[k], fmaxf(l2[k], l3[k]));
            float w1 = __builtin_amdgcn_exp2f(l1[k] - mx), w2 = __builtin_amdgcn_exp2f(l2[k] - mx), w3 = __builtin_amdgcn_exp2f(l3[k] - mx);
            const float inv = 1.f / (w1 + w2 + w3); w1 *= inv; w2 *= inv; w3 *= inv;
            v4u out;
#define CMB(e) { const float a = (w1 * bf_lo(o1[k][e]) + w2 * bf_lo(o2[k][e]) + w3 * bf_lo(o3[k][e])) * silu_f(bf_lo(gv[k][e])); const float b = (w1 * bf_hi(o1[k][e]) + w2 * bf_hi(o2[k][e]) + w3 * bf_hi(o3[k][e])) * silu_f(bf_hi(gv[k][e])); out[e] = pk2(a, b); }
            CMB(0) CMB(1) CMB(2) CMB(3)
#undef CMB
            *(GAS v4u*)(Y + yo[k]) = out;
        }
    }
}

struct Args { const float* x; const float* w_in; const float* w_pool; const float* pool_scale; const float* w_out; const float* ln_gain; const float* ln_bias; float* out; unsigned char* ws; int ph_lo, ph_hi; };
__global__ void __launch_bounds__(NWAVES * 64, 2) hybrid_fwd(Args args) {
    extern __shared__ __attribute__((aligned(16))) unsigned char lds_raw[];
    LAS unsigned char* lds = (LAS unsigned char*)lds_raw;
    volatile LAS unsigned* MISC = (volatile LAS unsigned*)(lds + MISC_OFF);
    const int tid = threadIdx.x, lane = tid & 63, wave = __builtin_amdgcn_readfirstlane(tid >> 6);
    const int G = gridDim.x; const int bx = blockIdx.x; const int vcu = (G % 8 == 0) ? (bx % 8) * (G / 8) + bx / 8 : bx;
    unsigned char* ws = args.ws;
    gu32* ctl = (gu32*)(ws + WS_CTL);
    for (int u = tid; u < (LDS_BYTES - LDSCTL_OFF) / 4; u += NWAVES * 64) ((LAS unsigned*)(lds + LDSCTL_OFF))[u] = 0u;
    __syncthreads();
    XcdBarrier bar; bar.bar = (unsigned*)(ctl + CW_BAR); bar.x = 0; bar.st = nullptr;
    if (N_LAUNCHES != PER_PHASE) bar = xcd_barrier_post((unsigned*)(ctl + CW_BAR), MISC + 8);
#define GRID_BAR() do { if (N_LAUNCHES != PER_PHASE) xcd_barrier(bar); } while (0)
#if defined(MK_STAMP_PHASE)
#define STAMP(k) do { if (tid == 0) { const unsigned long long t__ = __builtin_amdgcn_s_memrealtime(); MISC[16 + 2 * (k)] = (unsigned)t__; MISC[17 + 2 * (k)] = (unsigned)(t__ >> 32); } } while (0)
#else
#define STAMP(k)
#endif
    STAMP(0);
    const int lo = (N_LAUNCHES == 1) ? 0 : args.ph_lo, hi = (N_LAUNCHES == 1) ? PER_PHASE : args.ph_hi;
#define IN(k) (lo <= (k) && (k) < hi)
#if MK_DUP_PHASE >= 0
#define REP(k) for (int rep_ = 0; rep_ < (DUP_PHASE == (k) ? 2 : 1); ++rep_)
#else
#define REP(k)
#endif
#define BOTH(k) (IN(k) && IN((k) + 1))
    bf16* XB = (bf16*)(ws + WS_XB); bf16* WinT = (bf16*)(ws + WS_WIN); bf16* WoutT = (bf16*)(ws + WS_WOUT);
    bf16* QKV = (bf16*)(ws + WS_QKV); bf16* Ub = (bf16*)(ws + WS_U); bf16* Gb = (bf16*)(ws + WS_G); bf16* Ob = (bf16*)(ws + WS_O); float* Lb = (float*)(ws + WS_L); bf16* Yb = (bf16*)(ws + WS_Y);
    float* rope = (float*)(ws + WS_ROPE);

    REP(0) if (IN(0)) { int t_ = threadIdx.x; asm volatile("" : "+v"(t_)); p0_prologue(lds, args.x, args.w_in, args.w_pool, args.w_out, ws, vcu, G, t_, __builtin_amdgcn_readfirstlane(t_ >> 6), t_ & 63); if (BOTH(0)) GRID_BAR(); STAMP(1); }

    REP(1) if (IN(1)) {
        pg8::Gemm g{XB, WinT, M, DIN, DM}; pg8::StaticOrder S; S.init(M, DIN, G, bx); S.rev = true;
        pg8::EpiH E{QKV, Ub, Gb, rope, QSCALE};
        pg8::gemm_phase<pg8::EpiH, pg8::StaticOrder, true, true>(lds, g, S, E);
        if (BOTH(1)) GRID_BAR();
        STAMP(2);
    }

    REP(2) if (IN(2)) {
#if defined(MK_DUP_SUB) && MK_DUP_SUB == 1
        for (int rs_ = 0; rs_ < 2; ++rs_)
#endif
        if (G == 256) {
            att::Carry S;
            att::Chain cur, nxt;
#define MKCH(R, c) do { const int c_ = (c), bh = (vcu >> 3), kk = vcu & 7, pt = c_ ? 2 : (kk >> 2), res = c_ ? 2 * kk + c_ - 1 : (kk < 4 ? 0 : kk - 4), dil = 1 << (2 * pt); \
                const size_t hb = (size_t)bh * 4096 * 128 + (size_t)res * 128; \
                R.Q = QKV + hb; R.K = QKV + (size_t)32 * 4096 * 128 + hb; R.V = QKV + (size_t)64 * 4096 * 128 + hb; R.O = Ob + (size_t)(32 * pt) * 4096 * 128 + hb; \
                R.L = Lb + (size_t)(32 * pt + bh) * 4096 + res; R.P0 = (c_ == 0 && kk < 4) ? 1024 * kk : 0; R.M = c_ ? 1 : 4; R.pitch = 128 * dil; R.lstride = dil; } while (0)
            MKCH(cur, 0);
            att::swc_prime(cur, lds, S);
            for (int i = 0; i < 3; ++i) {
                if (i < 2) MKCH(nxt, i + 1); else nxt = cur;
                att::swc_chain(cur, nxt, i < 2, (char*)lds_raw, lds, S);
                cur = nxt;
            }
#undef MKCH
            VM_WAIT(); __syncthreads();
        }
        if (BOTH(2)) GRID_BAR();
        STAMP(3);
    }

    REP(3) if (IN(3)) { int t_ = threadIdx.x; asm volatile("" : "+v"(t_)); combine_phase(Ob, Lb, Gb, Yb, vcu, G, t_);
        pool_phase(Ub, Gb, args.pool_scale, Yb, vcu, G, t_);
        if (BOTH(3)) GRID_BAR(); STAMP(4); }

    REP(4) if (IN(4)) {
        pg8::Gemm g{Yb, WoutT, M, DM, DM}; pg8::SchedLN S{(int)bx};
        pg8::EpiLN E{args.x, args.out, args.ln_gain, args.ln_bias, DN_ALPHA, LN_EPS, (unsigned long long*)(ws + WS_X), (unsigned*)(ctl + CW_PANEL)};
        if (G == 256) pg8::gemm_phase<pg8::EpiLN, pg8::SchedLN, true, true>(lds, g, S, E);
    }
#if defined(MK_STAMP_PHASE)
    STAMP(5);
    if (blockIdx.x == 0 && tid == 0) {
        const unsigned long long a = ((unsigned long long)MISC[17 + 2 * MK_STAMP_PHASE] << 32) | MISC[16 + 2 * MK_STAMP_PHASE], b = ((unsigned long long)MISC[19 + 2 * MK_STAMP_PHASE] << 32) | MISC[18 + 2 * MK_STAMP_PHASE];
        const unsigned long long t0 = __builtin_amdgcn_s_memrealtime(), want = 8ull * (b - a);
        while (__builtin_amdgcn_s_memrealtime() - t0 < want) __builtin_amdgcn_s_sleep(8);
    }
#endif
#undef IN
#undef BOTH
#undef GRID_BAR
}

extern "C" void kernel_launch(void* const* d_in, const int* in_sizes, int n_in, void* d_out, int out_size, void* d_ws, size_t ws_size, hipStream_t stream) {
    static int grid = 0;
    if (grid == 0) {
        if (n_in != 7 || in_sizes[0] != M * DM || out_size != M * DM || ws_size < WS_END) { fprintf(stderr, "kernel_launch: shape mismatch (n_in %d in0 %d out %d ws %zu)\n", n_in, n_in > 0 ? in_sizes[0] : -1, out_size, ws_size); grid = -1; return; }
        int dev = 0, cus = 0, per_cu = 0;
        if (hipGetDevice(&dev) != hipSuccess || hipDeviceGetAttribute(&cus, hipDeviceAttributeMultiprocessorCount, dev) != hipSuccess) { fprintf(stderr, "kernel_launch: device query failed\n"); grid = -1; return; }
        if (hipFuncSetAttribute((const void*)hybrid_fwd, hipFuncAttributeMaxDynamicSharedMemorySize, LDS_BYTES) != hipSuccess) { fprintf(stderr, "kernel_launch: hipFuncSetAttribute failed\n"); grid = -1; return; }
        if (hipOccupancyMaxActiveBlocksPerMultiprocessor(&per_cu, (const void*)hybrid_fwd, NWAVES * 64, LDS_BYTES) != hipSuccess || per_cu < 1)
            fprintf(stderr, "kernel_launch: note: occupancy query reports %d workgroups per CU\n", per_cu);
        (void)hipGetLastError();
        grid = cus;
        if (grid != 256) fprintf(stderr, "kernel_launch: %d CUs: the attention phase is dealt for 256 workgroups\n", grid);
    }
    if (grid < 0) return;
    if (hipMemsetAsync((char*)d_ws + WS_CTL, 0, CTL_ZERO_BYTES, stream) != hipSuccess) { fprintf(stderr, "kernel_launch: memset failed\n"); return; }
    Args a{};
    a.x = (const float*)d_in[0]; a.w_in = (const float*)d_in[1]; a.w_pool = (const float*)d_in[2]; a.pool_scale = (const float*)d_in[3];
    a.w_out = (const float*)d_in[4]; a.ln_gain = (const float*)d_in[5]; a.ln_bias = (const float*)d_in[6]; a.out = (float*)d_out; a.ws = (unsigned char*)d_ws;
    for (int li = 0; li < N_LAUNCHES; ++li) {
        a.ph_lo = (N_LAUNCHES == PER_PHASE) ? li : 0; a.ph_hi = (N_LAUNCHES == PER_PHASE) ? li + 1 : PER_PHASE;
        hipLaunchKernelGGL(hybrid_fwd, dim3(grid), dim3(NWAVES * 64), LDS_BYTES, stream, a);
        const hipError_t le = hipPeekAtLastError();
        if (le != hipSuccess) { fprintf(stderr, "kernel_launch: launch %d failed: %s\n", li, hipGetErrorName(le)); break; }
    }
}
```

```cpp
#define MK_XU 4
#define MK_FULLLINE 1
#define MK_BREMAP 1
#define MK_AHEAD 2
#include <hip/hip_runtime.h>
#include <cstdio>
#include <cstdint>

#ifndef MK_N_LAUNCHES
#define MK_N_LAUNCHES 1
#endif

namespace pg8 {
#define PG8_LAS __attribute__((address_space(3)))
typedef unsigned short bf16_t;
typedef short bf16x8 __attribute__((ext_vector_type(8)));
typedef float f32x4 __attribute__((ext_vector_type(4)));
typedef unsigned u32x4 __attribute__((ext_vector_type(4)));
constexpr int BM = 256, BK = 64, HALF = 128, HTB = HALF * BK * 2  , STAGE_BYTES = 8 * HTB, NXCD = 8, WGM = 8;

__host__ __device__ __forceinline__ int lds_byte(int r, int c) { const int st = (r >> 4) * 2 + (c >> 5), rr = r & 15, cc = c & 31, ob = rr * 64 + cc * 2; return st * 1024 + (ob ^ (((ob >> 9) & 1) << 5)); }
__host__ __device__ __forceinline__ void stage_rc(int b, int& R, int& C) { const int st = b / 1024, sb = b % 1024, swz = sb ^ (((sb >> 9) & 1) << 5); R = (st >> 1) * 16 + swz / 64; C = (st & 1) * 32 + (swz % 64) / 2; }
__host__ __device__ __forceinline__ int perm32(int rho) { const int n = rho >> 4, i = rho & 15; return 8 * (i >> 2) + 4 * n + (i & 3); }

#ifndef MK_BREMAP
#define MK_BREMAP 1
#endif
constexpr int BJC = MK_BREMAP ? 32 : 128, WCW = MK_BREMAP ? 64 : 32;
struct Unit { int pm, pn; };
struct Gemm { const bf16_t* A; const bf16_t* Bt; int M, N, K; };

struct StaticOrder {
    int nM, nN, nwg, G, c; bool rev = false;
    __host__ __device__ void init(int M, int N, int G_, int c_) { nM = M / BM; nN = N / BM; nwg = nM * nN; G = G_; c = c_; }
    __host__ __device__ bool next(int i, Unit& u) const {
        const long L = (long)i * G + c; if (L >= nwg) return false;
        int wgid = (int)L; { const int q = nwg / NXCD, r = nwg % NXCD, xcd = wgid % NXCD, off = wgid / NXCD; wgid = (xcd < r ? xcd * (q + 1) : r * (q + 1) + (xcd - r) * q) + off; }
        const int nig = WGM * nN, gid = wgid / nig, fm = gid * WGM, gsz = (nM - fm) < WGM ? (nM - fm) : WGM;
        u.pm = fm + ((wgid % nig) % gsz); u.pn = (wgid % nig) / gsz; if (rev) u.pn = nN - 1 - u.pn; return true;
    }
    __device__ __forceinline__ void a_ready(const Unit&) const {}
    __device__ __forceinline__ void done(const Unit&) const {}
};

#ifndef MK_FULLLINE
#define MK_FULLLINE 1
#endif

__device__ __forceinline__ unsigned cvt_pk_bf16(float lo, float hi) { unsigned r; asm volatile("v_cvt_pk_bf16_f32 %0, %1, %2" : "=v"(r) : "v"(lo), "v"(hi)); return r; }

struct EpiH {
    static constexpr bool PERM = true, AFTER_DRAIN = false, LNX = false;
    bf16_t* QKV;
    bf16_t* U;
    bf16_t* G;
    const float* rope;
    float qscale;
    __device__ __forceinline__ void operator()(const f32x4 (&acc)[2][2][4][2], const Unit& u, int wr, int wc, int fr, int fq) const {
        const int pn = u.pn, row0 = u.pm * BM + wr * 64 + fr;
        if (pn < 12) {
            const int which = pn >> 2;
            const bool rot = (which < 2) && (MK_BREMAP ? ((wc & 1) == 0) : (wc == 0));
            const float sc = (which == 0) ? qscale : 1.f;
            const float sgn = (fq < 2) ? -1.f : 1.f;
#pragma unroll
            for (int ai = 0; ai < 2; ++ai)
#pragma unroll
                for (int m = 0; m < 4; ++m) {
                    const int row = row0 + ai * HALF + m * 16, b = row >> 12, t = row & 4095;
                    f32x4 cs[2], sn[2]; u32x4 wq[2]; bf16_t* qdst = QKV;
                    if (rot) {
#pragma unroll
                        for (int n = 0; n < 2; ++n) { cs[n] = *(const f32x4*)(rope + t * 16 + 8 * (fq & 1) + 4 * n); sn[n] = *(const f32x4*)(rope + 65536 + t * 16 + 8 * (fq & 1) + 4 * n); }
                    }
#pragma unroll
                    for (int bj = 0; bj < 2; ++bj) {
                        const int head = 2 * (pn & 3) + (MK_BREMAP ? (wc >> 1) : bj), hcol = MK_BREMAP ? (wc & 1) * 64 + bj * 32 + 8 * fq : wc * 32 + 8 * fq;
                        f32x4 v[2] = {acc[ai][bj][m][0], acc[ai][bj][m][1]};
                        if (rot && (!MK_BREMAP || bj == 0)) {
#pragma unroll
                            for (int n = 0; n < 2; ++n)
#pragma unroll
                                for (int j = 0; j < 4; ++j) { const float own = v[n][j], oth = __shfl_xor(own, 32); v[n][j] = own * cs[n][j] + sgn * oth * sn[n][j]; }
                        }
                        u32x4 w; w.x = cvt_pk_bf16(v[0][0] * sc, v[0][1] * sc); w.y = cvt_pk_bf16(v[0][2] * sc, v[0][3] * sc); w.z = cvt_pk_bf16(v[1][0] * sc, v[1][1] * sc); w.w = cvt_pk_bf16(v[1][2] * sc, v[1][3] * sc);
#if MK_BREMAP && MK_FULLLINE
                        wq[bj] = w; if (bj == 0) qdst = QKV + ((size_t)((which * 32 + b * 8 + head) * 4096 + t)) * 128 + hcol;
#else
                        *(u32x4*)(QKV + ((size_t)((which * 32 + b * 8 + head) * 4096 + t)) * 128 + hcol) = w;
#endif
                    }
#if MK_BREMAP && MK_FULLLINE
                    {
                        const bool lo_ = (fr & 8) == 0;
                        u32x4 R, A_, B_;
#pragma unroll
                        for (int c = 0; c < 4; ++c) { const unsigned xs = lo_ ? wq[1][c] : wq[0][c];
                            R[c] = (unsigned)__builtin_amdgcn_update_dpp(0, (int)xs, 0x128  , 0xf, 0xf, false);
                            A_[c] = lo_ ? wq[0][c] : R[c]; B_[c] = lo_ ? R[c] : wq[1][c]; }
                        *(u32x4*)(qdst + (lo_ ? 0 : 32 - 8 * 128)) = A_;
                        *(u32x4*)(qdst + (lo_ ? 8 * 128 : 32)) = B_;
                    }
#endif
                }
        } else {
            bf16_t* base; int ldc, colt;
            if (pn < 16) { base = U; ldc = 1024; colt = (pn - 12) * BM; } else { base = G; ldc = 2048; colt = (pn - 16) * BM; }
            const int col0 = colt + wc * WCW + 8 * fq;
#pragma unroll
            for (int ai = 0; ai < 2; ++ai)
#pragma unroll
                for (int m = 0; m < 4; ++m) { bf16_t* rowp = base + (size_t)(row0 + ai * HALF + m * 16) * ldc + col0;
#if MK_BREMAP && MK_FULLLINE
                    u32x4 wq[2];
#pragma unroll
                    for (int bj = 0; bj < 2; ++bj) { const f32x4 v0 = acc[ai][bj][m][0], v1 = acc[ai][bj][m][1];
                        wq[bj].x = cvt_pk_bf16(v0[0], v0[1]); wq[bj].y = cvt_pk_bf16(v0[2], v0[3]); wq[bj].z = cvt_pk_bf16(v1[0], v1[1]); wq[bj].w = cvt_pk_bf16(v1[2], v1[3]); }
                    {   const bool lo_ = (fr & 8) == 0;
                        u32x4 R, A_, B_;
#pragma unroll
                        for (int c = 0; c < 4; ++c) { const unsigned xs = lo_ ? wq[1][c] : wq[0][c];
                            R[c] = (unsigned)__builtin_amdgcn_update_dpp(0, (int)xs, 0x128  , 0xf, 0xf, false);
                            A_[c] = lo_ ? wq[0][c] : R[c]; B_[c] = lo_ ? R[c] : wq[1][c]; }
                        *(u32x4*)(rowp + (lo_ ? 0l : 32l - 8l * ldc)) = A_;
                        *(u32x4*)(rowp + (lo_ ? 8l * ldc : 32l)) = B_; } }
#else
#pragma unroll
                    for (int bj = 0; bj < 2; ++bj) { const f32x4 v0 = acc[ai][bj][m][0], v1 = acc[ai][bj][m][1];
                        u32x4 w; w.x = cvt_pk_bf16(v0[0], v0[1]); w.y = cvt_pk_bf16(v0[2], v0[3]); w.z = cvt_pk_bf16(v1[0], v1[1]); w.w = cvt_pk_bf16(v1[2], v1[3]);
                        *(u32x4*)(rowp + bj * BJC) = w; } }
#endif
        }
    }
};
struct SchedLN {
    int c;
    __device__ __forceinline__ bool next(int i, Unit& u) const { if (i >= 2) return false; const int k = c >> 3; u.pn = k & 7; u.pm = i * 32 + (c & 7) * 4 + (k >> 3); return true; }
    __device__ __forceinline__ void a_ready(const Unit&) const {}
    __device__ __forceinline__ void done(const Unit&) const {}
};
struct EpiLN {
    static constexpr bool PERM = false, AFTER_DRAIN = false, LNX = true;
    const float* x; float* out; const float* gain; const float* bias; float alpha, eps;
    unsigned long long* xbuf;
    unsigned* cnt;
    typedef float f32x2v __attribute__((ext_vector_type(2)));
    __device__ __forceinline__ void lnx(f32x4 (&acc)[2][2][4][2], const Unit& u, bool, int wr, int wc, int fr, int fq, PG8_LAS unsigned char* lx, int wid, int lane) const {
        PG8_LAS f32x2v* P = (PG8_LAS f32x2v*)lx;
        PG8_LAS f32x2v* S = (PG8_LAS f32x2v*)(lx + 8192);
        const int row0 = u.pm * BM + wr * 64 + fr, col0 = u.pn * BM + wc * WCW + 4 * fq;
        {
            const bool lo_ = (fr & 8) == 0;
            const long dA_ = lo_ ? 0l : (16l - 8l * 2048l), dB_ = lo_ ? 8l * 2048l : 16l;
#pragma unroll
            for (int ai = 0; ai < 2; ++ai)
#pragma unroll
                for (int mp = 0; mp < 4; mp += 2) {
                    f32x4 A_[2][2], B_[2][2];
#pragma unroll
                    for (int m = 0; m < 2; ++m) { const long off = (long)((size_t)(row0 + ai * HALF + (mp + m) * 16) * 2048 + col0);
#pragma unroll
                        for (int bj = 0; bj < 2; ++bj) { A_[m][bj] = __builtin_nontemporal_load((const f32x4*)(x + off + bj * BJC + dA_)); B_[m][bj] = __builtin_nontemporal_load((const f32x4*)(x + off + bj * BJC + dB_)); } }
#pragma unroll
                    for (int m = 0; m < 2; ++m) asm volatile("" : "+v"(A_[m][0]), "+v"(A_[m][1]), "+v"(B_[m][0]), "+v"(B_[m][1]));
#pragma unroll
                    for (int m = 0; m < 2; ++m) {
#pragma unroll
                        for (int bj = 0; bj < 2; ++bj) {
                            f32x4 n0, n1;
#pragma unroll
                            for (int c = 0; c < 4; ++c) { const float xs = lo_ ? B_[m][bj][c] : A_[m][bj][c];
                                const float r_ = __int_as_float(__builtin_amdgcn_update_dpp(0, __float_as_int(xs), 0x128  , 0xf, 0xf, false));
                                n0[c] = lo_ ? A_[m][bj][c] : r_; n1[c] = lo_ ? r_ : B_[m][bj][c]; }
                            acc[ai][bj][mp + m][0] = n0 * alpha + acc[ai][bj][mp + m][0]; acc[ai][bj][mp + m][1] = n1 * alpha + acc[ai][bj][mp + m][1]; }
                        asm volatile("" : "+v"(acc[ai][0][mp + m][0]), "+v"(acc[ai][0][mp + m][1]), "+v"(acc[ai][1][mp + m][0]), "+v"(acc[ai][1][mp + m][1])); }
                    asm volatile("" ::: "memory"); }
        }
#pragma unroll
        for (int ai = 0; ai < 2; ++ai)
#pragma unroll
            for (int m = 0; m < 4; ++m) {
                float s = 0.f;
#pragma unroll
                for (int bj = 0; bj < 2; ++bj)
#pragma unroll
                    for (int n = 0; n < 2; ++n) { const f32x4 v = acc[ai][bj][m][n]; s += (v[0] + v[1]) + (v[2] + v[3]); }
                s += __shfl_xor(s, 16); s += __shfl_xor(s, 32);
                const float mw = s * (1.0f / 64.0f); float q = 0.f;
#pragma unroll
                for (int bj = 0; bj < 2; ++bj)
#pragma unroll
                    for (int n = 0; n < 2; ++n) { const f32x4 d = acc[ai][bj][m][n] - mw; q += (d[0] * d[0] + d[1] * d[1]) + (d[2] * d[2] + d[3] * d[3]); }
                q += __shfl_xor(q, 16); q += __shfl_xor(q, 32);
                if (fq == 0) P[(ai * HALF + wr * 64 + m * 16 + fr) * 4 + wc] = (f32x2v){mw, q};
            }
        asm volatile("s_waitcnt lgkmcnt(0)" ::: "memory"); __builtin_amdgcn_s_barrier(); asm volatile("" ::: "memory");
        const int row = wid * 32 + (lane & 31);
        if (lane < 32) {
            const f32x2v a = P[row * 4 + 0], b = P[row * 4 + 1], c = P[row * 4 + 2], d = P[row * 4 + 3];
            const float mt = (a.x + b.x + c.x + d.x) * 0.25f;
            const float da = a.x - mt, db = b.x - mt, dc = c.x - mt, dd = d.x - mt;
            const float m2 = (a.y + b.y) + (c.y + d.y) + 64.0f * ((da * da + db * db) + (dc * dc + dd * dd));
            unsigned long long* slot = xbuf + ((size_t)(u.pm * BM + row) * 8 + u.pn);
            __hip_atomic_store(slot, ((unsigned long long)__float_as_uint(m2) << 32) | __float_as_uint(mt), __ATOMIC_RELAXED, __HIP_MEMORY_SCOPE_AGENT);
        }
        asm volatile("s_waitcnt vmcnt(0)" ::: "memory");
        if (lane == 0) __hip_atomic_fetch_add(cnt + 64 * u.pm, 1u, __ATOMIC_RELAXED, __HIP_MEMORY_SCOPE_AGENT);
        if (wid == 0) {
            unsigned polls = 0;
            while ((unsigned)__builtin_amdgcn_readfirstlane(__hip_atomic_load(cnt + 64 * u.pm, __ATOMIC_RELAXED, __HIP_MEMORY_SCOPE_AGENT)) < 64u) {
                if (++polls > (1u << 22)) break;
                __builtin_amdgcn_s_sleep(2); }
            __builtin_amdgcn_fence(__ATOMIC_ACQUIRE, "agent");
        }
        asm volatile("s_waitcnt vmcnt(0) lgkmcnt(0)" ::: "memory"); __builtin_amdgcn_s_barrier(); asm volatile("" ::: "memory");
        if (lane < 32) {
            const unsigned long long* slot = xbuf + (size_t)(u.pm * BM + row) * 8; float mm[8], qq[8]; float ms = 0.f;
#pragma unroll
            for (int t = 0; t < 8; ++t) { const unsigned long long w = __hip_atomic_load(slot + t, __ATOMIC_RELAXED, __HIP_MEMORY_SCOPE_AGENT); mm[t] = __uint_as_float((unsigned)w); qq[t] = __uint_as_float((unsigned)(w >> 32)); ms += mm[t]; }
            const float mean = ms * 0.125f; float q = 0.f;
#pragma unroll
            for (int t = 0; t < 8; ++t) { const float dm = mm[t] - mean; q += qq[t] + 256.0f * dm * dm; }
            S[row] = (f32x2v){mean, 1.0f / sqrtf(q * (1.0f / 2048.0f) + eps)};
        }
        asm volatile("s_waitcnt lgkmcnt(0)" ::: "memory"); __builtin_amdgcn_s_barrier(); asm volatile("" ::: "memory");
        f32x4 gn[2][2], bs[2][2];
#pragma unroll
        for (int bj = 0; bj < 2; ++bj)
#pragma unroll
            for (int n = 0; n < 2; ++n) { gn[bj][n] = *(const f32x4*)(gain + col0 + bj * BJC + n * 16); bs[bj][n] = *(const f32x4*)(bias + col0 + bj * BJC + n * 16); }
#pragma unroll
        for (int ai = 0; ai < 2; ++ai)
#pragma unroll
            for (int m = 0; m < 4; ++m) { const int r = ai * HALF + wr * 64 + m * 16 + fr; const f32x2v sr = S[r]; const size_t off = (size_t)(u.pm * BM + r) * 2048 + col0;
#if MK_FULLLINE
                const bool lo_ = (fr & 8) == 0;
                const long dA_ = lo_ ? 0l : (16l - 8l * 2048l), dB_ = lo_ ? 8l * 2048l : 16l;
#pragma unroll
                for (int bj = 0; bj < 2; ++bj) {
                    const f32x4 P0 = (acc[ai][bj][m][0] - sr.x) * sr.y * gn[bj][0] + bs[bj][0], P1 = (acc[ai][bj][m][1] - sr.x) * sr.y * gn[bj][1] + bs[bj][1];
                    f32x4 R, A_, B_;
#pragma unroll
                    for (int c = 0; c < 4; ++c) { const float xs = lo_ ? P1[c] : P0[c];
                        R[c] = __int_as_float(__builtin_amdgcn_update_dpp(0, __float_as_int(xs), 0x128  , 0xf, 0xf, false));
                        A_[c] = lo_ ? P0[c] : R[c]; B_[c] = lo_ ? R[c] : P1[c]; }
                    __builtin_nontemporal_store(A_, (f32x4*)(out + (long)off + bj * BJC + dA_));
                    __builtin_nontemporal_store(B_, (f32x4*)(out + (long)off + bj * BJC + dB_));
                } }
#else
#pragma unroll
                for (int bj = 0; bj < 2; ++bj)
#pragma unroll
                    for (int n = 0; n < 2; ++n) __builtin_nontemporal_store((acc[ai][bj][m][n] - sr.x) * sr.y * gn[bj][n] + bs[bj][n], (f32x4*)(out + off + bj * BJC + n * 16)); }
#endif
    }
};

struct SchedOne {
    __device__ __forceinline__ bool next(int i, Unit& u) const { if (i != 0) return false; u.pm = 0; u.pn = 0; return true; }
    __device__ __forceinline__ void a_ready(const Unit&) const {}
    __device__ __forceinline__ void done(const Unit&) const {}
};
struct EpiW {
    static constexpr bool PERM = true, AFTER_DRAIN = false, LNX = false;
    bf16_t* O;
    __device__ __forceinline__ void operator()(const f32x4 (&acc)[2][2][4][2], const Unit&, int wr, int wc, int fr, int fq) const {
        const int row0 = wr * 64 + fr, col0 = wc * WCW + 8 * fq;
#pragma unroll
        for (int ai = 0; ai < 2; ++ai)
#pragma unroll
            for (int m = 0; m < 4; ++m) { bf16_t* rowp = O + (size_t)(row0 + ai * HALF + m * 16) * 2048 + col0;
#pragma unroll
                for (int bj = 0; bj < 2; ++bj) { const f32x4 v0 = acc[ai][bj][m][0], v1 = acc[ai][bj][m][1];
                    u32x4 w; w.x = cvt_pk_bf16(v0[0], v0[1]); w.y = cvt_pk_bf16(v0[2], v0[3]); w.z = cvt_pk_bf16(v1[0], v1[1]); w.w = cvt_pk_bf16(v1[2], v1[3]);
                    *(u32x4*)(rowp + bj * BJC) = w; } }
    }
};

template <class Epi, class Sched, bool ALIGN_EPI = false, bool SP2 = false>
__device__ __forceinline__ void gemm_phase(PG8_LAS unsigned char* lds, const Gemm g, const Sched& S, const Epi& E) {
    int tid_ = threadIdx.x; asm volatile("" : "+v"(tid_));
    const int tid = tid_, wid = __builtin_amdgcn_readfirstlane(tid >> 6), lane = tid & 63, wr = wid >> 2, wc = wid & 3, fr = lane & 15, fq = lane >> 4;
    const int K = g.K, nt = K / BK;
    unsigned voffA[2], voffB[2];
#pragma unroll
    for (int i = 0; i < 2; ++i) { int R, C; stage_rc(tid * 16 + i * 8192, R, C); const int Rb = Epi::PERM ? ((R & ~31) + perm32(R & 31)) : R;
        const int Rb2 = MK_BREMAP ? ((Rb >> 5) * 64 + (Rb & 31)) : Rb;
        voffA[i] = (unsigned)(R * K + C) * 2u; voffB[i] = (unsigned)(Rb2 * K + C) * 2u; }
    const size_t kstep = (size_t)(BK * 2);
    const size_t hstep = (size_t)HALF * K * 2;
    const size_t bhstep = MK_BREMAP ? (size_t)32 * K * 2 : hstep;
    const size_t tstep = 2 * hstep;
    const unsigned ldsw = (unsigned)wid * 1024u;
    const int aoff = lds_byte(wr * 64 + fr, fq * 8), boff = lds_byte(wc * 32 + fr, fq * 8);
#define PG8_SA(b, h) (((b) * 2 + (h)) * HTB)
#define PG8_SB(b, h) ((4 + (b) * 2 + (h)) * HTB)
#define PG8_STAGE(bufoff, gbase, voff) do { _Pragma("unroll") for (int _i = 0; _i < 2; ++_i) \
        __builtin_amdgcn_global_load_lds((const unsigned*)((const char*)(gbase) + (voff)[_i]), (PG8_LAS unsigned*)(lds + (bufoff) + ldsw + _i * 8192), 16, 0, 0); } while (0)
#define PG8_LDA(dst, b, h) do { _Pragma("unroll") for (int m = 0; m < 4; ++m) _Pragma("unroll") for (int k = 0; k < 2; ++k) dst[m][k] = *(const PG8_LAS bf16x8*)(lds + PG8_SA(b, h) + aoff + m * 2048 + k * 1024); } while (0)
#define PG8_LDB(dst, b, h) do { _Pragma("unroll") for (int n = 0; n < 2; ++n) _Pragma("unroll") for (int k = 0; k < 2; ++k) dst[n][k] = *(const PG8_LAS bf16x8*)(lds + PG8_SB(b, h) + boff + n * 2048 + k * 1024); } while (0)
#define PG8_MMA(ai, bj, At, Bt) do { __builtin_amdgcn_s_setprio(1); _Pragma("unroll") for (int m = 0; m < 4; ++m) _Pragma("unroll") for (int n = 0; n < 2; ++n) _Pragma("unroll") for (int k = 0; k < 2; ++k) \
        acc[ai][bj][m][n] = __builtin_amdgcn_mfma_f32_16x16x32_bf16(Bt[n][k], At[m][k], acc[ai][bj][m][n], 0, 0, 0); __builtin_amdgcn_s_setprio(0); } while (0)
#define PG8_WAIT_V(n) asm volatile("s_waitcnt vmcnt(" #n ")" ::: "memory")
#define PG8_WAIT_L(n) asm volatile("s_waitcnt lgkmcnt(" #n ")" ::: "memory")
#define PG8_BAR __builtin_amdgcn_s_barrier()
#define PG8_SCHED __builtin_amdgcn_sched_barrier(0)
    Unit cur, nxt; int ui = 0;
    if (!S.next(0, cur)) return;
    f32x4 acc[2][2][4][2];
#pragma unroll
    for (int a = 0; a < 2; ++a)
#pragma unroll
        for (int b = 0; b < 2; ++b)
#pragma unroll
            for (int m = 0; m < 4; ++m)
#pragma unroll
                for (int n = 0; n < 2; ++n) acc[a][b][m][n] = (f32x4){0.f, 0.f, 0.f, 0.f};
    bf16x8 At[4][2], B0[2][2], B1[2][2];
    const char* cA = (const char*)g.A + (size_t)cur.pm * tstep; const char* cB = (const char*)g.Bt + (size_t)cur.pn * tstep;
    S.a_ready(cur);
    if constexpr (SP2) {
        PG8_STAGE(PG8_SB(0, 0), cB, voffB); PG8_STAGE(PG8_SB(0, 1), cB + bhstep, voffB); PG8_STAGE(PG8_SA(0, 0), cA, voffA); PG8_STAGE(PG8_SA(0, 1), cA + hstep, voffA);
        if (wr == 1) PG8_BAR;
        PG8_WAIT_V(2); PG8_BAR;
        PG8_STAGE(PG8_SB(1, 0), cB + kstep, voffB); PG8_STAGE(PG8_SA(1, 0), cA + kstep, voffA); PG8_STAGE(PG8_SB(1, 1), cB + bhstep + kstep, voffB);
        PG8_WAIT_V(6); PG8_BAR;
    } else {
        PG8_STAGE(PG8_SB(0, 0), cB, voffB); PG8_STAGE(PG8_SA(0, 0), cA, voffA); PG8_STAGE(PG8_SB(0, 1), cB + bhstep, voffB); PG8_STAGE(PG8_SA(0, 1), cA + hstep, voffA);
        if (wr == 1) PG8_BAR;
        PG8_WAIT_V(4); PG8_BAR;
        PG8_STAGE(PG8_SB(1, 0), cB + kstep, voffB); PG8_STAGE(PG8_SA(1, 0), cA + kstep, voffA); PG8_STAGE(PG8_SB(1, 1), cB + bhstep + kstep, voffB);
        PG8_WAIT_V(6); PG8_BAR;
    }
    for (;;) {
        const bool has_next = S.next(ui + 1, nxt);
        const char* nA = has_next ? (const char*)g.A + (size_t)nxt.pm * tstep : cA; const char* nB = has_next ? (const char*)g.Bt + (size_t)nxt.pn * tstep : cB;
        for (int t = 0; t < nt; t += 2) {
            const bool last = (t == nt - 2);
            const char* a1 = cA + (size_t)(t + 1) * kstep;
            const char* a2 = last ? nA : cA + (size_t)(t + 2) * kstep; const char* b2 = last ? nB : cB + (size_t)(t + 2) * kstep;
            const char* a3 = a2 + kstep; const char* b3 = b2 + kstep;
            if (last && has_next) S.a_ready(nxt);
            if constexpr (SP2) {
            PG8_LDB(B0, 0, 0); PG8_LDB(B1, 0, 1); PG8_SCHED; PG8_LDA(At, 0, 0); PG8_STAGE(PG8_SA(1, 1), a1 + hstep, voffA);
            PG8_WAIT_V(8); PG8_WAIT_L(0); PG8_BAR; PG8_MMA(0, 0, At, B0); PG8_MMA(0, 1, At, B1); PG8_BAR; PG8_SCHED;
            PG8_LDA(At, 0, 1); PG8_STAGE(PG8_SB(0, 0), b2, voffB); PG8_STAGE(PG8_SB(0, 1), b2 + bhstep, voffB); PG8_STAGE(PG8_SA(0, 0), a2, voffA);
            PG8_WAIT_V(8); PG8_WAIT_L(0); PG8_BAR; PG8_MMA(1, 0, At, B0); PG8_MMA(1, 1, At, B1); PG8_BAR; PG8_SCHED;
            PG8_LDB(B0, 1, 0); PG8_LDB(B1, 1, 1); PG8_SCHED; PG8_LDA(At, 1, 0); PG8_STAGE(PG8_SA(0, 1), a2 + hstep, voffA);
            PG8_WAIT_V(8); PG8_WAIT_L(0); PG8_BAR; PG8_MMA(0, 0, At, B0); PG8_MMA(0, 1, At, B1); PG8_BAR; PG8_SCHED;
            PG8_LDA(At, 1, 1); PG8_STAGE(PG8_SB(1, 0), b3, voffB); PG8_STAGE(PG8_SB(1, 1), b3 + bhstep, voffB); PG8_STAGE(PG8_SA(1, 0), a3, voffA);
            PG8_WAIT_V(8); PG8_WAIT_L(0); PG8_BAR; PG8_MMA(1, 0, At, B0); PG8_MMA(1, 1, At, B1); PG8_BAR; PG8_SCHED;
            } else {
            PG8_LDB(B0, 0, 0); PG8_SCHED; PG8_LDA(At, 0, 0); PG8_STAGE(PG8_SA(1, 1), a1 + hstep, voffA);
            PG8_WAIT_L(8); PG8_BAR; PG8_WAIT_L(0); PG8_MMA(0, 0, At, B0); PG8_BAR; PG8_SCHED;
            PG8_LDB(B1, 0, 1); PG8_STAGE(PG8_SB(0, 0), b2, voffB);
            PG8_BAR; PG8_WAIT_L(0); PG8_MMA(0, 1, At, B1); PG8_BAR;
            PG8_LDA(At, 0, 1); PG8_STAGE(PG8_SA(0, 0), a2, voffA);
            PG8_BAR; PG8_WAIT_L(0); PG8_MMA(1, 0, At, B0); PG8_BAR; PG8_SCHED;
            PG8_STAGE(PG8_SB(0, 1), b2 + bhstep, voffB);
            PG8_WAIT_V(6); PG8_BAR; PG8_MMA(1, 1, At, B1); PG8_BAR;
            PG8_LDB(B0, 1, 0); PG8_SCHED; PG8_LDA(At, 1, 0); PG8_STAGE(PG8_SA(0, 1), a2 + hstep, voffA);
            PG8_WAIT_L(8); PG8_BAR; PG8_WAIT_L(0); PG8_MMA(0, 0, At, B0); PG8_BAR; PG8_SCHED;
            PG8_LDB(B1, 1, 1); PG8_STAGE(PG8_SB(1, 0), b3, voffB);
            PG8_BAR; PG8_WAIT_L(0); PG8_MMA(0, 1, At, B1); PG8_BAR;
            PG8_LDA(At, 1, 1); PG8_STAGE(PG8_SA(1, 0), a3, voffA);
            PG8_BAR; PG8_WAIT_L(0); PG8_MMA(1, 0, At, B0); PG8_BAR; PG8_SCHED;
            PG8_STAGE(PG8_SB(1, 1), b3 + bhstep, voffB);
            PG8_WAIT_V(6); PG8_BAR; PG8_MMA(1, 1, At, B1); PG8_BAR;
            }
        }
        if constexpr (ALIGN_EPI) { if (wr == 0) PG8_BAR; }
        if constexpr (Epi::LNX) { E.lnx(acc, cur, !has_next, wr, wc, fr, fq, lds + STAGE_BYTES, wid, lane); } else if constexpr (!Epi::AFTER_DRAIN) { E(acc, cur, wr, wc, fr, fq); S.done(cur); }
        if (!has_next) break;
#pragma unroll
        for (int a = 0; a < 2; ++a)
#pragma unroll
            for (int b = 0; b < 2; ++b)
#pragma unroll
                for (int m = 0; m < 4; ++m)
#pragma unroll
                    for (int n = 0; n < 2; ++n) acc[a][b][m][n] = (f32x4){0.f, 0.f, 0.f, 0.f};
        cur = nxt; cA = nA; cB = nB; ++ui;
        if constexpr (ALIGN_EPI) { if (wr == 1) PG8_BAR; }
    }
    PG8_WAIT_V(0);
    if constexpr (!ALIGN_EPI) { if (wr == 0) PG8_BAR; }
    PG8_BAR;
    if constexpr (Epi::AFTER_DRAIN) { E.fused(acc, cur, wr, wc, fr, fq, lds, wid, lane); S.done(cur); }
#undef PG8_SA
#undef PG8_SB
#undef PG8_STAGE
#undef PG8_LDA
#undef PG8_LDB
#undef PG8_MMA
#undef PG8_WAIT_V
#undef PG8_WAIT_L
#undef PG8_BAR
#undef PG8_SCHED
}
}

namespace att {
typedef unsigned short bf16_t;
typedef short bf16x8 __attribute__((ext_vector_type(8)));
typedef short s16x4 __attribute__((ext_vector_type(4)));
typedef float f32x16 __attribute__((ext_vector_type(16)));
typedef float f32x4 __attribute__((ext_vector_type(4)));
typedef unsigned u32x4 __attribute__((ext_vector_type(4)));
constexpr int D = 128, NW = 8, QBLK = 32, KVBLK = 64, QB = NW * QBLK;
constexpr int SHM_V = KVBLK * D * 2, SHM_K = KVBLK * D * 2;
constexpr int BIAS_OFF = 4 * SHM_V + 4 * SHM_K;
constexpr int SCR_OFF = 4 * SHM_V + 4 * SHM_K, STG_OFF = SCR_OFF + NW * 64 * 4;
constexpr int LDS_BYTES = STG_OFF + NW * 2048;
constexpr float THR = 8.f;
constexpr int W = 129;

#define KSWZ(row, colB) ((row) * 256 + ((colB) ^ (((row) & 7) << 4)))
#define SBAR() __builtin_amdgcn_sched_barrier(0)
__device__ __forceinline__ int v_st(int k, int c) { const int kk = (k & ~0xC) | ((k & 4) << 1) | ((k & 8) >> 1); return ((kk >> 3) * 4 + (c >> 5)) * 512 + ((kk & 7) * 32 + (c & 31)) * 2; }
__device__ __forceinline__ int v_rd_base(int lane) { return ((lane & 3) << 3) | (((lane >> 2) & 3) << 6) | (((lane >> 4) & 1) << 5) | (((lane >> 5) & 1) << 8); }
constexpr int v_rd_off(int d0, int ks, int half) { return d0 * 512 + ks * 4096 + half * 2048; }
__device__ __forceinline__ int crow(int r, int hi) { return (r & 3) + 8 * (r >> 2) + 4 * hi; }
__device__ __forceinline__ unsigned cvtpk(float lo, float hi) { unsigned r; asm volatile("v_cvt_pk_bf16_f32 %0, %1, %2" : "=v"(r) : "v"(lo), "v"(hi)); return r; }
__device__ __forceinline__ bf16x8 load8(const bf16_t* p) { return *reinterpret_cast<const bf16x8*>(p); }
__device__ __forceinline__ void mask_tile(f32x16& p0, f32x16& p1, int dq, unsigned Wm) {
    const float NEG = -__builtin_inff();
#pragma unroll
    for (int r = 0; r < 16; ++r) {
        const int c = (r & 3) + 8 * (r >> 2);
        if ((unsigned)(dq - c) >= Wm) p0[r] = NEG;
        if ((unsigned)(dq - c - 32) >= Wm) p1[r] = NEG;
    }
}
constexpr unsigned half_mask_lt(int n) { return n <= 0 ? 0u : (n >= 32 ? 0xffffffffu : ((1u << n) - 1u)); }
constexpr unsigned long long lane_mask(int odd, int ph, int c) {
    const int c0 = c - 32 * odd, c1 = c + 4 - 32 * odd;
    const unsigned lo = ph == 0 ? ~half_mask_lt(c0 + 1) : half_mask_lt(c0);
    const unsigned hi = ph == 0 ? ~half_mask_lt(c1 + 1) : half_mask_lt(c1);
    return ((unsigned long long)hi << 32) | lo;
}
template <int ODD, int PH>
__device__ __forceinline__ void mask_const(f32x16& p0, f32x16& p1) {
    const float NEG = -__builtin_inff();
#define MSK1(P, r, cc) do { constexpr unsigned long long m_ = lane_mask(ODD, PH, cc); constexpr int lo_ = (int)(unsigned)m_, hi_ = (int)(unsigned)(m_ >> 32); \
        if (m_ == ~0ull) P[r] = NEG; \
        else if (m_ != 0ull) { float t_ = P[r]; asm("s_mov_b32 vcc_lo, %2\n\ts_mov_b32 vcc_hi, %3\n\tv_cndmask_b32_e32 %0, %0, %1, vcc" : "+v"(t_) : "v"(NEG), "n"(lo_), "n"(hi_) : "vcc"); P[r] = t_; } } while (0)
#define MSK2(r) MSK1(p0, r, ((r) & 3) + 8 * ((r) >> 2)); MSK1(p1, r, ((r) & 3) + 8 * ((r) >> 2) + 32)
    MSK2(0); MSK2(1); MSK2(2); MSK2(3); MSK2(4); MSK2(5); MSK2(6); MSK2(7); MSK2(8); MSK2(9); MSK2(10); MSK2(11); MSK2(12); MSK2(13); MSK2(14); MSK2(15);
#undef MSK2
#undef MSK1
}
__device__ __forceinline__ void partialSM(f32x16& p0, f32x16& p1, float& m_reg, float& mn, float& alpha) {
    float pmax = p0[0]; for (int r = 1; r < 16; ++r) pmax = fmaxf(pmax, p0[r]); for (int r = 0; r < 16; ++r) pmax = fmaxf(pmax, p1[r]);
    { auto rr = __builtin_amdgcn_permlane32_swap(__float_as_uint(pmax), __float_as_uint(pmax), false, false);
      pmax = fmaxf(__uint_as_float(rr[0]), __uint_as_float(rr[1])); }
    if (__builtin_expect(__all((pmax - m_reg) <= THR), 1)) { mn = m_reg; alpha = 1.f; }
    else { mn = fmaxf(m_reg, pmax); alpha = __builtin_amdgcn_exp2f(m_reg - mn); m_reg = mn; }
    { typedef float f32x2 __attribute__((ext_vector_type(2))); const f32x2 mn2 = {mn, mn};
#pragma unroll
      for (int r = 0; r < 16; r += 2) { f32x2 t = {p0[r], p0[r + 1]}; t = t - mn2; p0[r] = t[0]; p0[r + 1] = t[1]; f32x2 u = {p1[r], p1[r + 1]}; u = u - mn2; p1[r] = u[0]; p1[r + 1] = u[1]; } }
    for (int r = 0; r < 16; ++r) p0[r] = __builtin_amdgcn_exp2f(p0[r]);
}
__device__ __forceinline__ void finishSM(f32x16& p0, f32x16& p1, float alpha, float& l_reg, bf16x8& pa0, bf16x8& pa1, bf16x8& pa2, bf16x8& pa3) {
    for (int r = 0; r < 16; ++r) p1[r] = __builtin_amdgcn_exp2f(p1[r]);
    float ps;
    { typedef float f32x2 __attribute__((ext_vector_type(2))); f32x2 s2 = {p0[0], p0[1]};
#pragma unroll
      for (int r = 2; r < 16; r += 2) s2 += (f32x2){p0[r], p0[r + 1]};
#pragma unroll
      for (int r = 0; r < 16; r += 2) s2 += (f32x2){p1[r], p1[r + 1]};
      ps = s2[0] + s2[1]; }
    { auto rr = __builtin_amdgcn_permlane32_swap(__float_as_uint(ps), __float_as_uint(ps), false, false);
      ps = __uint_as_float(rr[0]) + __uint_as_float(rr[1]); }
    l_reg = l_reg * alpha + ps;
#define PK4(P, B_, OUT) do { unsigned a0 = cvtpk(P[B_+0], P[B_+1]), a1 = cvtpk(P[B_+2], P[B_+3]);                          \
        unsigned b0 = cvtpk(P[B_+4], P[B_+5]), b1 = cvtpk(P[B_+6], P[B_+7]);                                             \
        auto r0 = __builtin_amdgcn_permlane32_swap(a0, b0, false, false); auto r1 = __builtin_amdgcn_permlane32_swap(a1, b1, false, false); \
        u32x4 w = {r0[0], r1[0], r0[1], r1[1]}; OUT = *reinterpret_cast<bf16x8*>(&w); } while (0)
    PK4(p0, 0, pa0); PK4(p0, 8, pa1); PK4(p1, 0, pa2); PK4(p1, 8, pa3);
#undef PK4
}
template <int KB>
__device__ __forceinline__ void qkt(f32x16& p0, f32x16& p1, const char* K_lds, int r32, int hi, const bf16x8* qr, bool act) {
    if (!act) { const float NEG = -__builtin_inff();
#pragma unroll
        for (int r = 0; r < 16; ++r) { p0[r] = NEG; p1[r] = NEG; } return; }
    p0 = f32x16{}; p1 = f32x16{};
    const char* kb[4];
#pragma unroll
    for (int dd = 0; dd < 4; ++dd) kb[dd] = K_lds + KB * SHM_K + KSWZ(r32, (dd * 16 + hi * 8) * 2);
#pragma unroll
    for (int d0 = 0; d0 < 8; ++d0) { const char* a = kb[d0 & 3] + (d0 >> 2) * 128;
        bf16x8 b0 = *reinterpret_cast<const bf16x8*>(a);
        bf16x8 b1 = *reinterpret_cast<const bf16x8*>(a + 32 * 256);
        p0 = __builtin_amdgcn_mfma_f32_32x32x16_bf16(b0, qr[d0], p0, 0, 0, 0);
        p1 = __builtin_amdgcn_mfma_f32_32x32x16_bf16(b1, qr[d0], p1, 0, 0, 0); }
}
template <int VB>
__device__ __forceinline__ void pv_tile(f32x16* o, int vb0, bf16x8 pa0, bf16x8 pa1, bf16x8 pa2, bf16x8 pa3, bool act) {
    if (!act) return;
#define TRRD(dst, off) asm volatile("ds_read_b64_tr_b16 %0, %1 offset:%2" : "=&v"(dst) : "v"(vb0), "i"(off) : "memory")
#define PV_D0(d0) do { s16x4 l0, l1, l2, l3, h0, h1, h2, h3; constexpr int b_ = VB * SHM_V + v_rd_off(d0, 0, 0);     \
        TRRD(l0, b_); TRRD(h0, b_ + 2048); TRRD(l1, b_ + 4096); TRRD(h1, b_ + 6144); TRRD(l2, b_ + 8192); TRRD(h2, b_ + 10240); TRRD(l3, b_ + 12288); TRRD(h3, b_ + 14336); \
        asm volatile("s_waitcnt lgkmcnt(0)" ::: "memory"); SBAR();                 \
        o[d0] = __builtin_amdgcn_mfma_f32_32x32x16_bf16(pa0, (bf16x8){l0[0], l0[1], l0[2], l0[3], h0[0], h0[1], h0[2], h0[3]}, o[d0], 0, 0, 0);   \
        o[d0] = __builtin_amdgcn_mfma_f32_32x32x16_bf16(pa1, (bf16x8){l1[0], l1[1], l1[2], l1[3], h1[0], h1[1], h1[2], h1[3]}, o[d0], 0, 0, 0);   \
        o[d0] = __builtin_amdgcn_mfma_f32_32x32x16_bf16(pa2, (bf16x8){l2[0], l2[1], l2[2], l2[3], h2[0], h2[1], h2[2], h2[3]}, o[d0], 0, 0, 0);   \
        o[d0] = __builtin_amdgcn_mfma_f32_32x32x16_bf16(pa3, (bf16x8){l3[0], l3[1], l3[2], l3[3], h3[0], h3[1], h3[2], h3[3]}, o[d0], 0, 0, 0); } while (0)
    PV_D0(0); PV_D0(1); PV_D0(2); PV_D0(3);
#undef PV_D0
#undef TRRD
}

__device__ __forceinline__ void pv_tile_p(f32x16* o, int vb0, bf16x8 pa0, bf16x8 pa1, bf16x8 pa2, bf16x8 pa3) {
#define TRRD(dst, off) asm volatile("ds_read_b64_tr_b16 %0, %1 offset:%2" : "=&v"(dst) : "v"(vb0), "i"(off) : "memory")
#define PVRD(S, ks) do { TRRD(S##l0, (ks) * 4096); TRRD(S##h0, (ks) * 4096 + 2048); TRRD(S##l1, 512 + (ks) * 4096); TRRD(S##h1, 512 + (ks) * 4096 + 2048); \
                         TRRD(S##l2, 1024 + (ks) * 4096); TRRD(S##h2, 1024 + (ks) * 4096 + 2048); TRRD(S##l3, 1536 + (ks) * 4096); TRRD(S##h3, 1536 + (ks) * 4096 + 2048); } while (0)
#define PVMF(S, pa) do { \
        o[0] = __builtin_amdgcn_mfma_f32_32x32x16_bf16((bf16x8){S##l0[0], S##l0[1], S##l0[2], S##l0[3], S##h0[0], S##h0[1], S##h0[2], S##h0[3]}, pa, o[0], 0, 0, 0); \
        o[1] = __builtin_amdgcn_mfma_f32_32x32x16_bf16((bf16x8){S##l1[0], S##l1[1], S##l1[2], S##l1[3], S##h1[0], S##h1[1], S##h1[2], S##h1[3]}, pa, o[1], 0, 0, 0); \
        o[2] = __builtin_amdgcn_mfma_f32_32x32x16_bf16((bf16x8){S##l2[0], S##l2[1], S##l2[2], S##l2[3], S##h2[0], S##h2[1], S##h2[2], S##h2[3]}, pa, o[2], 0, 0, 0); \
        o[3] = __builtin_amdgcn_mfma_f32_32x32x16_bf16((bf16x8){S##l3[0], S##l3[1], S##l3[2], S##l3[3], S##h3[0], S##h3[1], S##h3[2], S##h3[3]}, pa, o[3], 0, 0, 0); } while (0)
    s16x4 Al0, Ah0, Al1, Ah1, Al2, Ah2, Al3, Ah3, Bl0, Bh0, Bl1, Bh1, Bl2, Bh2, Bl3, Bh3;
    PVRD(A, 0); PVRD(B, 1);
    asm volatile("s_waitcnt lgkmcnt(8)" ::: "memory"); SBAR(); PVMF(A, pa0); SBAR();
    PVRD(A, 2);
    asm volatile("s_waitcnt lgkmcnt(8)" ::: "memory"); SBAR(); PVMF(B, pa1); SBAR();
    PVRD(B, 3);
    asm volatile("s_waitcnt lgkmcnt(8)" ::: "memory"); SBAR(); PVMF(A, pa2); SBAR();
    asm volatile("s_waitcnt lgkmcnt(0)" ::: "memory"); SBAR(); PVMF(B, pa3); SBAR();
#undef PVMF
#undef PVRD
#undef TRRD
}

struct Chain { const bf16_t* Q; const bf16_t* K; const bf16_t* V; bf16_t* O; float* L; int P0, M, pitch, lstride; };
struct Carry { bf16x8 qr[8]; int v; unsigned long long tacc; float m, l; f32x16 o[4]; int fresh; bf16_t* eO; float* eL; int eq, epitch, elst; };
typedef __attribute__((address_space(3))) unsigned char lds_u8;
constexpr int AHEAD = MK_AHEAD;
#ifndef MK_LAGSLEEP
#define MK_LAGSLEEP 0
#endif
#ifndef MK_TSEC
#define MK_TSEC 0
#endif
#if MK_TSEC > 0
#define TSTART(s) unsigned long long t0_##s = 0; if (MK_TSEC == (s)) { t0_##s = __builtin_amdgcn_s_memtime(); asm volatile("s_waitcnt lgkmcnt(0)" ::: "memory"); }
#define TSTOP(s) if (MK_TSEC == (s)) { const unsigned long long t1_ = __builtin_amdgcn_s_memtime(); asm volatile("s_waitcnt lgkmcnt(0)" ::: "memory"); S.tacc += t1_ - t0_##s; }
#else
#define TSTART(s)
#define TSTOP(s)
#endif
#ifndef MK_EPI_REP
#define MK_EPI_REP 1
#endif
#ifndef MK_QKT_REP
#define MK_QKT_REP 1
#endif
__device__ __forceinline__ void dma_tile(lds_u8* ldsL, const bf16_t* Kp, const bf16_t* Vp, int pitch, int key0, int slot, int wid, int lane) {
#pragma unroll
    for (int i = 0; i < 2; ++i) {
        const int r = wid * 8 + i * 4 + (lane >> 4), c = (lane & 15) ^ (r & 7);
        __builtin_amdgcn_global_load_lds((const unsigned*)(Kp + (size_t)(key0 + r) * (size_t)pitch + c * 8), (__attribute__((address_space(3))) unsigned*)(ldsL + slot * SHM_K + wid * 2048 + i * 1024), 16, 0, 0);
    }
#pragma unroll
    for (int i = 0; i < 2; ++i) {
        const int ip = 2 * wid + i, sub = 2 * ip + (lane >> 5), kk = (sub >> 2) * 8 + ((lane & 31) >> 2), k = (kk & ~0xC) | ((kk & 4) << 1) | ((kk & 8) >> 1), c = (sub & 3) * 32 + (lane & 3) * 8;
        __builtin_amdgcn_global_load_lds((const unsigned*)(Vp + (size_t)(key0 + k) * (size_t)pitch + c), (__attribute__((address_space(3))) unsigned*)(ldsL + 4 * SHM_K + slot * SHM_V + ip * 1024), 16, 0, 0);
    }
}
__device__ __forceinline__ void dma_offsets(int pitch, int wid, int lane, unsigned (&ko)[2], unsigned (&vo)[2]) {
#pragma unroll
    for (int i = 0; i < 2; ++i) {
        const int r = wid * 8 + i * 4 + (lane >> 4), c = (lane & 15) ^ (r & 7);
        ko[i] = (unsigned)(r * pitch + c * 8) * 2u;
        const int ip = 2 * wid + i, sub = 2 * ip + (lane >> 5), kk = (sub >> 2) * 8 + ((lane & 31) >> 2), k = (kk & ~0xC) | ((kk & 4) << 1) | ((kk & 8) >> 1), cv = (sub & 3) * 32 + (lane & 3) * 8;
        vo[i] = (unsigned)(k * pitch + cv) * 2u;
    }
}
__device__ __forceinline__ void dma_tile_f(lds_u8* ldsL, const char* Kt, const char* Vt, const unsigned (&ko)[2], const unsigned (&vo)[2], int slot, int wid) {
#pragma unroll
    for (int i = 0; i < 2; ++i)
        __builtin_amdgcn_global_load_lds((const unsigned*)(Kt + ko[i]), (__attribute__((address_space(3))) unsigned*)(ldsL + slot * SHM_K + wid * 2048 + i * 1024), 16, 0, 0);
#pragma unroll
    for (int i = 0; i < 2; ++i)
        __builtin_amdgcn_global_load_lds((const unsigned*)(Vt + vo[i]), (__attribute__((address_space(3))) unsigned*)(ldsL + 4 * SHM_K + slot * SHM_V + (2 * wid + i) * 1024), 16, 0, 0);
}
#define VMWN(n) asm volatile("s_waitcnt vmcnt(" #n ")" ::: "memory")
#define LBAR() asm volatile("s_waitcnt lgkmcnt(0)\n\ts_barrier" ::: "memory")
#define LGKM0() asm volatile("s_waitcnt lgkmcnt(0)" ::: "memory")
__device__ __forceinline__ void vm_wait_le(int n) {
    if (n >= 20) VMWN(20); else if (n >= 16) VMWN(16); else if (n >= 12) VMWN(12); else if (n >= 8) VMWN(8); else if (n >= 4) VMWN(4); else VMWN(0);
}
#define QLD(dst, ptr, off) asm volatile("global_load_dwordx4 %0, %1, off offset:%2" : "+v"(dst) : "v"(ptr), "i"(off) : "memory")
#define QLD0(dst, ptr, off) asm volatile("global_load_dwordx4 %0, %1, off offset:%2" : "=v"(dst) : "v"(ptr), "i"(off) : "memory")
#define DSW32(addr, val, off) asm volatile("ds_write_b32 %0, %1 offset:%2" :: "v"(addr), "v"(val), "i"(off) : "memory")
#define DSW16(addr, val, off) asm volatile("ds_write_b16 %0, %1 offset:%2" :: "v"(addr), "v"(val), "i"(off) : "memory")
#define DSR32(dst, addr, off) asm volatile("ds_read_b32 %0, %1 offset:%2" : "=v"(dst) : "v"(addr), "i"(off) : "memory")
#define DSR128(dst, addr, off) asm volatile("ds_read_b128 %0, %1 offset:%2" : "=v"(dst) : "v"(addr), "i"(off) : "memory")
__device__ __forceinline__ void swc_prime(const Chain& c, lds_u8* ldsL, char* ldsL_c, Carry& S) {
    int tid_ = threadIdx.x; asm volatile("" : "+v"(tid_));
    const int tid = tid_, wid = __builtin_amdgcn_readfirstlane(tid >> 6), lane = tid & 63, r32 = lane & 31, hi = lane >> 5;
    const int a0 = c.P0 / KVBLK - 2 + (c.P0 ? 0 : 2);
#pragma unroll
    for (int j = 0; j < AHEAD; ++j) dma_tile(ldsL, c.K, c.V, c.pitch, (a0 + j) * KVBLK, j, wid, lane);
    { const bf16_t* qp = c.Q + (size_t)(c.P0 + wid * QBLK + r32) * (size_t)c.pitch + hi * 8;
      QLD0(S.qr[0], qp, 0); QLD0(S.qr[1], qp, 32); QLD0(S.qr[2], qp, 64); QLD0(S.qr[3], qp, 96); QLD0(S.qr[4], qp, 128); QLD0(S.qr[5], qp, 160); QLD0(S.qr[6], qp, 192); QLD0(S.qr[7], qp, 224); }
    if (wid == 0) {
        const float NEG = -__builtin_inff();
#pragma unroll
        for (int ch = 0; ch < 4; ++ch) {
            f32x4 z = {0.f, 0.f, 0.f, 0.f}, ng = {NEG, NEG, NEG, NEG}, e0, e2;
#pragma unroll
            for (int i = 0; i < 4; ++i) { const int r = ch * 4 + i, cc = (r & 3) + 8 * (r >> 2) + 4 * hi; e0[i] = (r32 > cc) ? NEG : 0.f; e2[i] = (r32 < cc) ? NEG : 0.f; }
            char* bl = (char*)ldsL_c + BIAS_OFF + ch * 1024 + lane * 16;
            *(f32x4*)(bl) = z; *(f32x4*)(bl + 4096) = ng; *(f32x4*)(bl + 8192) = e0; *(f32x4*)(bl + 12288) = e2;
        }
    }
    S.eO = c.O; S.eL = c.L; S.eq = 0; S.epitch = c.pitch; S.elst = c.lstride;
    S.v = 0; S.tacc = 0; S.m = -1e30f; S.l = 0; S.fresh = 1;
#pragma unroll
    for (int d_ = 0; d_ < 4; ++d_) S.o[d_] = f32x16{};
    VMWN(0); LBAR();
}
#define KRD(dst, base, off) asm volatile("ds_read_b128 %0, %1 offset:%2" : "=v"(dst) : "v"(base), "i"(off) : "memory")
__device__ __forceinline__ void qkt_rt(f32x16& p0, f32x16& p1, const char* K_lds, int kso, int r32, int hi, const bf16x8* qr, int ba0, int ba1) {
    { f32x4 c0, c1, c2, c3, e0, e1, e2, e3;
      KRD(c0, ba0, 0); KRD(c1, ba0, 1024); KRD(c2, ba0, 2048); KRD(c3, ba0, 3072); KRD(e0, ba1, 0); KRD(e1, ba1, 1024); KRD(e2, ba1, 2048); KRD(e3, ba1, 3072);
      p0 = (f32x16){c0[0], c0[1], c0[2], c0[3], c1[0], c1[1], c1[2], c1[3], c2[0], c2[1], c2[2], c2[3], c3[0], c3[1], c3[2], c3[3]};
      p1 = (f32x16){e0[0], e0[1], e0[2], e0[3], e1[0], e1[1], e1[2], e1[3], e2[0], e2[1], e2[2], e2[3], e3[0], e3[1], e3[2], e3[3]}; }
    int kb[4];
#pragma unroll
    for (int dd = 0; dd < 4; ++dd) kb[dd] = (int)(uintptr_t)K_lds + kso + KSWZ(r32, (dd * 16 + hi * 8) * 2);
    bf16x8 fa[3], fb[3];
#define KLOAD(d0_, s_) do { if (((d0_) >> 2) == 0) { KRD(fa[s_], kb[(d0_) & 3], 0); KRD(fb[s_], kb[(d0_) & 3], 8192); } else { KRD(fa[s_], kb[(d0_) & 3], 128); KRD(fb[s_], kb[(d0_) & 3], 8320); } } while (0)
    KLOAD(0, 0); KLOAD(1, 1);
#pragma unroll
    for (int d0 = 0; d0 < 8; ++d0) {
        if (d0 + 2 < 8) { KLOAD(d0 + 2, (d0 + 2) % 3); asm volatile("s_waitcnt lgkmcnt(4)" ::: "memory"); }
        else if (d0 + 1 < 8) asm volatile("s_waitcnt lgkmcnt(2)" ::: "memory");
        else asm volatile("s_waitcnt lgkmcnt(0)" ::: "memory");
        SBAR();
        p0 = __builtin_amdgcn_mfma_f32_32x32x16_bf16(fa[d0 % 3], qr[d0], p0, 0, 0, 0);
        p1 = __builtin_amdgcn_mfma_f32_32x32x16_bf16(fb[d0 % 3], qr[d0], p1, 0, 0, 0);
        SBAR();
    }
#undef KLOAD
}
#undef KRD
__device__ __forceinline__ void swc_chain(bool has_prev, const Chain& cur, const Chain& nxt, bool has_next, char* lds, lds_u8* ldsL, Carry& S) {
    int tid_ = threadIdx.x; asm volatile("" : "+v"(tid_));
    const int tid = tid_, wid = __builtin_amdgcn_readfirstlane(tid >> 6), lane = tid & 63, r32 = lane & 31, hi = lane >> 5, wh = wid >> 1;
    const int s0 = cur.P0 ? 0 : 2, T = 4 * cur.M + 2 - s0;
    const int KN = has_next ? T : T + 1;
    const int A0 = cur.P0 / KVBLK - 2;
    const int a0n = nxt.P0 / KVBLK - 2 + (nxt.P0 ? 0 : 2);
    const int v0 = S.v;
    char* K_lds = lds;
    float m_reg = S.m, l_reg = S.l; f32x16 o[4] = {S.o[0], S.o[1], S.o[2], S.o[3]};
    bool fresh = S.fresh != 0, issued = true, pe_due = has_prev && wh == 3;
    bf16_t* const pO = S.eO; float* const pL = S.eL; const int pq = S.eq, ppit = S.epitch, plst = S.elst;
    unsigned ko[2], vo[2]; dma_offsets(cur.pitch, wid, lane, ko, vo);
    const int bias_l = (int)(uintptr_t)lds + BIAS_OFF + lane * 16;
    const int vb0 = (int)(uintptr_t)lds + 4 * SHM_K + v_rd_base(lane);
    const int pit = cur.pitch;
#define CROFF(r) (((r) & 3) + 8 * ((r) >> 2))
#define ISSUE(j_) do { const int j = (j_), slot = (v0 + j) & 3; issued = false; \
        if (j < T) { const size_t to_ = (size_t)((A0 + s0 + j) * KVBLK) * (size_t)pit * 2; dma_tile_f(ldsL, (const char*)cur.K + to_, (const char*)cur.V + to_, ko, vo, slot, wid); issued = true; } \
        else if (has_next) { dma_tile(ldsL, nxt.K, nxt.V, nxt.pitch, (a0n + (j - T)) * KVBLK, slot, wid, lane); issued = true; } } while (0)
    for (int k = 0; k < KN; ++k) {
        const int sg = s0 + k, d = sg - wh, n = d >> 2, ph = d & 3, so = (v0 + k) & 3;
        const bool inu = (unsigned)n < (unsigned)cur.M, comp = inu && ph < 3, pe = pe_due;
        if (!comp && (inu || pe)) VMWN(0);
        TSTART(7) TSTART(6) ISSUE(k + 2); TSTOP(6)
#if MK_LAGSLEEP > 0
        if (wid & 4) __builtin_amdgcn_s_sleep(MK_LAGSLEEP);
#endif
        int newer8 = 0;
        if (comp) {
            const int qlo = cur.P0 + 256 * n + wid * QBLK;
            f32x16 p0, p1; float mn, alpha; bf16x8 pa0, pa1, pa2, pa3;
            const int odd = wid & 1;
            const int bt0 = (ph == 1) ? 0 : (ph == 0 ? (odd ? 1 : 2) : (odd ? 0 : 3)), bt1 = (ph == 1) ? 0 : (ph == 0 ? (odd ? 2 : 0) : (odd ? 3 : 1));
            TSTART(2) for (int rep_ = 0; rep_ < MK_QKT_REP; ++rep_) { SBAR(); qkt_rt(p0, p1, K_lds, so * SHM_K, r32, hi, S.qr, bias_l + bt0 * 4096, bias_l + bt1 * 4096); SBAR(); } TSTOP(2)
            if (ph == 2 && (n + 1 < cur.M || has_next)) {
                vm_wait_le(issued ? 4 : 0);
                const bf16_t* qp = (n + 1 < cur.M) ? cur.Q + (size_t)(qlo + 256 + r32) * (size_t)pit + hi * 8
                                                   : nxt.Q + (size_t)(nxt.P0 + wid * QBLK + r32) * (size_t)nxt.pitch + hi * 8;
                QLD(S.qr[0], qp, 0); QLD(S.qr[1], qp, 32); QLD(S.qr[2], qp, 64); QLD(S.qr[3], qp, 96); QLD(S.qr[4], qp, 128); QLD(S.qr[5], qp, 160); QLD(S.qr[6], qp, 192); QLD(S.qr[7], qp, 224);
                newer8 = 8;
            }
            TSTART(3)
            partialSM(p0, p1, m_reg, mn, alpha);
            finishSM(p0, p1, alpha, l_reg, pa0, pa1, pa2, pa3);
            if (!fresh && __any(alpha < 1.f)) {
#pragma unroll
                for (int d_ = 0; d_ < 4; ++d_)
#pragma unroll
                    for (int r = 0; r < 16; ++r) o[d_][r] *= alpha;
            }
            fresh = false; TSTOP(3)
            TSTART(4) SBAR(); pv_tile_p(o, vb0 + so * SHM_V, pa0, pa1, pa2, pa3); SBAR(); TSTOP(4)
        } else if (inu || pe) {
            TSTART(5)
            const int qlo = (pe ? pq : cur.P0 + 256 * n) + wid * QBLK, epit = pe ? ppit : pit, elst = pe ? plst : cur.lstride;
            float* eL = pe ? pL : cur.L; bf16_t* eO = pe ? pO : cur.O;
            if (hi == 0) eL[(size_t)(qlo + r32) * (size_t)elst] = m_reg + __builtin_amdgcn_logf(l_reg);
            const float inv = __builtin_amdgcn_rcpf(l_reg);
            u32x4 wp[4][2];
#pragma unroll
            for (int d0 = 0; d0 < 4; ++d0)
#pragma unroll
                for (int h = 0; h < 2; ++h) {
                    typedef float f32x2 __attribute__((ext_vector_type(2))); const f32x2 i2 = {inv, inv};
                    const f32x2 x0 = (f32x2){o[d0][8 * h + 0], o[d0][8 * h + 1]} * i2, x1 = (f32x2){o[d0][8 * h + 2], o[d0][8 * h + 3]} * i2, x2 = (f32x2){o[d0][8 * h + 4], o[d0][8 * h + 5]} * i2, x3 = (f32x2){o[d0][8 * h + 6], o[d0][8 * h + 7]} * i2;
                    const unsigned a0 = cvtpk(x0[0], x0[1]), a1 = cvtpk(x1[0], x1[1]), b0 = cvtpk(x2[0], x2[1]), b1 = cvtpk(x3[0], x3[1]);
                    auto r0 = __builtin_amdgcn_permlane32_swap(a0, b0, false, false); auto r1 = __builtin_amdgcn_permlane32_swap(a1, b1, false, false);
                    wp[d0][h] = (u32x4){r0[0], r1[0], r0[1], r1[1]};
                }
            {
                const bool od1 = (lane & 1) != 0, od2 = (lane & 2) != 0;
                bf16_t* Oq = eO + (size_t)(qlo + (r32 & ~3)) * (size_t)epit + 16 * (r32 & 3) + 8 * hi;
#define QSW(A, B, odd, ctrl) do { const unsigned s_ = (odd) ? (A) : (B); const unsigned r_ = (unsigned)__builtin_amdgcn_update_dpp(0, (int)s_, ctrl, 0xf, 0xf, false); \
                                  const unsigned na_ = (odd) ? r_ : (A), nb_ = (odd) ? (B) : r_; (A) = na_; (B) = nb_; } while (0)
#pragma unroll
                for (int grp = 0; grp < 2; ++grp) {
                    u32x4 v0 = wp[2 * grp][0], v1 = wp[2 * grp][1], v2 = wp[2 * grp + 1][0], v3 = wp[2 * grp + 1][1];
#pragma unroll
                    for (int c = 0; c < 4; ++c) {
                        unsigned t0 = v0[c], t1 = v1[c], t2 = v2[c], t3 = v3[c];
                        QSW(t0, t1, od1, 0xB1  ); QSW(t2, t3, od1, 0xB1);
                        QSW(t0, t2, od2, 0x4E  ); QSW(t1, t3, od2, 0x4E);
                        v0[c] = t0; v1[c] = t1; v2[c] = t2; v3[c] = t3;
                    }
                    if (true) {
                        bf16_t* o0 = Oq + 64 * grp; bf16_t* o1 = o0 + (size_t)epit; bf16_t* o2 = o1 + (size_t)epit; bf16_t* o3 = o2 + (size_t)epit;
                        asm volatile("global_store_dwordx4 %0, %4, off sc0 sc1\n\tglobal_store_dwordx4 %1, %5, off sc0 sc1\n\tglobal_store_dwordx4 %2, %6, off sc0 sc1\n\tglobal_store_dwordx4 %3, %7, off sc0 sc1\n\ts_nop 1"
                                     :: "v"(o0), "v"(o1), "v"(o2), "v"(o3), "v"(v0), "v"(v1), "v"(v2), "v"(v3) : "memory");
                    } else {
                    *(u32x4*)(Oq + 64 * grp) = v0;
                    *(u32x4*)(Oq + (size_t)epit + 64 * grp) = v1;
                    *(u32x4*)(Oq + 2 * (size_t)epit + 64 * grp) = v2;
                    *(u32x4*)(Oq + 3 * (size_t)epit + 64 * grp) = v3;
                    }
                }
#undef QSW
            }
            newer8 = 8;
            m_reg = -1e30f; l_reg = 0; fresh = true; pe_due = false;
#pragma unroll
            for (int d_ = 0; d_ < 4; ++d_)
#pragma unroll
                for (int r = 0; r < 16; ++r) o[d_][r] *= 0.f;
            TSTOP(5)
        }
        TSTART(1) vm_wait_le((issued ? 4 : 0) + newer8); LBAR(); TSTOP(1) TSTOP(7)
    }
#undef ISSUE
#undef CROFF
    S.eO = cur.O; S.eL = cur.L; S.eq = cur.P0 + 256 * (cur.M - 1); S.epitch = pit; S.elst = cur.lstride;
    S.v = v0 + KN; S.m = m_reg; S.l = l_reg; S.fresh = fresh ? 1 : 0;
#pragma unroll
    for (int d_ = 0; d_ < 4; ++d_) S.o[d_] = o[d_];
}
#undef QLD
#undef QLD0
#undef DSW32
#undef DSW16
#undef DSR32
#undef DSR128
#undef LGKM0
#undef VMWN
#undef LBAR
#undef KSWZ
#undef SBAR
}

constexpr int NWAVES = 8;
constexpr int N_LAUNCHES = MK_N_LAUNCHES;
constexpr int PER_PHASE = 5;
#ifndef MK_DUP_PHASE
#define MK_DUP_PHASE -1
#endif
constexpr int DUP_PHASE = MK_DUP_PHASE;
constexpr int BATCH = 4, SEQ = 4096, DM = 2048, M = BATCH * SEQ;
constexpr int NH = 8, HD = 128, DATT = 1024, DPOOL = 1024, DIN = 6144;
constexpr float LN_EPS = 1e-5f;
constexpr float DN_ALPHA = 1.189207115002721f;
constexpr float QSCALE = 1.4426950408889634f * 0.08838834764831845f;

constexpr size_t MiB = 1u << 20;
constexpr size_t WS_CTL = 0, CTL_ZERO_BYTES = 64 * 1024;
constexpr size_t WS_ROPE = 1 * MiB;
constexpr size_t WS_WOUT = 4 * MiB;
constexpr size_t WS_XB = 36 * MiB;
constexpr size_t WS_WIN = 100 * MiB;
constexpr size_t WS_O = 36 * MiB;
constexpr size_t WS_QKV = 132 * MiB;
constexpr size_t WS_Y = 132 * MiB;
constexpr size_t WS_U = 228 * MiB;
constexpr size_t WS_G = 260 * MiB;
constexpr size_t WS_L = 324 * MiB;
constexpr size_t WS_FOLD = 326 * MiB;
constexpr size_t WS_END = 334 * MiB;
constexpr size_t WS_X = 1 * MiB + 512 * 1024;
constexpr int CW_PANEL = 8192;
constexpr int CW_BAR = 1024;

constexpr int RING_BYTES = 131072;
constexpr int LDSCTL_OFF = 159744, MISC_OFF = LDSCTL_OFF + 320;
constexpr int LDS_BYTES = 163840;

#define GAS __attribute__((address_space(1)))
#define LAS __attribute__((address_space(3)))
typedef unsigned short bf16;
typedef unsigned v4u __attribute__((ext_vector_type(4)));
typedef unsigned v2u __attribute__((ext_vector_type(2)));
typedef float f32x4 __attribute__((ext_vector_type(4)));
typedef short bf16x8 __attribute__((ext_vector_type(8)));
typedef GAS unsigned gu32;
#define RLX_AGENT __ATOMIC_RELAXED, __HIP_MEMORY_SCOPE_AGENT
#define LDS_WAIT() asm volatile("s_waitcnt lgkmcnt(0)" ::: "memory")
#define VM_WAIT() asm volatile("s_waitcnt vmcnt(0)" ::: "memory")
__device__ __forceinline__ unsigned pk2(float lo, float hi) { unsigned r; asm volatile("v_cvt_pk_bf16_f32 %0, %1, %2" : "=v"(r) : "v"(lo), "v"(hi)); return r; }
__device__ __forceinline__ float bf_lo(unsigned w) { return __uint_as_float(w << 16); }
__device__ __forceinline__ float bf_hi(unsigned w) { return __uint_as_float(w & 0xffff0000u); }
__device__ __forceinline__ float silu_f(float g) { return g * __builtin_amdgcn_rcpf(1.f + __builtin_amdgcn_exp2f(-1.4426950408889634f * g)); }

#define XB_TMO      128
#define XB_XCNT(j)  (256  + 64 * (j))
#define XB_XSUB(j)  (1280 + 64 * (j))
#define XB_XGEN(j)  (2304 + 64 * (j))
#define XB_TOP      3328
#define XB_TOPGEN   3392
#define XCD_BAR_WORDS 3456
#define XB_SPIN_CAP (1u << 18)

__device__ __forceinline__ unsigned xb_ld(unsigned* p)              { return __hip_atomic_load(p, __ATOMIC_RELAXED, __HIP_MEMORY_SCOPE_AGENT); }
__device__ __forceinline__ unsigned xb_add(unsigned* p, unsigned v) { return __hip_atomic_fetch_add(p, v, __ATOMIC_RELAXED, __HIP_MEMORY_SCOPE_AGENT); }
__device__ __forceinline__ unsigned xb_xcc_id() { return (unsigned)__builtin_amdgcn_s_getreg((3 << 11) | 20) & 0xFu; }
#define XB_SPIN(cond, bar) do { unsigned _sp = 0; while (cond) { __builtin_amdgcn_s_sleep(1); \
    if ((++_sp & 255u) == 0u) { if (xb_ld(&(bar)[XB_TMO])) break; if (_sp > XB_SPIN_CAP) { atomicAdd(&(bar)[XB_TMO], 1u); break; } } } } while (0)

struct XcdBarrier {
    unsigned* bar; unsigned x;
    volatile LAS unsigned* st;
};

__device__ __forceinline__ XcdBarrier xcd_barrier_post(unsigned* bar, volatile LAS unsigned* st) {
    XcdBarrier b; b.bar = bar; b.x = xb_xcc_id(); b.st = st;
    if (threadIdx.x == 0) (void)xb_add(&bar[XB_XCNT(b.x)], 1u);
    return b;
}
__device__ __forceinline__ void xcd_barrier_complete(unsigned* bar, unsigned x, unsigned& nloc, unsigned& nx) {
    const unsigned G = gridDim.x * gridDim.y * gridDim.z;
    unsigned sum, cnt, mine, sp = 0u;
    for (;;) {
        sum = 0u; cnt = 0u; mine = 0u;
#pragma unroll
        for (unsigned j = 0; j < 16; ++j) { const unsigned c = xb_ld(&bar[XB_XCNT(j)]); sum += c; cnt += (c > 0u) ? 1u : 0u; mine = (j == x) ? c : mine; }
        if (sum == G) break;
        __builtin_amdgcn_s_sleep(1);
        if ((++sp & 255u) == 0u) { if (xb_ld(&bar[XB_TMO])) break; if (sp > XB_SPIN_CAP) { atomicAdd(&bar[XB_TMO], 1u); break; } }
    }
    nloc = mine > 0u ? mine : 1u; nx = cnt > 0u ? cnt : 1u;
}

__device__ __forceinline__ void xcd_barrier(const XcdBarrier& b) {
    asm volatile("s_waitcnt vmcnt(0)" ::: "memory");
    __syncthreads();
    if (threadIdx.x == 0) {
        unsigned* bar = b.bar;
        __builtin_amdgcn_s_waitcnt(0);
        unsigned nloc = b.st[0], nx = b.st[1];
        if (nloc == 0u) { xcd_barrier_complete(bar, b.x, nloc, nx); b.st[0] = nloc; b.st[1] = nx; }
        const unsigned old = xb_add(&bar[XB_XSUB(b.x)], 1u);
        const unsigned gen = old / nloc;
        if (old + 1u == (gen + 1u) * nloc) {
            __builtin_amdgcn_fence(__ATOMIC_RELEASE, "agent");
            asm volatile("s_waitcnt vmcnt(0)" ::: "memory");
            const unsigned og = xb_add(&bar[XB_TOP], 1u);
            const unsigned tg = og / nx;
            if (og + 1u == (tg + 1u) * nx) xb_add(&bar[XB_TOPGEN], 1u);
            else XB_SPIN(xb_ld(&bar[XB_TOPGEN]) == tg, bar);
            __builtin_amdgcn_fence(__ATOMIC_ACQUIRE, "agent");
            xb_add(&bar[XB_XGEN(b.x)], 1u);
            asm volatile("s_waitcnt vmcnt(0)" ::: "memory");
        } else {
            XB_SPIN(xb_ld(&bar[XB_XGEN(b.x)]) == gen, bar);
            __builtin_amdgcn_fence(__ATOMIC_ACQUIRE, "agent");
            asm volatile("s_waitcnt vmcnt(0)" ::: "memory");
        }
    }
    __syncthreads();
}
#ifndef MK_FSLOTS
#define MK_FSLOTS 1
#define MK_OSLOTS 5
#endif
#ifndef MK_OSHI
#define MK_OSHI 0
#endif

__device__ __forceinline__ void p0_transpose_item(const float* W, int K, int N, bf16* WT, LAS float* scr, int item, int lane) {
    const int nblk = N / 64, kb = item / nblk, nb = item % nblk, k0 = 64 * kb, n0 = 64 * nb;
    f32x4 v[16];
#pragma unroll
    for (int i = 0; i < 16; ++i) v[i] = __builtin_nontemporal_load((const GAS f32x4*)(W + (size_t)(k0 + 4 * i + (lane >> 4)) * N + n0 + 4 * (lane & 15)));
#pragma unroll
    for (int i = 0; i < 16; ++i) { LAS float* d = scr + (4 * i + (lane >> 4)) * 65 + 4 * (lane & 15); d[0] = v[i][0]; d[1] = v[i][1]; d[2] = v[i][2]; d[3] = v[i][3]; }
    LDS_WAIT(); asm volatile("" ::: "memory");
    const int c = lane & 7;
#pragma unroll
    for (int j = 0; j < 8; ++j) { const int n = (lane >> 3) + 8 * j; const LAS float* s = scr + (8 * c) * 65 + n;
        v4u o; o.x = pk2(s[0 * 65], s[1 * 65]); o.y = pk2(s[2 * 65], s[3 * 65]); o.z = pk2(s[4 * 65], s[5 * 65]); o.w = pk2(s[6 * 65], s[7 * 65]);
        *(GAS v4u*)(WT + (size_t)(n0 + n) * K + k0 + 8 * c) = o; }
    LDS_WAIT(); asm volatile("" ::: "memory");
}
__device__ __forceinline__ void p0_transpose_pair(const float* Wa, int Ka, int Na, bf16* WTa, int itema, const float* Wb, int Kb, int Nb, bf16* WTb, int itemb, LAS float* scr, int lane) {
    const int nba = Na / 64, kba = itema / nba, nna = itema % nba, k0a = 64 * kba, n0a = 64 * nna;
    const int nbb = Nb / 64, kbb = itemb / nbb, nnb = itemb % nbb, k0b = 64 * kbb, n0b = 64 * nnb;
    f32x4 va[16], vb[16];
#pragma unroll
    for (int i = 0; i < 16; ++i) va[i] = __builtin_nontemporal_load((const GAS f32x4*)(Wa + (size_t)(k0a + 4 * i + (lane >> 4)) * Na + n0a + 4 * (lane & 15)));
#pragma unroll
    for (int i = 0; i < 16; ++i) vb[i] = __builtin_nontemporal_load((const GAS f32x4*)(Wb + (size_t)(k0b + 4 * i + (lane >> 4)) * Nb + n0b + 4 * (lane & 15)));
    const int c = lane & 7;
#define P0T_ONE(v, WT, K, k0, n0) do { \
    _Pragma("unroll") for (int i = 0; i < 16; ++i) { LAS float* d = scr + (4 * i + (lane >> 4)) * 65 + 4 * (lane & 15); d[0] = v[i][0]; d[1] = v[i][1]; d[2] = v[i][2]; d[3] = v[i][3]; } \
    LDS_WAIT(); asm volatile("" ::: "memory"); \
    _Pragma("unroll") for (int j = 0; j < 8; ++j) { const int n = (lane >> 3) + 8 * j; const LAS float* s = scr + (8 * c) * 65 + n; \
        v4u o; o.x = pk2(s[0 * 65], s[1 * 65]); o.y = pk2(s[2 * 65], s[3 * 65]); o.z = pk2(s[4 * 65], s[5 * 65]); o.w = pk2(s[6 * 65], s[7 * 65]); \
        *(GAS v4u*)(WT + (size_t)(n0 + n) * K + k0 + 8 * c) = o; } \
    LDS_WAIT(); asm volatile("" ::: "memory"); } while (0)
    P0T_ONE(va, WTa, Ka, k0a, n0a);
    P0T_ONE(vb, WTb, Kb, k0b, n0b);
#undef P0T_ONE
}
__device__ __forceinline__ void sincos_pi(double r, double& s, double& c) {
    const double z = r * r;
    double ss = 0.0, cc = 0.0, term_s = r, term_c = 1.0;
#pragma unroll
    for (int k = 0; k < 16; ++k) { ss += term_s; cc += term_c; term_c = -term_c * z * (1.0 / (double)((2 * k + 1) * (2 * k + 2))); term_s = -term_s * z * (1.0 / (double)((2 * k + 2) * (2 * k + 3))); }
    s = ss; c = cc;
}
__device__ __forceinline__ void p0_prologue(LAS unsigned char* lds, const float* x, const float* w_in, const float* w_pool, const float* w_out, unsigned char* ws, int vcu, int G, int tid, int wave, int lane) {
    LAS float* scr = (LAS float*)(lds + wave * 16896);
    bf16* WinT = (bf16*)(ws + WS_WIN); bf16* WoutT = (bf16*)(ws + WS_WOUT);
    const bool fold = (G == 256) && (vcu < 32);
    if (fold) {
        const int g = vcu >> 3, j = vcu & 7;
        bf16* Ap = (bf16*)(ws + WS_FOLD) + (size_t)vcu * 131072;
        bf16* Bp = Ap + 65536;
        p0_transpose_pair(w_pool + (size_t)g * 65536, 256, 256, Ap, wave, w_pool + (size_t)g * 65536, 256, 256, Ap, wave + 8, scr, lane);
        {
            f32x4 a[16], b[16];
#pragma unroll
            for (int k = 0; k < 16; ++k) { const int e = tid + k * (NWAVES * 64), r = e >> 5, c8 = e & 31;
                const float* s = w_in + (size_t)(256 * j + r) * DIN + 3072 + 256 * g + c8 * 8;
                a[k] = __builtin_nontemporal_load((const GAS f32x4*)s); b[k] = __builtin_nontemporal_load((const GAS f32x4*)(s + 4)); }
#pragma unroll
            for (int k = 0; k < 16; ++k) { const int e = tid + k * (NWAVES * 64), r = e >> 5, c8 = e & 31;
                v4u o; o.x = pk2(a[k][0], a[k][1]); o.y = pk2(a[k][2], a[k][3]); o.z = pk2(b[k][0], b[k][1]); o.w = pk2(b[k][2], b[k][3]);
                *(GAS v4u*)(Bp + (size_t)r * 256 + c8 * 8) = o; }
        }
        VM_WAIT(); __syncthreads();
        pg8::Gemm gg{Ap, Bp, 256, 256, 256}; pg8::SchedOne S1; pg8::EpiW E{WinT + (size_t)(3072 + 256 * g) * DM + 256 * j};
        pg8::gemm_phase<pg8::EpiW, pg8::SchedOne, true, true>(lds, gg, S1, E);
    }
    {
        const int nfold = (G == 256) ? 32 : 0;
        const int gw = (vcu - nfold) * NWAVES + wave, NGW = (G - nfold) * NWAVES;
        constexpr int NB_IN = DIN / 64 - 16, I_IN = (DM / 64) * NB_IN, I_OUT = (DM / 64) * (DM / 64), NITEMS = I_IN + I_OUT;
        if (!fold) {
            if (G == 256) {
                const int ja = gw, jb = gw + NGW;
                const bool ain = ja < I_IN, bin = jb < I_IN;
                const int ra = ain ? (ja / NB_IN) * (DIN / 64) + ((ja % NB_IN) < 48 ? (ja % NB_IN) : (ja % NB_IN) + 16) : ja - I_IN;
                const int rb = bin ? (jb / NB_IN) * (DIN / 64) + ((jb % NB_IN) < 48 ? (jb % NB_IN) : (jb % NB_IN) + 16) : jb - I_IN;
                p0_transpose_pair(ain ? w_in : w_out, DM, ain ? DIN : DM, ain ? WinT : WoutT, ra, bin ? w_in : w_out, DM, bin ? DIN : DM, bin ? WinT : WoutT, rb, scr, lane);
            } else {
                for (int it = gw; it < (DM / 64) * (DIN / 64) + I_OUT; it += NGW) {
                    int r = it;
                    if (r < (DM / 64) * (DIN / 64)) { p0_transpose_item(w_in, DM, DIN, WinT, scr, r, lane); continue; } r -= (DM / 64) * (DIN / 64);
                    p0_transpose_item(w_out, DM, DM, WoutT, scr, r, lane);
                }
            }
        }
    }
    {
        const size_t gt = (size_t)vcu * (NWAVES * 64) + tid, NT = (size_t)G * (NWAVES * 64);
        bf16* XB = (bf16*)(ws + WS_XB);
        const int nf = (G == 256) ? 32 : 0, nlo = (G == 256) ? 96 : 0;
        const int slots = fold ? MK_FSLOTS : (vcu < nf + nlo ? MK_OSLOTS : MK_OSLOTS + MK_OSHI);
        const int slot0 = fold ? MK_FSLOTS * vcu : MK_FSLOTS * nf + (vcu < nf + nlo ? MK_OSLOTS * (vcu - nf) : MK_OSLOTS * nlo + (MK_OSLOTS + MK_OSHI) * (vcu - nf - nlo));
        const int nslots = MK_FSLOTS * nf + MK_OSLOTS * nlo + (MK_OSLOTS + MK_OSHI) * (G - nf - nlo);
        constexpr int XU = MK_XU;
        for (int sl = 0; sl < slots; ++sl) {
            int tx_ = tid; asm volatile("" : "+v"(tx_));
            const size_t st = (size_t)(slot0 + sl) * (NWAVES * 64) + tx_, SN = (size_t)nslots * (NWAVES * 64);
            for (size_t i = st; i < (size_t)M * DM / 8; i += SN * XU) {
                f32x4 a[XU], b[XU];
#pragma unroll
                for (int k = 0; k < XU; ++k) { const unsigned ii = (unsigned)(i + (size_t)k * SN), pa = (ii >> 6) * 128u + (ii & 63u); a[k] = (f32x4){0.f, 0.f, 0.f, 0.f}; b[k] = a[k];
                    if (ii < (unsigned)(M * DM / 8)) { const float* xa_ = x + (size_t)pa * 4; a[k] = __builtin_nontemporal_load((const GAS f32x4*)xa_); b[k] = __builtin_nontemporal_load((const GAS f32x4*)(xa_ + 256)); } }
#pragma unroll
                for (int k = 0; k < XU; ++k) { const unsigned ii = (unsigned)(i + (size_t)k * SN), pa = (ii >> 6) * 128u + (ii & 63u);
                    v2u oa, ob; oa.x = pk2(a[k][0], a[k][1]); oa.y = pk2(a[k][2], a[k][3]); ob.x = pk2(b[k][0], b[k][1]); ob.y = pk2(b[k][2], b[k][3]);
                    if (ii < (unsigned)(M * DM / 8)) { bf16* xo_ = XB + (size_t)pa * 4; bf16* xo2_ = xo_ + 256; asm volatile("global_store_dwordx2 %0, %2, off sc0 sc1\n\tglobal_store_dwordx2 %1, %3, off sc0 sc1\n\ts_nop 1" :: "v"(xo_), "v"(xo2_), "v"(oa), "v"(ob) : "memory"); } }
            }
        }
        float* rope = (float*)(ws + WS_ROPE);
        for (size_t e = gt; e < 65536; e += NT) {
            const int i = (int)(e & 15), pos = (int)(e >> 4);
            double f;
            switch (i) { case 0: f = 1.0; break; case 1: f = 0.44036660267178046; break; case 2: f = 0.19392274474868576; break; case 3: f = 0.08539710028576561; break;
                case 4: f = 0.03760603093086393; break; case 5: f = 0.016560440080994446; break; case 6: f = 0.007292664737217109; break; case 7: f = 0.003211445994752591; break;
                case 8: f = 0.001414213562373095; break; case 9: f = 0.000622772421914596; break; case 10: f = 0.0002742481756762073; break; case 11: f = 0.00012076973741146504; break;
                case 12: f = 5.318295896944988e-05; break; case 13: f = 2.341999896140934e-05; break; case 14: f = 1.031338537721246e-05; break; default: f = 4.5416704806078695e-06; break; }
            const double ang = (double)pos * f;
            const double k = __builtin_rint(ang * 0.15915494309189535);
            const double r = __builtin_fma(-k, 2.4492935982947064e-16, __builtin_fma(-k, 6.283185307179586, ang));
            double s, c; sincos_pi(r, s, c);
            rope[e] = (float)c; rope[65536 + e] = (float)s;
        }
    }
}

template <int W>
__device__ __forceinline__ void pool_strip(const bf16* V, const bf16* Gt, const float* pool_scale, bf16* Y, int g, int strip, int ch) {
    const int tok0 = strip * 8, t0 = tok0 & 4095, col = g * 256 + ch * 8;
    constexpr int NR = W - 1 + 8;
    v4u rows[NR];
#pragma unroll
    for (int j = 0; j < NR; ++j) { const int dt = j - (W - 1); rows[j] = (v4u){0u, 0u, 0u, 0u}; if (t0 + dt >= 0) rows[j] = *(const GAS v4u*)(V + (size_t)(tok0 + dt) * 1024 + col); }
    const f32x4 sa = *(const GAS f32x4*)(pool_scale + col), sb = *(const GAS f32x4*)(pool_scale + col + 4);
    const float sc[8] = {sa[0], sa[1], sa[2], sa[3], sb[0], sb[1], sb[2], sb[3]};
    float s[8];
#pragma unroll
    for (int k = 0; k < 8; ++k) s[k] = 0.f;
#pragma unroll
    for (int j = 0; j < W - 1; ++j)
#pragma unroll
        for (int k = 0; k < 4; ++k) { s[2 * k] += bf_lo(rows[j][k]); s[2 * k + 1] += bf_hi(rows[j][k]); }
    v4u gts[8];
#pragma unroll
    for (int i = 0; i < 8; ++i) gts[i] = __builtin_nontemporal_load((const GAS v4u*)(Gt + (size_t)(tok0 + i) * 2048 + 1024 + col));
#pragma unroll
    for (int i = 0; i < 8; ++i) {
        const v4u q = rows[W - 1 + i];
        const v4u gt = gts[i];
        const int cnt = (t0 + i + 1 < W) ? t0 + i + 1 : W;
        const float inv = 1.f / (float)cnt;
        v4u o;
#pragma unroll
        for (int k = 0; k < 4; ++k) { const float u0 = bf_lo(q[k]), u1 = bf_hi(q[k]); s[2 * k] += u0; s[2 * k + 1] += u1;
            o[k] = pk2((s[2 * k] * inv - u0) * sc[2 * k] * silu_f(bf_lo(gt[k])), (s[2 * k + 1] * inv - u1) * sc[2 * k + 1] * silu_f(bf_hi(gt[k]))); }
        { bf16* dp_ = Y + (size_t)(tok0 + i) * 2048 + 1024 + col; asm volatile("global_store_dwordx4 %0, %1, off sc0 sc1\n\ts_nop 1" :: "v"(dp_), "v"(o) : "memory"); }
#pragma unroll
        for (int k = 0; k < 4; ++k) { s[2 * k] -= bf_lo(rows[i][k]); s[2 * k + 1] -= bf_hi(rows[i][k]); }
    }
}
__device__ __forceinline__ void pool_phase(const bf16* V, const bf16* Gt, const float* pool_scale, bf16* Y, int vcu, int G, int tid) {
    for (int it = vcu * (NWAVES * 64) + tid; it < 262144; it += G * (NWAVES * 64)) {
        asm volatile("" ::: "memory");
        const int ch = it & 31, sub = (it >> 5) & 1, g = __builtin_amdgcn_readfirstlane((it >> 6) & 3), strip = ((it >> 8) << 1) | sub;
        switch (g) { case 0: pool_strip<2>(V, Gt, pool_scale, Y, 0, strip, ch); break; case 1: pool_strip<4>(V, Gt, pool_scale, Y, 1, strip, ch); break;
                     case 2: pool_strip<8>(V, Gt, pool_scale, Y, 2, strip, ch); break; default: pool_strip<16>(V, Gt, pool_scale, Y, 3, strip, ch); break; }
    }
}

__device__ __forceinline__ void combine_phase(const bf16* O, const float* L, const bf16* Gt, bf16* Y, int vcu, int G, int tid) {
    const size_t gt = (size_t)vcu * (NWAVES * 64) + tid, NT = (size_t)G * (NWAVES * 64);
    constexpr size_t PST = (size_t)32 * 4096 * 128, LST = (size_t)32 * 4096;
    constexpr int CU_ = 4;
    for (size_t idx0 = gt; idx0 < (size_t)32 * 4096 * 16; idx0 += NT * CU_) {
        v4u o1[CU_], o2[CU_], o3[CU_], gv[CU_]; float l1[CU_], l2[CU_], l3[CU_]; size_t yo[CU_];
#pragma unroll
        for (int k = 0; k < CU_; ++k) { const size_t idx = idx0 + (size_t)k * NT;
            const int c8 = (int)(idx & 15), t = (int)((idx >> 4) & 4095), bh = (int)(idx >> 16);
            const size_t oo = ((size_t)bh * 4096 + t) * 128 + c8 * 8, lo = (size_t)bh * 4096 + t;
            o1[k] = *(const GAS v4u*)(O + oo); o2[k] = *(const GAS v4u*)(O + PST + oo); o3[k] = *(const GAS v4u*)(O + 2 * PST + oo);
            l1[k] = L[lo]; l2[k] = L[LST + lo]; l3[k] = L[2 * LST + lo];
            yo[k] = ((size_t)((bh >> 3) * 4096 + t)) * 2048 + (bh & 7) * 128 + c8 * 8;
            gv[k] = *(const GAS v4u*)(Gt + yo[k]); }
#pragma unroll
        for (int k = 0; k < CU_; ++k) {
            const float mx = fmaxf(l1[k], fmaxf(l2[k], l3[k]));
            float w1 = __builtin_amdgcn_exp2f(l1[k] - mx), w2 = __builtin_amdgcn_exp2f(l2[k] - mx), w3 = __builtin_amdgcn_exp2f(l3[k] - mx);
            const float inv = 1.f / (w1 + w2 + w3); w1 *= inv; w2 *= inv; w3 *= inv;
            v4u out;
#define CMB(e) { const float a = (w1 * bf_lo(o1[k][e]) + w2 * bf_lo(o2[k][e]) + w3 * bf_lo(o3[k][e])) * silu_f(bf_lo(gv[k][e])); const float b = (w1 * bf_hi(o1[k][e]) + w2 * bf_hi(o2[k][e]) + w3 * bf_hi(o3[k][e])) * silu_f(bf_hi(gv[k][e])); out[e] = pk2(a, b); }
            CMB(0) CMB(1) CMB(2) CMB(3)
#undef CMB
            *(GAS v4u*)(Y + yo[k]) = out;
        }
    }
}

struct Args { const float* x; const float* w_in; const float* w_pool; const float* pool_scale; const float* w_out; const float* ln_gain; const float* ln_bias; float* out; unsigned char* ws; int ph_lo, ph_hi; };
__global__ void __launch_bounds__(NWAVES * 64, 2) hybrid_fwd(Args args) {
    extern __shared__ __attribute__((aligned(16))) unsigned char lds_raw[];
    LAS unsigned char* lds = (LAS unsigned char*)lds_raw;
    volatile LAS unsigned* MISC = (volatile LAS unsigned*)(lds + MISC_OFF);
    const int tid = threadIdx.x, lane = tid & 63, wave = __builtin_amdgcn_readfirstlane(tid >> 6);
    const int G = gridDim.x; const int bx = blockIdx.x; const int vcu = (G % 8 == 0) ? (bx % 8) * (G / 8) + bx / 8 : bx;
    unsigned char* ws = args.ws;
    gu32* ctl = (gu32*)(ws + WS_CTL);
    for (int u = tid; u < (LDS_BYTES - LDSCTL_OFF) / 4; u += NWAVES * 64) ((LAS unsigned*)(lds + LDSCTL_OFF))[u] = 0u;
    __syncthreads();
    XcdBarrier bar; bar.bar = (unsigned*)(ctl + CW_BAR); bar.x = 0; bar.st = nullptr;
    if (N_LAUNCHES != PER_PHASE) bar = xcd_barrier_post((unsigned*)(ctl + CW_BAR), MISC + 8);
#define GRID_BAR() do { if (N_LAUNCHES != PER_PHASE) xcd_barrier(bar); } while (0)
#if defined(MK_STAMP_PHASE)
#ifndef MK_STAMP_BLOCK
#define MK_STAMP_BLOCK 0
#endif
#ifndef MK_STAMP_TO
#define MK_STAMP_TO (MK_STAMP_PHASE + 1)
#endif
#define STAMP(k) do { if (tid == 0) { const unsigned long long t__ = __builtin_amdgcn_s_memrealtime(); MISC[16 + 2 * (k)] = (unsigned)t__; MISC[17 + 2 * (k)] = (unsigned)(t__ >> 32); } } while (0)
#else
#define STAMP(k)
#endif
    STAMP(0);
    const int lo = (N_LAUNCHES == 1) ? 0 : args.ph_lo, hi = (N_LAUNCHES == 1) ? PER_PHASE : args.ph_hi;
#define IN(k) (lo <= (k) && (k) < hi)
#if MK_DUP_PHASE >= 0
#define REP(k) for (int rep_ = 0; rep_ < (DUP_PHASE == (k) ? 2 : 1); ++rep_)
#else
#define REP(k)
#endif
#define BOTH(k) (IN(k) && IN((k) + 1))
    bf16* XB = (bf16*)(ws + WS_XB); bf16* WinT = (bf16*)(ws + WS_WIN); bf16* WoutT = (bf16*)(ws + WS_WOUT);
    bf16* QKV = (bf16*)(ws + WS_QKV); bf16* Ub = (bf16*)(ws + WS_U); bf16* Gb = (bf16*)(ws + WS_G); bf16* Ob = (bf16*)(ws + WS_O); float* Lb = (float*)(ws + WS_L); bf16* Yb = (bf16*)(ws + WS_Y);
    float* rope = (float*)(ws + WS_ROPE);

    REP(0) if (IN(0)) { int t_ = threadIdx.x; asm volatile("" : "+v"(t_)); p0_prologue(lds, args.x, args.w_in, args.w_pool, args.w_out, ws, vcu, G, t_, __builtin_amdgcn_readfirstlane(t_ >> 6), t_ & 63); __syncthreads(); STAMP(10); if (BOTH(0)) GRID_BAR(); STAMP(1); }

    REP(1) if (IN(1)) {
        pg8::Gemm g{XB, WinT, M, DIN, DM}; pg8::StaticOrder S; S.init(M, DIN, G, bx); S.rev = true;
        pg8::EpiH E{QKV, Ub, Gb, rope, QSCALE};
        pg8::gemm_phase<pg8::EpiH, pg8::StaticOrder, true, true>(lds, g, S, E);
        if (BOTH(1)) GRID_BAR();
        STAMP(2);
    }

    REP(2) if (IN(2)) {
#if defined(MK_DUP_SUB) && MK_DUP_SUB == 1
        for (int rs_ = 0; rs_ < 2; ++rs_)
#endif
        if (G == 256) {
            att::Carry S;
            att::Chain cur, nxt;
#define MKCH(R, c) do { const int c_ = (c), bh = (vcu >> 3), kk = vcu & 7, pt = c_ ? 2 : (kk >> 2), res = c_ ? 2 * kk + c_ - 1 : (kk < 4 ? 0 : kk - 4), dil = 1 << (2 * pt); \
                const size_t hb = (size_t)bh * 4096 * 128 + (size_t)res * 128; \
                R.Q = QKV + hb; R.K = QKV + (size_t)32 * 4096 * 128 + hb; R.V = QKV + (size_t)64 * 4096 * 128 + hb; R.O = Ob + (size_t)(32 * pt) * 4096 * 128 + hb; \
                R.L = Lb + (size_t)(32 * pt + bh) * 4096 + res; R.P0 = (c_ == 0 && kk < 4) ? 1024 * kk : 0; R.M = c_ ? 1 : 4; R.pitch = 128 * dil; R.lstride = dil; } while (0)
            MKCH(cur, 0);
            STAMP(9);
            att::swc_prime(cur, lds, (char*)lds_raw, S);
            STAMP(8);
            for (int i = 0; i < 3; ++i) {
                if (i < 2) MKCH(nxt, i + 1); else nxt = cur;
                att::swc_chain(i > 0, cur, nxt, i < 2, (char*)lds_raw, lds, S);
                cur = nxt;
            }
#undef MKCH
#if defined(MK_TSEC) && MK_TSEC > 0
            if (blockIdx.x == MK_TBLOCK && wave == MK_TWAVE && lane == 0) { MISC[40] = (unsigned)S.tacc; MISC[41] = (unsigned)(S.tacc >> 32); }
#endif
            STAMP(7);
            VM_WAIT(); __syncthreads();
            STAMP(6);
        }
        if (BOTH(2)) GRID_BAR();
        STAMP(3);
    }

    REP(3) if (IN(3)) { int t_ = threadIdx.x; asm volatile("" : "+v"(t_)); pool_phase(Ub, Gb, args.pool_scale, Yb, vcu, G, t_);
        combine_phase(Ob, Lb, Gb, Yb, vcu, G, t_);
        if (BOTH(3)) GRID_BAR(); STAMP(4); }

    REP(4) if (IN(4)) {
        pg8::Gemm g{Yb, WoutT, M, DM, DM}; pg8::SchedLN S{(int)bx};
        pg8::EpiLN E{args.x, args.out, args.ln_gain, args.ln_bias, DN_ALPHA, LN_EPS, (unsigned long long*)(ws + WS_X), (unsigned*)(ctl + CW_PANEL)};
        if (G == 256) pg8::gemm_phase<pg8::EpiLN, pg8::SchedLN, true, true>(lds, g, S, E);
    }
#if defined(MK_TSEC) && MK_TSEC > 0
    __syncthreads();
    if (blockIdx.x == MK_TBLOCK && tid == 0) {
        const unsigned long long want = 8ull * (((unsigned long long)MISC[41] << 32) | MISC[40]), t0 = __builtin_amdgcn_s_memtime();
        while (__builtin_amdgcn_s_memtime() - t0 < want) __builtin_amdgcn_s_sleep(4);
    }
#endif
#if defined(MK_STAMP_PHASE)
    STAMP(5);
    if (blockIdx.x == MK_STAMP_BLOCK && tid == 0) {
        const unsigned long long a = ((unsigned long long)MISC[17 + 2 * MK_STAMP_PHASE] << 32) | MISC[16 + 2 * MK_STAMP_PHASE], b = ((unsigned long long)MISC[17 + 2 * MK_STAMP_TO] << 32) | MISC[16 + 2 * MK_STAMP_TO];
        const unsigned long long t0 = __builtin_amdgcn_s_memrealtime(), want = 8ull * (b - a);
        while (__builtin_amdgcn_s_memrealtime() - t0 < want) __builtin_amdgcn_s_sleep(8);
    }
#endif
#undef IN
#undef BOTH
#undef GRID_BAR
}

extern "C" void kernel_launch(void* const* d_in, const int* in_sizes, int n_in, void* d_out, int out_size, void* d_ws, size_t ws_size, hipStream_t stream) {
    static int grid = 0;
    if (grid == 0) {
        if (n_in != 7 || in_sizes[0] != M * DM || out_size != M * DM || ws_size < WS_END) { fprintf(stderr, "kernel_launch: shape mismatch (n_in %d in0 %d out %d ws %zu)\n", n_in, n_in > 0 ? in_sizes[0] : -1, out_size, ws_size); grid = -1; return; }
        int dev = 0, cus = 0, per_cu = 0;
        if (hipGetDevice(&dev) != hipSuccess || hipDeviceGetAttribute(&cus, hipDeviceAttributeMultiprocessorCount, dev) != hipSuccess) { fprintf(stderr, "kernel_launch: device query failed\n"); grid = -1; return; }
        if (hipFuncSetAttribute((const void*)hybrid_fwd, hipFuncAttributeMaxDynamicSharedMemorySize, LDS_BYTES) != hipSuccess) { fprintf(stderr, "kernel_launch: hipFuncSetAttribute failed\n"); grid = -1; return; }
        if (hipOccupancyMaxActiveBlocksPerMultiprocessor(&per_cu, (const void*)hybrid_fwd, NWAVES * 64, LDS_BYTES) != hipSuccess || per_cu < 1)
            fprintf(stderr, "kernel_launch: note: occupancy query reports %d workgroups per CU\n", per_cu);
        (void)hipGetLastError();
        grid = cus;
        if (grid != 256) fprintf(stderr, "kernel_launch: %d CUs: the attention phase is dealt for 256 workgroups\n", grid);
    }
    if (grid < 0) return;
    if (hipMemsetAsync((char*)d_ws + WS_CTL, 0, CTL_ZERO_BYTES, stream) != hipSuccess) { fprintf(stderr, "kernel_launch: memset failed\n"); return; }
    Args a{};
    a.x = (const float*)d_in[0]; a.w_in = (const float*)d_in[1]; a.w_pool = (const float*)d_in[2]; a.pool_scale = (const float*)d_in[3];
    a.w_out = (const float*)d_in[4]; a.ln_gain = (const float*)d_in[5]; a.ln_bias = (const float*)d_in[6]; a.out = (float*)d_out; a.ws = (unsigned char*)d_ws;
    for (int li = 0; li < N_LAUNCHES; ++li) {
        a.ph_lo = (N_LAUNCHES == PER_PHASE) ? li : 0; a.ph_hi = (N_LAUNCHES == PER_PHASE) ? li + 1 : PER_PHASE;
        hipLaunchKernelGGL(hybrid_fwd, dim3(grid), dim3(NWAVES * 64), LDS_BYTES, stream, a);
        const hipError_t le = hipPeekAtLastError();
        if (le != hipSuccess) { fprintf(stderr, "kernel_launch: launch %d failed: %s\n", li, hipGetErrorName(le)); break; }
    }
}
```
